# Optimizing an MI355X kernel written in HIP

```python
import math
import jax, jax.numpy as jnp
from jax import lax
import numpy as np

D_MODEL = 1024
BATCH = 8
SEQ = 4096
DEPTH = 2

N_MIXERS = 2
N_A_LAYERS = (DEPTH + 1) // 2
N_B_LAYERS = DEPTH // 2
RMS_EPS = 1e-6
ROPE_THETA = 500000.0

H_A = 8
DH_A = D_MODEL // H_A
ROT_A = DH_A // 4
H_IDX = 8
D_IDX = 64
ROT_IDX = D_IDX // 4
TOPK_MAX = 256
Q_BLOCK = 128
A_COLS = [H_A * DH_A, DH_A, DH_A, H_IDX * D_IDX, D_IDX, H_IDX]
A_IN = sum(A_COLS)

H_R = 4
DK_R = D_MODEL // H_R
DV_R = 2 * DK_R
RET_THETA = 10000.0
CHUNK = 128
B_COLS = [H_R * DK_R, H_R * DK_R, H_R * DV_R, H_R * DV_R]
B_IN = sum(B_COLS)

D_FF = 4 * D_MODEL

kernel_name = "dsa_retention_interleaved_hybrid"


def _offsets(cols):
    return [int(v) for v in np.cumsum(cols)[:-1]]


def rmsnorm(x, g):
    xf = x.astype(jnp.float32)
    y = xf * lax.rsqrt(jnp.mean(xf * xf, axis=-1, keepdims=True) + RMS_EPS)
    return (y * g.astype(jnp.float32)).astype(x.dtype)


def rotary(x, pos, rot_dim, theta):
    half = rot_dim // 2
    inv = theta ** (-jnp.arange(half, dtype=jnp.float32) / half)
    ang = pos.astype(jnp.float32)[..., None] * inv
    cos = jnp.cos(ang)[:, :, None, :]
    sin = jnp.sin(ang)[:, :, None, :]
    x1 = x[..., :half].astype(jnp.float32)
    x2 = x[..., half:rot_dim].astype(jnp.float32)
    rot = jnp.concatenate([x1 * cos - x2 * sin, x2 * cos + x1 * sin], axis=-1).astype(x.dtype)
    return jnp.concatenate([rot, x[..., rot_dim:]], axis=-1)


def dsa_mixer(h, pos, w_in, w_out):
    B, S, _ = h.shape
    topk = min(TOPK_MAX, S // 4)
    nb = S // Q_BLOCK
    q, k, v, qi, ki, wi = jnp.split(h @ w_in, _offsets(A_COLS), axis=-1)
    q = rotary(q.reshape(B, S, H_A, DH_A), pos, ROT_A, ROPE_THETA)
    k = rotary(k[:, :, None, :], pos, ROT_A, ROPE_THETA)[:, :, 0]
    qi = rotary(qi.reshape(B, S, H_IDX, D_IDX), pos, ROT_IDX, ROPE_THETA)
    ki = rotary(ki[:, :, None, :], pos, ROT_IDX, ROPE_THETA)[:, :, 0]
    wi = wi * (H_IDX ** -0.5 * D_IDX ** -0.5)
    kv = jnp.concatenate([k, v], axis=-1)
    key_idx = jnp.arange(S)
    scale = 1.0 / math.sqrt(DH_A)

    def to_blocks(a):
        return a.reshape((B, nb, Q_BLOCK) + a.shape[2:]).swapaxes(0, 1)

    t_blk = jnp.arange(S).reshape(nb, Q_BLOCK)

    def block(args):
        qb, qib, wb, tb = args
        sc = jnp.einsum('bqhd,bsd->bqhs', qib, ki).astype(jnp.float32)
        idx_score = jnp.einsum('bqhs,bqh->bqs', jax.nn.relu(sc), wb.astype(jnp.float32))
        idx_score = jnp.where(key_idx[None, None, :] <= tb[None, :, None], idx_score, -jnp.inf)
        _, sel = lax.top_k(idx_score, topk)
        kvg = jax.vmap(lambda a, i: a[i])(kv, sel)
        kg, vg = kvg[..., :DH_A], kvg[..., DH_A:]
        valid = sel <= tb[None, :, None]
        logits = jnp.einsum('bqhd,bqkd->bqhk', qb, kg).astype(jnp.float32) * scale
        logits = jnp.where(valid[:, :, None, :], logits, -jnp.inf)
        p = jax.nn.softmax(logits, axis=-1)
        return jnp.einsum('bqhk,bqkd->bqhd', p.astype(vg.dtype), vg)

    o = lax.map(block, (to_blocks(q), to_blocks(qi), to_blocks(wi), t_blk))
    o = o.swapaxes(0, 1).reshape(B, S, H_A * DH_A)
    return o @ w_out


def retention_mixer(h, pos, w_in, gn_g, w_out):
    B, S, _ = h.shape
    n = S // CHUNK
    q, k, v, g = jnp.split(h @ w_in, _offsets(B_COLS), axis=-1)
    q = rotary(q.reshape(B, S, H_R, DK_R), pos, DK_R, RET_THETA)
    k = rotary(k.reshape(B, S, H_R, DK_R), pos, DK_R, RET_THETA) * (DK_R ** -0.5)
    v = v.reshape(B, S, H_R, DV_R)

    def chunks(a):
        return a.reshape(B, n, CHUNK, H_R, a.shape[-1]).transpose(1, 0, 3, 2, 4).astype(jnp.float32)

    log_gamma = jnp.log1p(-jnp.exp2(-5.0 - jnp.arange(H_R, dtype=jnp.float32)))
    j = jnp.arange(CHUNK, dtype=jnp.float32)
    diff = j[:, None] - j[None, :]
    decay = jnp.where(diff >= 0, jnp.exp(jnp.maximum(diff, 0.0) * log_gamma[:, None, None]), 0.0)
    xi = jnp.exp((j + 1.0) * log_gamma[:, None])[..., None]
    zeta = jnp.exp((CHUNK - 1.0 - j) * log_gamma[:, None])[..., None]
    gamma_c = jnp.exp(CHUNK * log_gamma)[:, None, None]

    def step(state, inp):
        qc, kc, vc = inp
        inner = jnp.einsum('bhnd,bhmd->bhnm', qc, kc) * decay
        out = jnp.einsum('bhnm,bhme->bhne', inner, vc) + jnp.einsum('bhnd,bhde->bhne', qc * xi, state)
        state = gamma_c * state + jnp.einsum('bhmd,bhme->bhde', kc * zeta, vc)
        return state, out

    state0 = jnp.zeros((B, H_R, DK_R, DV_R), jnp.float32)
    _, ys = lax.scan(step, state0, (chunks(q), chunks(k), chunks(v)))
    y = ys.transpose(1, 0, 3, 2, 4).reshape(B, S, H_R, DV_R)
    mu = jnp.mean(y, axis=-1, keepdims=True)
    var = jnp.mean(jnp.square(y - mu), axis=-1, keepdims=True)
    y = ((y - mu) * lax.rsqrt(var + RMS_EPS)).reshape(B, S, H_R * DV_R) * gn_g.astype(jnp.float32)
    y = (jax.nn.silu(g.astype(jnp.float32)) * y).astype(h.dtype)
    return y @ w_out


def sqrelu_mlp(h, w_up, w_down):
    return jnp.square(jax.nn.relu(h @ w_up)) @ w_down


def setup_inputs(seed: int = 0) -> dict:
    key = jax.random.key(seed)
    ks = jax.random.split(key, 12)

    def w(k, shape, fan_in):
        return jax.random.normal(k, shape, jnp.float32) * (fan_in ** -0.5)

    def gain(k, shape):
        return 1.0 + 0.02 * jax.random.normal(k, shape, jnp.float32)

    x = jax.random.normal(ks[0], (BATCH, SEQ, D_MODEL), jnp.float32)
    positions = jnp.broadcast_to(jnp.arange(SEQ, dtype=jnp.int32)[None, :], (BATCH, SEQ))
    return {
        "x": x,
        "positions": positions,
        "norm_mix_g": gain(ks[1], (DEPTH, D_MODEL)),
        "norm_mlp_g": gain(ks[2], (DEPTH, D_MODEL)),
        "w_in_a": w(ks[3], (N_A_LAYERS, D_MODEL, A_IN), D_MODEL),
        "w_out_a": w(ks[4], (N_A_LAYERS, H_A * DH_A, D_MODEL), H_A * DH_A),
        "w_in_b": w(ks[5], (N_B_LAYERS, D_MODEL, B_IN), D_MODEL),
        "ret_norm_g": gain(ks[6], (N_B_LAYERS, H_R * DV_R)),
        "w_out_b": w(ks[7], (N_B_LAYERS, H_R * DV_R, D_MODEL), H_R * DV_R),
        "w_mlp_up": w(ks[8], (DEPTH, D_MODEL, D_FF), D_MODEL),
        "w_mlp_down": w(ks[9], (DEPTH, D_FF, D_MODEL), D_FF),
        "final_norm_g": gain(ks[10], (D_MODEL,)),
    }


def reference(x, positions, norm_mix_g, norm_mlp_g, w_in_a, w_out_a, w_in_b, ret_norm_g,
              w_out_b, w_mlp_up, w_mlp_down, final_norm_g):
    h = x
    for i in range(DEPTH):
        j = i // N_MIXERS
        hn = rmsnorm(h, norm_mix_g[i])
        if i % N_MIXERS == 0:
            h = h + dsa_mixer(hn, positions, w_in_a[j], w_out_a[j])
        else:
            h = h + retention_mixer(hn, positions, w_in_b[j], ret_norm_g[j], w_out_b[j])
        h = h + sqrelu_mlp(rmsnorm(h, norm_mlp_g[i]), w_mlp_up[i], w_mlp_down[i])
    return rmsnorm(h, final_norm_g)
```

```cpp
#include <hip/hip_runtime.h>
#include <hip/hip_cooperative_groups.h>
#include <cstdio>
#include <cstdint>
namespace cg = cooperative_groups;

#define LAS __attribute__((address_space(3)))
#define GAS __attribute__((address_space(1)))
typedef unsigned short bf16_t;
typedef short bf16x8 __attribute__((ext_vector_type(8)));
typedef float f32x4 __attribute__((ext_vector_type(4)));
typedef float f32x2 __attribute__((ext_vector_type(2)));
typedef unsigned u32x4 __attribute__((ext_vector_type(4)));
typedef unsigned u32x2 __attribute__((ext_vector_type(2)));

constexpr int NB = 8, SEQ = 4096, T = NB * SEQ, D = 1024, FF = 4096;
constexpr int A_IN = 1864, A_PAD = 2048, B_IN = 6144;
constexpr int TOPK = 256;
constexpr float EPS = 1e-6f;
constexpr float QSCALE = 0.08838834764831845f * 1.4426950408889634f;

constexpr size_t MiB = 1u << 20;
constexpr size_t WS_CTL = 0, CTL_ZERO_BYTES = 1 * MiB;
constexpr size_t WS_SSQ = 1 * MiB;
constexpr size_t WS_WI = 3 * MiB;
constexpr size_t WS_TABA = 4 * MiB;
constexpr size_t WS_TABI = 4 * MiB + 512 * 1024;
constexpr size_t WS_TABR = 5 * MiB;
constexpr size_t WS_STATS = 9 * MiB;
constexpr size_t WS_WA = 18 * MiB, WS_WOA = 22 * MiB, WS_WUP0 = 24 * MiB, WS_WDN0 = 32 * MiB, WS_WB = 40 * MiB, WS_WOB = 52 * MiB, WS_WUP1 = 56 * MiB, WS_WDN1 = 64 * MiB;
constexpr size_t WS_Q = 72 * MiB, WS_K = 136 * MiB, WS_V = 144 * MiB, WS_QI = 152 * MiB, WS_KI = 184 * MiB, WS_SEL = 188 * MiB, WS_O = 204 * MiB;
constexpr size_t WS_HID0 = 72 * MiB, WS_XBHI = 448 * MiB;
constexpr size_t WS_Q1 = 72 * MiB, WS_K1 = 136 * MiB, WS_VT = 200 * MiB, WS_INNER = 328 * MiB, WS_Y = 384 * MiB, WS_XBLO = 72 * MiB, WS_HID1 = 136 * MiB;
constexpr size_t WS_END = 512 * MiB;

__device__ __forceinline__ float bf2f(bf16_t v) { return __uint_as_float((unsigned)v << 16); }
__device__ __forceinline__ unsigned f2bf(float f) { unsigned u = __float_as_uint(f); return (u + 0x7fffu + ((u >> 16) & 1u)) >> 16; }
__device__ __forceinline__ unsigned pk2(float lo, float hi) { return f2bf(lo) | (f2bf(hi) << 16); }
__device__ __forceinline__ u32x2 pk4(f32x4 v) { u32x2 r; r.x = pk2(v.x, v.y); r.y = pk2(v.z, v.w); return r; }
__device__ __forceinline__ float wave_sum(float v) {
#pragma unroll
    for (int o = 1; o < 64; o <<= 1) v += __shfl_xor(v, o);
    return v;
}
__device__ __forceinline__ float row_rstd(const float* ssq16, int row) {
    const f32x4* p = (const f32x4*)(ssq16 + (size_t)row * 16);
    const f32x4 a = p[0], b = p[1], c = p[2], d = p[3];
    const float s = (((a.x + a.y) + (a.z + a.w)) + ((b.x + b.y) + (b.z + b.w))) + (((c.x + c.y) + (c.z + c.w)) + ((d.x + d.y) + (d.z + d.w)));
    return rsqrtf(s * (1.0f / 1024.0f) + EPS);
}

namespace pg8 {
#define PG8_LAS __attribute__((address_space(3)))
constexpr int BM = 256, BK = 64, HALF = 128, HTB = HALF * BK * 2, STAGE_BYTES = 8 * HTB, NXCD = 8, WGM = 8;
__host__ __device__ __forceinline__ int lds_byte(int r, int c) { const int st = (r >> 4) * 2 + (c >> 5), rr = r & 15, cc = c & 31, ob = rr * 64 + cc * 2; return st * 1024 + (ob ^ (((ob >> 9) & 1) << 5)); }
__host__ __device__ __forceinline__ void stage_rc(int b, int& R, int& C) { const int st = b / 1024, sb = b % 1024, swz = sb ^ (((sb >> 9) & 1) << 5); R = (st >> 1) * 16 + swz / 64; C = (st & 1) * 32 + (swz % 64) / 2; }
__host__ __device__ __forceinline__ int perm32(int rho) { const int n = rho >> 4, i = rho & 15; return 8 * (i >> 2) + 4 * n + (i & 3); }
struct Unit { int pm, pn; };
struct Gemm { const bf16_t* A; const bf16_t* Bt; int M, N, K; };
struct StaticOrder {
    int nM, nN, nwg, G, c;
    __host__ __device__ void init(int M, int N, int G_, int c_) { nM = M / BM; nN = N / BM; nwg = nM * nN; G = G_; c = c_; }
    __host__ __device__ bool next(int i, Unit& u) const {
        const long L = (long)i * G + c; if (L >= nwg) return false;
        int wgid = (int)L; { const int q = nwg / NXCD, r = nwg % NXCD, xcd = wgid % NXCD, off = wgid / NXCD; wgid = (xcd < r ? xcd * (q + 1) : r * (q + 1) + (xcd - r) * q) + off; }
        const int nig = WGM * nN, gid = wgid / nig, fm = gid * WGM, gsz = (nM - fm) < WGM ? (nM - fm) : WGM;
        u.pm = fm + ((wgid % nig) % gsz); u.pn = (wgid % nig) / gsz; return true;
    }
    __device__ __forceinline__ void a_ready(const Unit&) const {}
    __device__ __forceinline__ void done(const Unit&) const {}
};

template <class Epi, class Sched, bool ALIGN_EPI, bool SP2, bool SWAP>
__device__ __forceinline__ void gemm_phase(PG8_LAS unsigned char* lds, const Gemm g, const Sched& S, const Epi& E) {
    const int tid = threadIdx.x, wid = __builtin_amdgcn_readfirstlane(tid >> 6), lane = tid & 63, wr = wid >> 2, wc = wid & 3, fr = lane & 15, fq = lane >> 4;
    const int K = g.K, nt = K / BK;
    unsigned voffA[2], voffB[2];
#pragma unroll
    for (int i = 0; i < 2; ++i) { int R, C; stage_rc(tid * 16 + i * 8192, R, C); const int Rb = Epi::PERM ? ((R & ~31) + perm32(R & 31)) : R;
        voffA[i] = (unsigned)(R * K + C) * 2u; voffB[i] = (unsigned)(Rb * K + C) * 2u; }
    const size_t kstep = (size_t)(BK * 2);
    const size_t hstep = (size_t)HALF * K * 2;
    const size_t tstep = 2 * hstep;
    const unsigned ldsw = (unsigned)wid * 1024u;
    const int aoff = lds_byte(wr * 64 + fr, fq * 8), boff = lds_byte(wc * 32 + fr, fq * 8);
#define PG8_SA(b, h) (((b) * 2 + (h)) * HTB)
#define PG8_SB(b, h) ((4 + (b) * 2 + (h)) * HTB)
#define PG8_STAGE(bufoff, gbase, voff) do { _Pragma("unroll") for (int _i = 0; _i < 2; ++_i) \
        __builtin_amdgcn_global_load_lds((const unsigned*)((const char*)(gbase) + (voff)[_i]), (PG8_LAS unsigned*)(lds + (bufoff) + ldsw + _i * 8192), 16, 0, 0); } while (0)
#define PG8_LDA(dst, b, h) do { _Pragma("unroll") for (int m = 0; m < 4; ++m) _Pragma("unroll") for (int k = 0; k < 2; ++k) dst[m][k] = *(const PG8_LAS bf16x8*)(lds + PG8_SA(b, h) + aoff + m * 2048 + k * 1024); } while (0)
#define PG8_LDB(dst, b, h) do { _Pragma("unroll") for (int n = 0; n < 2; ++n) _Pragma("unroll") for (int k = 0; k < 2; ++k) dst[n][k] = *(const PG8_LAS bf16x8*)(lds + PG8_SB(b, h) + boff + n * 2048 + k * 1024); } while (0)
#define PG8_MMA(ai, bj, At, Bt) do { __builtin_amdgcn_s_setprio(1); _Pragma("unroll") for (int m = 0; m < 4; ++m) _Pragma("unroll") for (int n = 0; n < 2; ++n) _Pragma("unroll") for (int k = 0; k < 2; ++k) { \
        if constexpr (SWAP) acc[ai][bj][m][n] = __builtin_amdgcn_mfma_f32_16x16x32_bf16(At[m][k], Bt[n][k], acc[ai][bj][m][n], 0, 0, 0); \
        else acc[ai][bj][m][n] = __builtin_amdgcn_mfma_f32_16x16x32_bf16(Bt[n][k], At[m][k], acc[ai][bj][m][n], 0, 0, 0); } __builtin_amdgcn_s_setprio(0); } while (0)
#define PG8_WAIT_V(n) asm volatile("s_waitcnt vmcnt(" #n ")" ::: "memory")
#define PG8_WAIT_L(n) asm volatile("s_waitcnt lgkmcnt(" #n ")" ::: "memory")
#define PG8_BAR __builtin_amdgcn_s_barrier()
#define PG8_SCHED __builtin_amdgcn_sched_barrier(0)
    Unit cur, nxt; int ui = 0;
    if (!S.next(0, cur)) return;
    f32x4 acc[2][2][4][2];
#pragma unroll
    for (int a = 0; a < 2; ++a)
#pragma unroll
        for (int b = 0; b < 2; ++b)
#pragma unroll
            for (int m = 0; m < 4; ++m)
#pragma unroll
                for (int n = 0; n < 2; ++n) acc[a][b][m][n] = (f32x4){0.f, 0.f, 0.f, 0.f};
    bf16x8 At[4][2], B0[2][2], B1[2][2];
    const char* cA = (const char*)g.A + (size_t)cur.pm * tstep; const char* cB = (const char*)g.Bt + (size_t)cur.pn * tstep;
    S.a_ready(cur);
    if constexpr (SP2) {
        PG8_STAGE(PG8_SB(0, 0), cB, voffB); PG8_STAGE(PG8_SB(0, 1), cB + hstep, voffB); PG8_STAGE(PG8_SA(0, 0), cA, voffA); PG8_STAGE(PG8_SA(0, 1), cA + hstep, voffA);
        if (wr == 1) PG8_BAR;
        PG8_WAIT_V(2); PG8_BAR;
        PG8_STAGE(PG8_SB(1, 0), cB + kstep, voffB); PG8_STAGE(PG8_SA(1, 0), cA + kstep, voffA); PG8_STAGE(PG8_SB(1, 1), cB + hstep + kstep, voffB);
        PG8_WAIT_V(6); PG8_BAR;
    } else {
        PG8_STAGE(PG8_SB(0, 0), cB, voffB); PG8_STAGE(PG8_SA(0, 0), cA, voffA); PG8_STAGE(PG8_SB(0, 1), cB + hstep, voffB); PG8_STAGE(PG8_SA(0, 1), cA + hstep, voffA);
        if (wr == 1) PG8_BAR;
        PG8_WAIT_V(4); PG8_BAR;
        PG8_STAGE(PG8_SB(1, 0), cB + kstep, voffB); PG8_STAGE(PG8_SA(1, 0), cA + kstep, voffA); PG8_STAGE(PG8_SB(1, 1), cB + hstep + kstep, voffB);
        PG8_WAIT_V(6); PG8_BAR;
    }
    for (;;) {
        const bool has_next = S.next(ui + 1, nxt);
        const char* nA = has_next ? (const char*)g.A + (size_t)nxt.pm * tstep : cA; const char* nB = has_next ? (const char*)g.Bt + (size_t)nxt.pn * tstep : cB;
        for (int t = 0; t < nt; t += 2) {
            const bool last = (t == nt - 2);
            const char* a1 = cA + (size_t)(t + 1) * kstep;
            const char* a2 = last ? nA : cA + (size_t)(t + 2) * kstep; const char* b2 = last ? nB : cB + (size_t)(t + 2) * kstep;
            const char* a3 = a2 + kstep; const char* b3 = b2 + kstep;
            if (last && has_next) S.a_ready(nxt);
            if constexpr (SP2) {
            PG8_LDB(B0, 0, 0); PG8_LDB(B1, 0, 1); PG8_SCHED; PG8_LDA(At, 0, 0); PG8_STAGE(PG8_SA(1, 1), a1 + hstep, voffA);
            PG8_WAIT_V(8); PG8_WAIT_L(0); PG8_BAR; PG8_MMA(0, 0, At, B0); PG8_MMA(0, 1, At, B1); PG8_BAR; PG8_SCHED;
            PG8_LDA(At, 0, 1); PG8_STAGE(PG8_SB(0, 0), b2, voffB); PG8_STAGE(PG8_SB(0, 1), b2 + hstep, voffB); PG8_STAGE(PG8_SA(0, 0), a2, voffA);
            PG8_WAIT_V(8); PG8_WAIT_L(0); PG8_BAR; PG8_MMA(1, 0, At, B0); PG8_MMA(1, 1, At, B1); PG8_BAR; PG8_SCHED;
            PG8_LDB(B0, 1, 0); PG8_LDB(B1, 1, 1); PG8_SCHED; PG8_LDA(At, 1, 0); PG8_STAGE(PG8_SA(0, 1), a2 + hstep, voffA);
            PG8_WAIT_V(8); PG8_WAIT_L(0); PG8_BAR; PG8_MMA(0, 0, At, B0); PG8_MMA(0, 1, At, B1); PG8_BAR; PG8_SCHED;
            PG8_LDA(At, 1, 1); PG8_STAGE(PG8_SB(1, 0), b3, voffB); PG8_STAGE(PG8_SB(1, 1), b3 + hstep, voffB); PG8_STAGE(PG8_SA(1, 0), a3, voffA);
            PG8_WAIT_V(8); PG8_WAIT_L(0); PG8_BAR; PG8_MMA(1, 0, At, B0); PG8_MMA(1, 1, At, B1); PG8_BAR; PG8_SCHED;
            } else {
            PG8_LDB(B0, 0, 0); PG8_SCHED; PG8_LDA(At, 0, 0); PG8_STAGE(PG8_SA(1, 1), a1 + hstep, voffA);
            PG8_WAIT_L(8); PG8_BAR; PG8_WAIT_L(0); PG8_MMA(0, 0, At, B0); PG8_BAR; PG8_SCHED;
            PG8_LDB(B1, 0, 1); PG8_STAGE(PG8_SB(0, 0), b2, voffB);
            PG8_BAR; PG8_WAIT_L(0); PG8_MMA(0, 1, At, B1); PG8_BAR;
            PG8_LDA(At, 0, 1); PG8_STAGE(PG8_SA(0, 0), a2, voffA);
            PG8_BAR; PG8_WAIT_L(0); PG8_MMA(1, 0, At, B0); PG8_BAR; PG8_SCHED;
            PG8_STAGE(PG8_SB(0, 1), b2 + hstep, voffB);
            PG8_WAIT_V(6); PG8_BAR; PG8_MMA(1, 1, At, B1); PG8_BAR;
            PG8_LDB(B0, 1, 0); PG8_SCHED; PG8_LDA(At, 1, 0); PG8_STAGE(PG8_SA(0, 1), a2 + hstep, voffA);
            PG8_WAIT_L(8); PG8_BAR; PG8_WAIT_L(0); PG8_MMA(0, 0, At, B0); PG8_BAR; PG8_SCHED;
            PG8_LDB(B1, 1, 1); PG8_STAGE(PG8_SB(1, 0), b3, voffB);
            PG8_BAR; PG8_WAIT_L(0); PG8_MMA(0, 1, At, B1); PG8_BAR;
            PG8_LDA(At, 1, 1); PG8_STAGE(PG8_SA(1, 0), a3, voffA);
            PG8_BAR; PG8_WAIT_L(0); PG8_MMA(1, 0, At, B0); PG8_BAR; PG8_SCHED;
            PG8_STAGE(PG8_SB(1, 1), b3 + hstep, voffB);
            PG8_WAIT_V(6); PG8_BAR; PG8_MMA(1, 1, At, B1); PG8_BAR;
            }
        }
        if constexpr (ALIGN_EPI) { if (wr == 0) PG8_BAR; }
        E(acc, cur, wr, wc, fr, fq); S.done(cur);
        if (!has_next) break;
#pragma unroll
        for (int a = 0; a < 2; ++a)
#pragma unroll
            for (int b = 0; b < 2; ++b)
#pragma unroll
                for (int m = 0; m < 4; ++m)
#pragma unroll
                    for (int n = 0; n < 2; ++n) acc[a][b][m][n] = (f32x4){0.f, 0.f, 0.f, 0.f};
        cur = nxt; cA = nA; cB = nB; ++ui;
        if constexpr (ALIGN_EPI) { if (wr == 1) PG8_BAR; }
    }
    PG8_WAIT_V(0);
    if constexpr (!ALIGN_EPI) { if (wr == 0) PG8_BAR; }
    PG8_BAR;
#undef PG8_SA
#undef PG8_SB
#undef PG8_STAGE
#undef PG8_LDA
#undef PG8_LDB
#undef PG8_MMA
#undef PG8_WAIT_V
#undef PG8_WAIT_L
#undef PG8_BAR
#undef PG8_SCHED
}

template <class Epi, class Sched, bool SWAP>
__device__ __forceinline__ void gemm_naive(const Gemm g, const Sched& S, const Epi& E) {
    const int tid = threadIdx.x, wid = tid >> 6, lane = tid & 63, wr = wid >> 2, wc = wid & 3, fr = lane & 15, fq = lane >> 4;
    Unit u;
    for (int i = 0; S.next(i, u); ++i) {
        f32x4 acc[2][2][4][2];
#pragma unroll 1
        for (int ai = 0; ai < 2; ++ai)
#pragma unroll 1
            for (int bj = 0; bj < 2; ++bj)
#pragma unroll 1
                for (int m = 0; m < 4; ++m)
#pragma unroll 1
                    for (int n = 0; n < 2; ++n) {
                        f32x4 r;
#pragma unroll 1
                        for (int e = 0; e < 4; ++e) {
                            int row, col;
                            if (SWAP) { row = u.pm * 256 + ai * 128 + wr * 64 + m * 16 + 4 * fq + e; col = u.pn * 256 + bj * 128 + wc * 32 + n * 16 + fr; }
                            else { row = u.pm * 256 + ai * 128 + wr * 64 + m * 16 + fr; col = u.pn * 256 + bj * 128 + wc * 32 + n * 16 + 4 * fq + e; }
                            const bf16x8* a = (const bf16x8*)(g.A + (size_t)row * g.K); const bf16x8* b = (const bf16x8*)(g.Bt + (size_t)col * g.K);
                            float s = 0.f;
                            for (int k = 0; k < g.K / 8; ++k) { const bf16x8 av = a[k], bv = b[k];
#pragma unroll
                                for (int j = 0; j < 8; ++j) s += bf2f((bf16_t)av[j]) * bf2f((bf16_t)bv[j]); }
                            r[e] = s;
                        }
#pragma unroll
                        for (int a2 = 0; a2 < 2; ++a2)
#pragma unroll
                            for (int b2 = 0; b2 < 2; ++b2)
#pragma unroll
                                for (int m2 = 0; m2 < 4; ++m2)
#pragma unroll
                                    for (int n2 = 0; n2 < 2; ++n2) if (a2 == ai && b2 == bj && m2 == m && n2 == n) acc[a2][b2][m2][n2] = r;
                    }
        E(acc, u, wr, wc, fr, fq);
    }
}
}
using pg8::Unit;

struct EpiA {
    static constexpr bool PERM = false;
    const float* ssq; const int* pos; const f32x2* tabA; const f32x2* tabI;
    bf16_t *q, *k, *v, *qi, *ki; float* wi;
    __device__ __forceinline__ void operator()(const f32x4 (&acc)[2][2][4][2], const Unit& u, int wr, int wc, int fr, int fq) const {
        const int row0 = u.pm * 256 + wr * 64 + fr; const int pn = u.pn;
#pragma unroll
        for (int ai = 0; ai < 2; ++ai)
#pragma unroll
            for (int m = 0; m < 4; ++m) {
                const int row = row0 + ai * 128 + m * 16;
                const float rs = row_rstd(ssq, row);
                int p = pos[row]; p = p < 0 ? 0 : (p > SEQ - 1 ? SEQ - 1 : p);
                if (pn < 4) {
#pragma unroll
                    for (int bj = 0; bj < 2; ++bj) {
                        f32x4 a0 = acc[ai][bj][m][0] * rs, a1 = acc[ai][bj][m][1] * rs;
                        if (wc == 0) { const f32x2* tb = tabA + p * 16 + 4 * fq;
#pragma unroll
                            for (int e = 0; e < 4; ++e) { const f32x2 cs = tb[e]; const float x1 = a0[e], x2 = a1[e]; a0[e] = x1 * cs.x - x2 * cs.y; a1[e] = x2 * cs.x + x1 * cs.y; } }
                        a0 = a0 * QSCALE; a1 = a1 * QSCALE;
                        bf16_t* dst = q + (size_t)row * 1024 + pn * 256 + bj * 128 + wc * 32 + 4 * fq;
                        *(u32x2*)dst = pk4(a0); *(u32x2*)(dst + 16) = pk4(a1);
                    }
                } else if (pn == 4) {
                    { f32x4 a0 = acc[ai][0][m][0] * rs, a1 = acc[ai][0][m][1] * rs;
                      if (wc == 0) { const f32x2* tb = tabA + p * 16 + 4 * fq;
#pragma unroll
                          for (int e = 0; e < 4; ++e) { const f32x2 cs = tb[e]; const float x1 = a0[e], x2 = a1[e]; a0[e] = x1 * cs.x - x2 * cs.y; a1[e] = x2 * cs.x + x1 * cs.y; } }
                      bf16_t* dst = k + (size_t)row * 128 + wc * 32 + 4 * fq; *(u32x2*)dst = pk4(a0); *(u32x2*)(dst + 16) = pk4(a1); }
                    { const f32x4 a0 = acc[ai][1][m][0] * rs, a1 = acc[ai][1][m][1] * rs;
                      bf16_t* dst = v + (size_t)row * 128 + wc * 32 + 4 * fq; *(u32x2*)dst = pk4(a0); *(u32x2*)(dst + 16) = pk4(a1); }
                } else if (pn < 7) {
#pragma unroll
                    for (int bj = 0; bj < 2; ++bj) {
                        f32x4 a0 = acc[ai][bj][m][0] * rs; const f32x4 a1 = acc[ai][bj][m][1] * rs;
                        if ((wc & 1) == 0) { const f32x2* tb = tabI + p * 8 + 4 * (fq & 1);
#pragma unroll
                            for (int e = 0; e < 4; ++e) { const float other = __shfl_xor(a0[e], 32); const f32x2 cs = tb[e]; a0[e] = (fq < 2) ? (a0[e] * cs.x - other * cs.y) : (a0[e] * cs.x + other * cs.y); } }
                        bf16_t* dst = qi + (size_t)row * 512 + (pn - 5) * 256 + bj * 128 + wc * 32 + 4 * fq;
                        *(u32x2*)dst = pk4(a0); *(u32x2*)(dst + 16) = pk4(a1);
                    }
                } else {
                    if (wc < 2) {
                        f32x4 a0 = acc[ai][0][m][0] * rs; const f32x4 a1 = acc[ai][0][m][1] * rs;
                        if (wc == 0) { const f32x2* tb = tabI + p * 8 + 4 * (fq & 1);
#pragma unroll
                            for (int e = 0; e < 4; ++e) { const float other = __shfl_xor(a0[e], 32); const f32x2 cs = tb[e]; a0[e] = (fq < 2) ? (a0[e] * cs.x - other * cs.y) : (a0[e] * cs.x + other * cs.y); } }
                        bf16_t* dst = ki + (size_t)row * 64 + wc * 32 + 4 * fq; *(u32x2*)dst = pk4(a0); *(u32x2*)(dst + 16) = pk4(a1);
                    } else if (wc == 2) {
                        if (fq < 2) { const f32x4 a0 = acc[ai][0][m][0] * (rs * 0.04419417382415922f); *(f32x4*)(wi + (size_t)row * 8 + 4 * fq) = a0; }
                    }
                }
            }
    }
};

struct EpiUp {
    static constexpr bool PERM = false;
    const float* ssq; bf16_t* hid;
    __device__ __forceinline__ void operator()(const f32x4 (&acc)[2][2][4][2], const Unit& u, int wr, int wc, int fr, int fq) const {
        const int row0 = u.pm * 256 + wr * 64 + fr, col0 = u.pn * 256 + wc * 32 + 4 * fq;
#pragma unroll
        for (int ai = 0; ai < 2; ++ai)
#pragma unroll
            for (int m = 0; m < 4; ++m) {
                const int row = row0 + ai * 128 + m * 16; const float rs = row_rstd(ssq, row);
                bf16_t* rowp = hid + (size_t)row * FF + col0;
#pragma unroll
                for (int bj = 0; bj < 2; ++bj)
#pragma unroll
                    for (int n = 0; n < 2; ++n) { f32x4 a = acc[ai][bj][m][n] * rs;
#pragma unroll
                        for (int e = 0; e < 4; ++e) { const float r = fmaxf(a[e], 0.f); a[e] = r * r; }
                        *(u32x2*)(rowp + bj * 128 + n * 16) = pk4(a); }
            }
    }
};

struct EpiResid {
    static constexpr bool PERM = false;
    float* h; bf16_t* xb; float* ssq;
    __device__ __forceinline__ void operator()(const f32x4 (&acc)[2][2][4][2], const Unit& u, int wr, int wc, int fr, int fq) const {
        const int row0 = u.pm * 256 + wr * 64 + fr, col0 = u.pn * 256 + wc * 32 + 4 * fq;
#pragma unroll
        for (int ai = 0; ai < 2; ++ai)
#pragma unroll
            for (int m = 0; m < 4; ++m) {
                const int row = row0 + ai * 128 + m * 16; float s = 0.f;
#pragma unroll
                for (int bj = 0; bj < 2; ++bj)
#pragma unroll
                    for (int n = 0; n < 2; ++n) { const size_t off = (size_t)row * D + col0 + bj * 128 + n * 16;
                        const f32x4 hv = *(const f32x4*)(h + off) + acc[ai][bj][m][n];
                        *(f32x4*)(h + off) = hv; *(u32x2*)(xb + off) = pk4(hv);
                        s += (hv.x * hv.x + hv.y * hv.y) + (hv.z * hv.z + hv.w * hv.w); }
                s += __shfl_xor(s, 16); s += __shfl_xor(s, 32);
                if (fq == 0) ssq[(size_t)row * 16 + u.pn * 4 + wc] = s;
            }
    }
};

struct EpiBqk {
    static constexpr bool PERM = false;
    const float* ssq; const int* pos; const f32x2* tabR; bf16_t *q1, *k1;
    __device__ __forceinline__ void operator()(const f32x4 (&acc)[2][2][4][2], const Unit& u, int wr, int wc, int fr, int fq) const {
        const int row0 = u.pm * 256 + wr * 64 + fr; const bool isk = u.pn >= 4; bf16_t* dstb = isk ? k1 : q1; const float sc = isk ? 0.0625f : 1.0f; const int hd = u.pn & 3;
#pragma unroll
        for (int ai = 0; ai < 2; ++ai)
#pragma unroll
            for (int m = 0; m < 4; ++m) {
                const int row = row0 + ai * 128 + m * 16; const float rs = row_rstd(ssq, row) * sc;
                int p = pos[row]; p = p < 0 ? 0 : (p > SEQ - 1 ? SEQ - 1 : p);
#pragma unroll
                for (int n = 0; n < 2; ++n) { f32x4 x1 = acc[ai][0][m][n] * rs, x2 = acc[ai][1][m][n] * rs; const f32x2* tb = tabR + p * 128 + wc * 32 + n * 16 + 4 * fq;
#pragma unroll
                    for (int e = 0; e < 4; ++e) { const f32x2 cs = tb[e]; const float a = x1[e], b = x2[e]; x1[e] = a * cs.x - b * cs.y; x2[e] = b * cs.x + a * cs.y; }
                    bf16_t* dst = dstb + (size_t)row * 1024 + hd * 256 + wc * 32 + n * 16 + 4 * fq; *(u32x2*)dst = pk4(x1); *(u32x2*)(dst + 128) = pk4(x2); }
            }
    }
};
struct EpiBv {
    static constexpr bool PERM = false;
    const float* ssq; bf16_t* vT;
    __device__ __forceinline__ void operator()(const f32x4 (&acc)[2][2][4][2], const Unit& u, int wr, int wc, int fr, int fq) const {
        const int rowb = u.pm * 256 + wr * 64 + 4 * fq; const int b = u.pm >> 4;
#pragma unroll
        for (int ai = 0; ai < 2; ++ai)
#pragma unroll
            for (int m = 0; m < 4; ++m) {
                const int row = rowb + ai * 128 + m * 16; f32x4 rs;
#pragma unroll
                for (int e = 0; e < 4; ++e) rs[e] = row_rstd(ssq, row + e);
                const int t = row & (SEQ - 1);
#pragma unroll
                for (int bj = 0; bj < 2; ++bj)
#pragma unroll
                    for (int n = 0; n < 2; ++n) { const int c = u.pn * 256 + bj * 128 + wc * 32 + n * 16 + fr;
                        const f32x4 a = acc[ai][bj][m][n] * rs;
                        *(u32x2*)(vT + ((size_t)(b * 4 + (c >> 9)) * 512 + (c & 511)) * SEQ + t) = pk4(a); }
            }
    }
};
struct EpiGate {
    static constexpr bool PERM = false;
    const float* ssq; const float* stats; bf16_t* y;
    __device__ __forceinline__ void operator()(const f32x4 (&acc)[2][2][4][2], const Unit& u, int wr, int wc, int fr, int fq) const {
        const int row0 = u.pm * 256 + wr * 64 + fr, col0 = u.pn * 256 + wc * 32 + 4 * fq; const int hd = u.pn >> 1;
#pragma unroll
        for (int ai = 0; ai < 2; ++ai)
#pragma unroll
            for (int m = 0; m < 4; ++m) {
                const int row = row0 + ai * 128 + m * 16; const float rs = row_rstd(ssq, row);
                const f32x4* sp = (const f32x4*)(stats + ((size_t)row * 4 + hd) * 16);
                const f32x4 s0 = sp[0], s1 = sp[1], s2 = sp[2], s3 = sp[3];
                const float sum = ((s0.x + s0.z) + (s1.x + s1.z)) + ((s2.x + s2.z) + (s3.x + s3.z));
                const float sq = ((s0.y + s0.w) + (s1.y + s1.w)) + ((s2.y + s2.w) + (s3.y + s3.w));
                const float mu = sum * (1.0f / 512.0f); const float var = fmaxf(sq * (1.0f / 512.0f) - mu * mu, 0.f); const float rh = rsqrtf(var + EPS);
                bf16_t* rowp = y + (size_t)row * 2048 + col0;
#pragma unroll
                for (int bj = 0; bj < 2; ++bj)
#pragma unroll
                    for (int n = 0; n < 2; ++n) { const f32x4 g = acc[ai][bj][m][n] * rs; const u32x2 yv = *(const u32x2*)(rowp + bj * 128 + n * 16);
                        f32x4 yf; yf.x = __uint_as_float(yv.x << 16); yf.y = __uint_as_float(yv.x & 0xffff0000u); yf.z = __uint_as_float(yv.y << 16); yf.w = __uint_as_float(yv.y & 0xffff0000u);
                        f32x4 o;
#pragma unroll
                        for (int e = 0; e < 4; ++e) { const float sg = g[e] / (1.0f + __expf(-g[e])); o[e] = sg * (yf[e] - mu) * rh; }
                        *(u32x2*)(rowp + bj * 128 + n * 16) = pk4(o); }
            }
    }
};

constexpr int NWAVES = 8, NTHREADS = NWAVES * 64;
constexpr int RING_BYTES = 131072, LDSCTL_OFF = RING_BYTES, MISC_OFF = LDSCTL_OFF + 320, LDS_BYTES = 147456;

struct Args {
    const float* x; const int* pos; const float* norm_mix_g; const float* norm_mlp_g; const float* w_in_a; const float* w_out_a; const float* w_in_b; const float* ret_norm_g;
    const float* w_out_b; const float* w_mlp_up; const float* w_mlp_down; const float* final_norm_g;
    float* out; unsigned char* ws; int ph_lo, ph_hi;
};

enum Phase { PH_PROLOGUE = 0, PH_GEMM_A, PH_DSA, PH_OUT_A, PH_UP0, PH_DOWN0, PH_GEMM_B, PH_R1, PH_RET, PH_XB2, PH_GATE, PH_OUT_B, PH_UP1, PH_DOWN1, PH_FINAL, PH_COUNT };

__device__ __forceinline__ void transpose_item(const float* W, const float* gain, int K, int N, int Npad, bf16_t* WT, LAS float* scr, int item, int lane) {
    const int nblk = Npad / 32, kb = item / nblk, nb = item % nblk, k0 = 64 * kb, n0 = 32 * nb;
    const int nn = n0 + (lane & 31);
#pragma unroll 8
    for (int i = 0; i < 32; ++i) { const int kk = 2 * i + (lane >> 5); float v = 0.f; if (nn < N) { v = W[(size_t)(k0 + kk) * N + nn]; if (gain) v *= gain[k0 + kk]; } scr[kk * 33 + (lane & 31)] = v; }
    asm volatile("s_waitcnt lgkmcnt(0)" ::: "memory");
    const int c = lane & 7;
#pragma unroll
    for (int j = 0; j < 4; ++j) { const int n = (lane >> 3) + 8 * j; const LAS float* s = scr + (8 * c) * 33 + n;
        u32x4 o; o.x = pk2(s[0 * 33], s[1 * 33]); o.y = pk2(s[2 * 33], s[3 * 33]); o.z = pk2(s[4 * 33], s[5 * 33]); o.w = pk2(s[6 * 33], s[7 * 33]);
        *(u32x4*)(WT + (size_t)(n0 + n) * K + k0 + 8 * c) = o; }
    asm volatile("s_waitcnt lgkmcnt(0)" ::: "memory");
}


__global__ void __launch_bounds__(NTHREADS, 2) mk_fwd(Args a) {
    extern __shared__ __attribute__((aligned(16))) unsigned char lds_raw[];
    LAS unsigned char* lds = (LAS unsigned char*)lds_raw;
    const int tid = threadIdx.x, lane = tid & 63, wave = __builtin_amdgcn_readfirstlane(tid >> 6);
    const int G = gridDim.x, bx = blockIdx.x;
    const int vcu = (G % 8 == 0) ? (bx % 8) * (G / 8) + bx / 8 : bx;
    unsigned char* ws = a.ws;
    float* ssq = (float*)(ws + WS_SSQ);
    const int lo = a.ph_lo, hi = a.ph_hi;
#define IN(k) (lo <= (k) && (k) < hi)

    if (IN(PH_PROLOGUE)) {
        LAS float* scr = (LAS float*)(lds + wave * 16384);
        const int gw = vcu * NWAVES + wave, NGW = G * NWAVES;
        int base = 0;
#define CONV(Wp, gp, K_, N_, Np_, dst) do { const int n_ = ((K_) / 64) * ((Np_) / 32); int first = gw - (base % NGW); if (first < 0) first += NGW; \
            for (int it = first; it < n_; it += NGW) transpose_item(Wp, gp, K_, N_, Np_, (bf16_t*)(ws + (dst)), scr, it, lane); base += n_; } while (0)
        CONV(a.w_in_a, a.norm_mix_g, D, A_IN, A_PAD, WS_WA);
        CONV(a.w_out_a, (const float*)nullptr, D, D, D, WS_WOA);
        CONV(a.w_mlp_up, a.norm_mlp_g, D, FF, FF, WS_WUP0);
        CONV(a.w_mlp_down, (const float*)nullptr, FF, D, D, WS_WDN0);
        CONV(a.w_in_b, a.norm_mix_g + D, D, B_IN, B_IN, WS_WB);
        CONV(a.w_out_b, a.ret_norm_g, 2048, D, D, WS_WOB);
        CONV(a.w_mlp_up + (size_t)D * FF, a.norm_mlp_g + D, D, FF, FF, WS_WUP1);
        CONV(a.w_mlp_down + (size_t)FF * D, (const float*)nullptr, FF, D, D, WS_WDN1);
#undef CONV
        bf16_t* xb = (bf16_t*)(ws + WS_XBHI);
        for (int row = gw; row < T; row += NGW) {
            const f32x4* xr = (const f32x4*)(a.x + (size_t)row * D) + lane; f32x4* hr = (f32x4*)(a.out + (size_t)row * D) + lane; u32x2* xo = (u32x2*)(xb + (size_t)row * D) + lane;
            float s = 0.f;
#pragma unroll
            for (int j = 0; j < 4; ++j) { const f32x4 v = xr[64 * j]; hr[64 * j] = v; xo[64 * j] = pk4(v); s += (v.x * v.x + v.y * v.y) + (v.z * v.z + v.w * v.w); }
            s = wave_sum(s);
            if (lane < 16) ssq[(size_t)row * 16 + lane] = (lane == 0) ? s : 0.f;
        }
        const int gt = vcu * NTHREADS + tid, NGT = G * NTHREADS;
        f32x2* tabA = (f32x2*)(ws + WS_TABA); f32x2* tabI = (f32x2*)(ws + WS_TABI); f32x2* tabR = (f32x2*)(ws + WS_TABR);
        for (int i = gt; i < SEQ * 152; i += NGT) {
            const int p = i / 152, r = i % 152; double inv; f32x2* dst;
            if (r < 16) { inv = pow(500000.0, -(double)r / 16.0); dst = tabA + p * 16 + r; }
            else if (r < 24) { inv = pow(500000.0, -(double)(r - 16) / 8.0); dst = tabI + p * 8 + (r - 16); }
            else { inv = pow(10000.0, -(double)(r - 24) / 128.0); dst = tabR + p * 128 + (r - 24); }
            const double ang = (double)p * inv; f32x2 cs; cs.x = (float)cos(ang); cs.y = (float)sin(ang); *dst = cs;
        }
    }

#ifdef GEMM_NAIVE
#define RUN_GEMM(EPI, SWAPV, g, E) do { pg8::StaticOrder S_; S_.init((g).M, (g).N, G, bx); pg8::gemm_naive<EPI, pg8::StaticOrder, SWAPV>(g, S_, E); } while (0)
#else
#define RUN_GEMM(EPI, SWAPV, g, E) do { pg8::StaticOrder S_; S_.init((g).M, (g).N, G, bx); pg8::gemm_phase<EPI, pg8::StaticOrder, true, true, SWAPV>(lds, g, S_, E); } while (0)
#endif

    if (IN(PH_GEMM_A)) {
        pg8::Gemm g{(const bf16_t*)(ws + WS_XBHI), (const bf16_t*)(ws + WS_WA), T, A_PAD, D};
        EpiA E{ssq, a.pos, (const f32x2*)(ws + WS_TABA), (const f32x2*)(ws + WS_TABI), (bf16_t*)(ws + WS_Q), (bf16_t*)(ws + WS_K), (bf16_t*)(ws + WS_V), (bf16_t*)(ws + WS_QI), (bf16_t*)(ws + WS_KI), (float*)(ws + WS_WI)};
        RUN_GEMM(EpiA, false, g, E);
    }
    if (IN(PH_OUT_A)) {
        pg8::Gemm g{(const bf16_t*)(ws + WS_O), (const bf16_t*)(ws + WS_WOA), T, D, D};
        EpiResid E{a.out, (bf16_t*)(ws + WS_XBHI), ssq};
        RUN_GEMM(EpiResid, false, g, E);
    }
    if (IN(PH_UP0)) {
        pg8::Gemm g{(const bf16_t*)(ws + WS_XBHI), (const bf16_t*)(ws + WS_WUP0), T, FF, D};
        EpiUp E{ssq, (bf16_t*)(ws + WS_HID0)};
        RUN_GEMM(EpiUp, false, g, E);
    }
    if (IN(PH_DOWN0)) {
        pg8::Gemm g{(const bf16_t*)(ws + WS_HID0), (const bf16_t*)(ws + WS_WDN0), T, D, FF};
        EpiResid E{a.out, (bf16_t*)(ws + WS_XBHI), ssq};
        RUN_GEMM(EpiResid, false, g, E);
    }
    if (IN(PH_GEMM_B)) {
        { pg8::Gemm g{(const bf16_t*)(ws + WS_XBHI), (const bf16_t*)(ws + WS_WB), T, 2048, D};
          EpiBqk E{ssq, a.pos, (const f32x2*)(ws + WS_TABR), (bf16_t*)(ws + WS_Q1), (bf16_t*)(ws + WS_K1)};
          RUN_GEMM(EpiBqk, false, g, E); }
        { pg8::Gemm g{(const bf16_t*)(ws + WS_XBHI), (const bf16_t*)(ws + WS_WB) + (size_t)2048 * D, T, 2048, D};
          EpiBv E{ssq, (bf16_t*)(ws + WS_VT)};
          RUN_GEMM(EpiBv, true, g, E); }
    }
    if (IN(PH_XB2)) {
        const int gw = vcu * NWAVES + wave, NGW = G * NWAVES; bf16_t* xb = (bf16_t*)(ws + WS_XBLO);
        for (int row = gw; row < T; row += NGW) {
            const f32x4* hr = (const f32x4*)(a.out + (size_t)row * D) + lane; u32x2* xo = (u32x2*)(xb + (size_t)row * D) + lane;
#pragma unroll
            for (int j = 0; j < 4; ++j) xo[64 * j] = pk4(hr[64 * j]);
        }
    }
    if (IN(PH_GATE)) {
        pg8::Gemm g{(const bf16_t*)(ws + WS_XBLO), (const bf16_t*)(ws + WS_WB) + (size_t)4096 * D, T, 2048, D};
        EpiGate E{ssq, (const float*)(ws + WS_STATS), (bf16_t*)(ws + WS_Y)};
        RUN_GEMM(EpiGate, false, g, E);
    }
    if (IN(PH_OUT_B)) {
        pg8::Gemm g{(const bf16_t*)(ws + WS_Y), (const bf16_t*)(ws + WS_WOB), T, D, 2048};
        EpiResid E{a.out, (bf16_t*)(ws + WS_XBLO), ssq};
        RUN_GEMM(EpiResid, false, g, E);
    }
    if (IN(PH_UP1)) {
        pg8::Gemm g{(const bf16_t*)(ws + WS_XBLO), (const bf16_t*)(ws + WS_WUP1), T, FF, D};
        EpiUp E{ssq, (bf16_t*)(ws + WS_HID1)};
        RUN_GEMM(EpiUp, false, g, E);
    }
    if (IN(PH_DOWN1)) {
        pg8::Gemm g{(const bf16_t*)(ws + WS_HID1), (const bf16_t*)(ws + WS_WDN1), T, D, FF};
        EpiResid E{a.out, (bf16_t*)(ws + WS_XBLO), ssq};
        RUN_GEMM(EpiResid, false, g, E);
    }
    if (IN(PH_FINAL)) {
        const int gw = vcu * NWAVES + wave, NGW = G * NWAVES;
        for (int row = gw; row < T; row += NGW) {
            const float rs = row_rstd(ssq, row);
            f32x4* hr = (f32x4*)(a.out + (size_t)row * D) + lane; const f32x4* gr = (const f32x4*)a.final_norm_g + lane;
#pragma unroll
            for (int j = 0; j < 4; ++j) hr[64 * j] = hr[64 * j] * rs * gr[64 * j];
        }
    }
#undef IN
}

__device__ __forceinline__ unsigned okey(float f) { const unsigned u = __float_as_uint(f); return (u & 0x80000000u) ? ~u : (u | 0x80000000u); }

__device__ __forceinline__ int block_sum_256(int v, int* red) {
    for (int o = 1; o < 64; o <<= 1) v += __shfl_xor(v, o);
    __syncthreads();
    if ((threadIdx.x & 63) == 0) red[threadIdx.x >> 6] = v;
    __syncthreads();
    return red[0] + red[1] + red[2] + red[3];
}

__global__ void __launch_bounds__(256) k_dsa_simple(const bf16_t* __restrict__ q, const bf16_t* __restrict__ k, const bf16_t* __restrict__ v, const bf16_t* __restrict__ qi, const bf16_t* __restrict__ ki,
                                                    const float* __restrict__ wi, bf16_t* __restrict__ o) {
    __shared__ float s_qi[512]; __shared__ float s_w[8]; __shared__ unsigned s_key[SEQ]; __shared__ int s_sel[TOPK]; __shared__ float s_q[1024]; __shared__ float s_p[8][TOPK];
    __shared__ int s_red[4]; __shared__ int s_cnt; __shared__ float s_mx[8], s_sm[8];
    const int tid = threadIdx.x;
    for (int tok = blockIdx.x; tok < T; tok += gridDim.x) {
        const int b = tok / SEQ, t = tok % SEQ; const int n = t + 1;
        __syncthreads();
        for (int i = tid; i < 512; i += 256) s_qi[i] = bf2f(qi[(size_t)tok * 512 + i]);
        for (int i = tid; i < 1024; i += 256) s_q[i] = bf2f(q[(size_t)tok * 1024 + i]);
        if (tid < 8) s_w[tid] = wi[(size_t)tok * 8 + tid];
        if (tid == 0) s_cnt = 0;
        __syncthreads();
        if (n <= TOPK) {
            s_sel[tid] = (tid < n) ? tid : -1;
        } else {
            for (int j = tid; j < n; j += 256) {
                const bf16_t* kr = ki + ((size_t)b * SEQ + j) * 64; float kv[64];
#pragma unroll
                for (int d = 0; d < 64; ++d) kv[d] = bf2f(kr[d]);
                float sc = 0.f;
#pragma unroll
                for (int h = 0; h < 8; ++h) { float dsum = 0.f;
#pragma unroll
                    for (int d = 0; d < 64; ++d) dsum += s_qi[h * 64 + d] * kv[d];
                    sc += fmaxf(dsum, 0.f) * s_w[h]; }
                s_key[j] = okey(sc);
            }
            __syncthreads();
            unsigned lo_ = 0u, hi_ = 0xFFFFFFFFu, thr = 0u; bool exact = false;
            for (;;) {
                const unsigned mid = lo_ + ((hi_ - lo_) >> 1);
                int c = 0; for (int j = tid; j < n; j += 256) c += (s_key[j] > mid) ? 1 : 0;
                c = block_sum_256(c, s_red);
                if (c == TOPK) { thr = mid; exact = true; break; }
                if (c < TOPK) hi_ = mid; else lo_ = mid + 1u;
                if (lo_ == hi_) { thr = lo_; break; }
            }
            for (int j = tid; j < n; j += 256) if (s_key[j] > thr) { const int p = atomicAdd(&s_cnt, 1); s_sel[p] = j; }
            __syncthreads();
            if (!exact && tid == 0) { int c = s_cnt; for (int j = 0; j < n && c < TOPK; ++j) if (s_key[j] == thr) s_sel[c++] = j; s_cnt = c; }
            __syncthreads();
        }
        __syncthreads();
        { const int j = s_sel[tid];
          if (j >= 0) { const bf16_t* kr = k + ((size_t)b * SEQ + j) * 128; float acc8[8];
#pragma unroll
              for (int h = 0; h < 8; ++h) acc8[h] = 0.f;
              for (int d = 0; d < 128; ++d) { const float kd = bf2f(kr[d]);
#pragma unroll
                  for (int h = 0; h < 8; ++h) acc8[h] += s_q[h * 128 + d] * kd; }
#pragma unroll
              for (int h = 0; h < 8; ++h) s_p[h][tid] = acc8[h];
          } else {
#pragma unroll
              for (int h = 0; h < 8; ++h) s_p[h][tid] = -INFINITY; } }
        __syncthreads();
        { const int w = tid >> 6, l = tid & 63;
          for (int h = w * 2; h < w * 2 + 2; ++h) { float m = -INFINITY; for (int j = l; j < TOPK; j += 64) m = fmaxf(m, s_p[h][j]);
              for (int off = 1; off < 64; off <<= 1) m = fmaxf(m, __shfl_xor(m, off));
              float s = 0.f; for (int j = l; j < TOPK; j += 64) { const float e = exp2f(s_p[h][j] - m); s_p[h][j] = e; s += e; }
              s = wave_sum(s); if (l == 0) { s_mx[h] = m; s_sm[h] = s; } } }
        __syncthreads();
        { const int d = tid & 127, hh = (tid >> 7) * 4; float a0 = 0.f, a1 = 0.f, a2 = 0.f, a3 = 0.f;
          for (int jj = 0; jj < TOPK; ++jj) { const int j = s_sel[jj]; if (j < 0) continue; const float vv = bf2f(v[((size_t)b * SEQ + j) * 128 + d]);
              a0 += s_p[hh][jj] * vv; a1 += s_p[hh + 1][jj] * vv; a2 += s_p[hh + 2][jj] * vv; a3 += s_p[hh + 3][jj] * vv; }
          bf16_t* orow = o + (size_t)tok * 1024;
          orow[(hh + 0) * 128 + d] = (bf16_t)f2bf(a0 / s_sm[hh]); orow[(hh + 1) * 128 + d] = (bf16_t)f2bf(a1 / s_sm[hh + 1]);
          orow[(hh + 2) * 128 + d] = (bf16_t)f2bf(a2 / s_sm[hh + 2]); orow[(hh + 3) * 128 + d] = (bf16_t)f2bf(a3 / s_sm[hh + 3]); }
    }
}

constexpr int DSPLIT = 4;
__global__ void __launch_bounds__(256) k_ret_simple(const bf16_t* __restrict__ q1, const bf16_t* __restrict__ k1, const bf16_t* __restrict__ vT, bf16_t* __restrict__ y) {
    const int bh = blockIdx.x >> 3, eb = blockIdx.x & 7, b = bh >> 2, h = bh & 3;
    const int e = eb * 64 + (threadIdx.x & 63), dq = __builtin_amdgcn_readfirstlane(threadIdx.x >> 6);
    const float gamma = 1.0f - exp2f(-5.0f - (float)h);
    float Sst[64];
#pragma unroll
    for (int d = 0; d < 64; ++d) Sst[d] = 0.f;
    __shared__ float s_part[4][64];
    const bf16_t* vrow = vT + ((size_t)(b * 4 + h) * 512 + e) * SEQ;
    for (int t0 = 0; t0 < SEQ; t0 += 8) {
        const bf16x8 v8 = *(const bf16x8*)(vrow + t0);
#pragma unroll
        for (int tt = 0; tt < 8; ++tt) {
            const size_t row = (size_t)b * SEQ + t0 + tt;
            const bf16_t* qr = q1 + row * 1024 + h * 256 + dq * 64; const bf16_t* kr = k1 + row * 1024 + h * 256 + dq * 64;
            const float vv = bf2f((bf16_t)v8[tt]); float o = 0.f;
#pragma unroll
            for (int d = 0; d < 64; ++d) { Sst[d] = gamma * Sst[d] + bf2f(kr[d]) * vv; o += bf2f(qr[d]) * Sst[d]; }
            s_part[dq][threadIdx.x & 63] = o;
            __syncthreads();
            if (dq == 0) { const int l = threadIdx.x; const float tot = (s_part[0][l] + s_part[1][l]) + (s_part[2][l] + s_part[3][l]); y[row * 2048 + h * 512 + e] = (bf16_t)f2bf(tot); }
            __syncthreads();
        }
    }
}
__global__ void __launch_bounds__(256) k_stats_simple(const bf16_t* __restrict__ y, float* __restrict__ stats) {
    const int i = blockIdx.x * 256 + threadIdx.x; if (i >= T * 32) return;
    const bf16_t* p = y + (size_t)i * 64; float s = 0.f, q = 0.f;
    for (int e = 0; e < 64; ++e) { const float v = bf2f(p[e]); s += v; q += v * v; }
    stats[(size_t)i * 2] = s; stats[(size_t)i * 2 + 1] = q;
}

extern "C" void kernel_launch(void* const* d_in, const int* in_sizes, int n_in, void* d_out, int out_size, void* d_ws, size_t ws_size, hipStream_t stream) {
    static int grid = 0;
    if (grid == 0) {
        if (n_in != 12 || out_size != T * D || ws_size < WS_END) { fprintf(stderr, "kernel_launch: unexpected shapes (n_in %d out %d ws %zu)\n", n_in, out_size, ws_size); grid = -1; return; }
        int dev = 0, cus = 0;
        if (hipGetDevice(&dev) != hipSuccess || hipDeviceGetAttribute(&cus, hipDeviceAttributeMultiprocessorCount, dev) != hipSuccess) { grid = -1; return; }
        if (hipFuncSetAttribute((const void*)mk_fwd, hipFuncAttributeMaxDynamicSharedMemorySize, LDS_BYTES) != hipSuccess) { fprintf(stderr, "kernel_launch: hipFuncSetAttribute failed\n"); grid = -1; return; }
        (void)hipGetLastError();
        grid = cus;
    }
    if (grid < 0) return;
    unsigned char* ws = (unsigned char*)d_ws;
    Args a{};
    a.x = (const float*)d_in[0]; a.pos = (const int*)d_in[1]; a.norm_mix_g = (const float*)d_in[2]; a.norm_mlp_g = (const float*)d_in[3]; a.w_in_a = (const float*)d_in[4]; a.w_out_a = (const float*)d_in[5];
    a.w_in_b = (const float*)d_in[6]; a.ret_norm_g = (const float*)d_in[7]; a.w_out_b = (const float*)d_in[8]; a.w_mlp_up = (const float*)d_in[9]; a.w_mlp_down = (const float*)d_in[10]; a.final_norm_g = (const float*)d_in[11];
    a.out = (float*)d_out; a.ws = ws;
    for (int ph = 0; ph < PH_COUNT; ++ph) {
        if (ph == PH_DSA) {
            k_dsa_simple<<<2048, 256, 0, stream>>>((const bf16_t*)(ws + WS_Q), (const bf16_t*)(ws + WS_K), (const bf16_t*)(ws + WS_V), (const bf16_t*)(ws + WS_QI), (const bf16_t*)(ws + WS_KI), (const float*)(ws + WS_WI), (bf16_t*)(ws + WS_O));
        } else if (ph == PH_R1) {
        } else if (ph == PH_RET) {
            k_ret_simple<<<256, 256, 0, stream>>>((const bf16_t*)(ws + WS_Q1), (const bf16_t*)(ws + WS_K1), (const bf16_t*)(ws + WS_VT), (bf16_t*)(ws + WS_Y));
            k_stats_simple<<<(T * 32) / 256, 256, 0, stream>>>((const bf16_t*)(ws + WS_Y), (float*)(ws + WS_STATS));
        } else {
            a.ph_lo = ph; a.ph_hi = ph + 1;
            hipLaunchKernelGGL(mk_fwd, dim3(grid), dim3(NTHREADS), LDS_BYTES, stream, a);
        }
    }
}
```

```cpp
#include <hip/hip_runtime.h>
#include <hip/hip_cooperative_groups.h>
#include <cstdio>
#include <cstdint>
namespace cg = cooperative_groups;

#define LAS __attribute__((address_space(3)))
#define GAS __attribute__((address_space(1)))
typedef unsigned short bf16_t;
typedef short bf16x8 __attribute__((ext_vector_type(8)));
typedef float f32x4 __attribute__((ext_vector_type(4)));
typedef float f32x2 __attribute__((ext_vector_type(2)));
typedef unsigned u32x4 __attribute__((ext_vector_type(4)));
typedef unsigned u32x2 __attribute__((ext_vector_type(2)));

constexpr int NB = 8, SEQ = 4096, T = NB * SEQ, D = 1024, FF = 4096;
constexpr int A_IN = 1864, A_PAD = 2048, B_IN = 6144;
constexpr int TOPK = 256;
constexpr float EPS = 1e-6f;
constexpr float QSCALE = 0.08838834764831845f * 1.4426950408889634f;

constexpr size_t MiB = 1u << 20;
constexpr size_t WS_CTL = 0, CTL_ZERO_BYTES = 1 * MiB;
constexpr size_t WS_SSQ = 1 * MiB;
constexpr size_t WS_WI = 3 * MiB;
constexpr size_t WS_TABA = 4 * MiB;
constexpr size_t WS_TABI = 4 * MiB + 512 * 1024;
constexpr size_t WS_TABR = 5 * MiB;
constexpr size_t WS_STATS = 9 * MiB;
constexpr size_t WS_WA = 26 * MiB, WS_WOA = 30 * MiB, WS_WUP0 = 32 * MiB, WS_WDN0 = 40 * MiB, WS_WB = 48 * MiB, WS_WOB = 60 * MiB, WS_WUP1 = 64 * MiB, WS_WDN1 = 72 * MiB;
constexpr size_t WS_Q = 80 * MiB, WS_K = 144 * MiB, WS_V = 152 * MiB, WS_QI = 160 * MiB, WS_KI = 192 * MiB, WS_SEL = 196 * MiB, WS_O = 212 * MiB;
constexpr size_t WS_HID0 = 80 * MiB, WS_XBHI = 448 * MiB;
constexpr size_t WS_Q1 = 80 * MiB, WS_K1 = 144 * MiB, WS_VT = 208 * MiB, WS_INNER = 336 * MiB, WS_Y = 384 * MiB, WS_XBLO = 80 * MiB, WS_HID1 = 144 * MiB;
constexpr size_t WS_END = 512 * MiB;

__device__ __forceinline__ float bf2f(bf16_t v) { return __uint_as_float((unsigned)v << 16); }
__device__ __forceinline__ unsigned f2bf(float f) { unsigned u = __float_as_uint(f); return (u + 0x7fffu + ((u >> 16) & 1u)) >> 16; }
__device__ __forceinline__ unsigned pk2(float lo, float hi) { return f2bf(lo) | (f2bf(hi) << 16); }
__device__ __forceinline__ u32x2 pk4(f32x4 v) { u32x2 r; r.x = pk2(v.x, v.y); r.y = pk2(v.z, v.w); return r; }
__device__ __forceinline__ float wave_sum(float v) {
#pragma unroll
    for (int o = 1; o < 64; o <<= 1) v += __shfl_xor(v, o);
    return v;
}
__device__ __forceinline__ float row_rstd(const float* ssq16, int row) {
    const f32x4* p = (const f32x4*)(ssq16 + (size_t)row * 16);
    const f32x4 a = p[0], b = p[1], c = p[2], d = p[3];
    const float s = (((a.x + a.y) + (a.z + a.w)) + ((b.x + b.y) + (b.z + b.w))) + (((c.x + c.y) + (c.z + c.w)) + ((d.x + d.y) + (d.z + d.w)));
    return rsqrtf(s * (1.0f / 1024.0f) + EPS);
}

namespace pg8 {
#define PG8_LAS __attribute__((address_space(3)))
constexpr int BM = 256, BK = 64, HALF = 128, HTB = HALF * BK * 2, STAGE_BYTES = 8 * HTB, NXCD = 8, WGM = 8;
__host__ __device__ __forceinline__ int lds_byte(int r, int c) { const int st = (r >> 4) * 2 + (c >> 5), rr = r & 15, cc = c & 31, ob = rr * 64 + cc * 2; return st * 1024 + (ob ^ (((ob >> 9) & 1) << 5)); }
__host__ __device__ __forceinline__ void stage_rc(int b, int& R, int& C) { const int st = b / 1024, sb = b % 1024, swz = sb ^ (((sb >> 9) & 1) << 5); R = (st >> 1) * 16 + swz / 64; C = (st & 1) * 32 + (swz % 64) / 2; }
__host__ __device__ __forceinline__ int perm32(int rho) { const int n = rho >> 4, i = rho & 15; return 8 * (i >> 2) + 4 * n + (i & 3); }
struct Unit { int pm, pn; };
struct Gemm { const bf16_t* A; const bf16_t* Bt; int M, N, K; };
struct StaticOrder {
    int nM, nN, nwg, G, c;
    __host__ __device__ void init(int M, int N, int G_, int c_) { nM = M / BM; nN = N / BM; nwg = nM * nN; G = G_; c = c_; }
    __host__ __device__ bool next(int i, Unit& u) const {
        const long L = (long)i * G + c; if (L >= nwg) return false;
        int wgid = (int)L; { const int q = nwg / NXCD, r = nwg % NXCD, xcd = wgid % NXCD, off = wgid / NXCD; wgid = (xcd < r ? xcd * (q + 1) : r * (q + 1) + (xcd - r) * q) + off; }
        const int nig = WGM * nN, gid = wgid / nig, fm = gid * WGM, gsz = (nM - fm) < WGM ? (nM - fm) : WGM;
        u.pm = fm + ((wgid % nig) % gsz); u.pn = (wgid % nig) / gsz; return true;
    }
    __device__ __forceinline__ void a_ready(const Unit&) const {}
    __device__ __forceinline__ void done(const Unit&) const {}
};

template <class Epi, class Sched, bool ALIGN_EPI, bool SP2, bool SWAP>
__device__ __forceinline__ void gemm_phase(PG8_LAS unsigned char* lds, const Gemm g, const Sched& S, const Epi& E) {
    const int tid = threadIdx.x, wid = __builtin_amdgcn_readfirstlane(tid >> 6), lane = tid & 63, wr = wid >> 2, wc = wid & 3, fr = lane & 15, fq = lane >> 4;
    const int K = g.K, nt = K / BK;
    unsigned voffA[2], voffB[2];
#pragma unroll
    for (int i = 0; i < 2; ++i) { int R, C; stage_rc(tid * 16 + i * 8192, R, C); const int Rb = Epi::PERM ? ((R & ~31) + perm32(R & 31)) : R;
        voffA[i] = (unsigned)(R * K + C) * 2u; voffB[i] = (unsigned)(Rb * K + C) * 2u; }
    const size_t kstep = (size_t)(BK * 2);
    const size_t hstep = (size_t)HALF * K * 2;
    const size_t tstep = 2 * hstep;
    const unsigned ldsw = (unsigned)wid * 1024u;
    const int aoff = lds_byte(wr * 64 + fr, fq * 8), boff = lds_byte(wc * 32 + fr, fq * 8);
#define PG8_SA(b, h) (((b) * 2 + (h)) * HTB)
#define PG8_SB(b, h) ((4 + (b) * 2 + (h)) * HTB)
#define PG8_STAGE(bufoff, gbase, voff) do { _Pragma("unroll") for (int _i = 0; _i < 2; ++_i) \
        __builtin_amdgcn_global_load_lds((const unsigned*)((const char*)(gbase) + (voff)[_i]), (PG8_LAS unsigned*)(lds + (bufoff) + ldsw + _i * 8192), 16, 0, 0); } while (0)
#define PG8_LDA(dst, b, h) do { _Pragma("unroll") for (int m = 0; m < 4; ++m) _Pragma("unroll") for (int k = 0; k < 2; ++k) dst[m][k] = *(const PG8_LAS bf16x8*)(lds + PG8_SA(b, h) + aoff + m * 2048 + k * 1024); } while (0)
#define PG8_LDB(dst, b, h) do { _Pragma("unroll") for (int n = 0; n < 2; ++n) _Pragma("unroll") for (int k = 0; k < 2; ++k) dst[n][k] = *(const PG8_LAS bf16x8*)(lds + PG8_SB(b, h) + boff + n * 2048 + k * 1024); } while (0)
#define PG8_MMA(ai, bj, At, Bt) do { __builtin_amdgcn_s_setprio(1); _Pragma("unroll") for (int m = 0; m < 4; ++m) _Pragma("unroll") for (int n = 0; n < 2; ++n) _Pragma("unroll") for (int k = 0; k < 2; ++k) { \
        if constexpr (SWAP) acc[ai][bj][m][n] = __builtin_amdgcn_mfma_f32_16x16x32_bf16(At[m][k], Bt[n][k], acc[ai][bj][m][n], 0, 0, 0); \
        else acc[ai][bj][m][n] = __builtin_amdgcn_mfma_f32_16x16x32_bf16(Bt[n][k], At[m][k], acc[ai][bj][m][n], 0, 0, 0); } __builtin_amdgcn_s_setprio(0); } while (0)
#define PG8_WAIT_V(n) asm volatile("s_waitcnt vmcnt(" #n ")" ::: "memory")
#define PG8_WAIT_L(n) asm volatile("s_waitcnt lgkmcnt(" #n ")" ::: "memory")
#define PG8_BAR __builtin_amdgcn_s_barrier()
#define PG8_SCHED __builtin_amdgcn_sched_barrier(0)
    Unit cur, nxt; int ui = 0;
    if (!S.next(0, cur)) return;
    f32x4 acc[2][2][4][2];
#pragma unroll
    for (int a = 0; a < 2; ++a)
#pragma unroll
        for (int b = 0; b < 2; ++b)
#pragma unroll
            for (int m = 0; m < 4; ++m)
#pragma unroll
                for (int n = 0; n < 2; ++n) acc[a][b][m][n] = (f32x4){0.f, 0.f, 0.f, 0.f};
    bf16x8 At[4][2], B0[2][2], B1[2][2];
    const char* cA = (const char*)g.A + (size_t)cur.pm * tstep; const char* cB = (const char*)g.Bt + (size_t)cur.pn * tstep;
    S.a_ready(cur);
    if constexpr (SP2) {
        PG8_STAGE(PG8_SB(0, 0), cB, voffB); PG8_STAGE(PG8_SB(0, 1), cB + hstep, voffB); PG8_STAGE(PG8_SA(0, 0), cA, voffA); PG8_STAGE(PG8_SA(0, 1), cA + hstep, voffA);
        if (wr == 1) PG8_BAR;
        PG8_WAIT_V(2); PG8_BAR;
        PG8_STAGE(PG8_SB(1, 0), cB + kstep, voffB); PG8_STAGE(PG8_SA(1, 0), cA + kstep, voffA); PG8_STAGE(PG8_SB(1, 1), cB + hstep + kstep, voffB);
        PG8_WAIT_V(6); PG8_BAR;
    } else {
        PG8_STAGE(PG8_SB(0, 0), cB, voffB); PG8_STAGE(PG8_SA(0, 0), cA, voffA); PG8_STAGE(PG8_SB(0, 1), cB + hstep, voffB); PG8_STAGE(PG8_SA(0, 1), cA + hstep, voffA);
        if (wr == 1) PG8_BAR;
        PG8_WAIT_V(4); PG8_BAR;
        PG8_STAGE(PG8_SB(1, 0), cB + kstep, voffB); PG8_STAGE(PG8_SA(1, 0), cA + kstep, voffA); PG8_STAGE(PG8_SB(1, 1), cB + hstep + kstep, voffB);
        PG8_WAIT_V(6); PG8_BAR;
    }
    for (;;) {
        const bool has_next = S.next(ui + 1, nxt);
        const char* nA = has_next ? (const char*)g.A + (size_t)nxt.pm * tstep : cA; const char* nB = has_next ? (const char*)g.Bt + (size_t)nxt.pn * tstep : cB;
        for (int t = 0; t < nt; t += 2) {
            const bool last = (t == nt - 2);
            const char* a1 = cA + (size_t)(t + 1) * kstep;
            const char* a2 = last ? nA : cA + (size_t)(t + 2) * kstep; const char* b2 = last ? nB : cB + (size_t)(t + 2) * kstep;
            const char* a3 = a2 + kstep; const char* b3 = b2 + kstep;
            if (last && has_next) S.a_ready(nxt);
            if constexpr (SP2) {
            PG8_LDB(B0, 0, 0); PG8_LDB(B1, 0, 1); PG8_SCHED; PG8_LDA(At, 0, 0); PG8_STAGE(PG8_SA(1, 1), a1 + hstep, voffA);
            PG8_WAIT_V(8); PG8_WAIT_L(0); PG8_BAR; PG8_MMA(0, 0, At, B0); PG8_MMA(0, 1, At, B1); PG8_BAR; PG8_SCHED;
            PG8_LDA(At, 0, 1); PG8_STAGE(PG8_SB(0, 0), b2, voffB); PG8_STAGE(PG8_SB(0, 1), b2 + hstep, voffB); PG8_STAGE(PG8_SA(0, 0), a2, voffA);
            PG8_WAIT_V(8); PG8_WAIT_L(0); PG8_BAR; PG8_MMA(1, 0, At, B0); PG8_MMA(1, 1, At, B1); PG8_BAR; PG8_SCHED;
            PG8_LDB(B0, 1, 0); PG8_LDB(B1, 1, 1); PG8_SCHED; PG8_LDA(At, 1, 0); PG8_STAGE(PG8_SA(0, 1), a2 + hstep, voffA);
            PG8_WAIT_V(8); PG8_WAIT_L(0); PG8_BAR; PG8_MMA(0, 0, At, B0); PG8_MMA(0, 1, At, B1); PG8_BAR; PG8_SCHED;
            PG8_LDA(At, 1, 1); PG8_STAGE(PG8_SB(1, 0), b3, voffB); PG8_STAGE(PG8_SB(1, 1), b3 + hstep, voffB); PG8_STAGE(PG8_SA(1, 0), a3, voffA);
            PG8_WAIT_V(8); PG8_WAIT_L(0); PG8_BAR; PG8_MMA(1, 0, At, B0); PG8_MMA(1, 1, At, B1); PG8_BAR; PG8_SCHED;
            } else {
            PG8_LDB(B0, 0, 0); PG8_SCHED; PG8_LDA(At, 0, 0); PG8_STAGE(PG8_SA(1, 1), a1 + hstep, voffA);
            PG8_WAIT_L(8); PG8_BAR; PG8_WAIT_L(0); PG8_MMA(0, 0, At, B0); PG8_BAR; PG8_SCHED;
            PG8_LDB(B1, 0, 1); PG8_STAGE(PG8_SB(0, 0), b2, voffB);
            PG8_BAR; PG8_WAIT_L(0); PG8_MMA(0, 1, At, B1); PG8_BAR;
            PG8_LDA(At, 0, 1); PG8_STAGE(PG8_SA(0, 0), a2, voffA);
            PG8_BAR; PG8_WAIT_L(0); PG8_MMA(1, 0, At, B0); PG8_BAR; PG8_SCHED;
            PG8_STAGE(PG8_SB(0, 1), b2 + hstep, voffB);
            PG8_WAIT_V(6); PG8_BAR; PG8_MMA(1, 1, At, B1); PG8_BAR;
            PG8_LDB(B0, 1, 0); PG8_SCHED; PG8_LDA(At, 1, 0); PG8_STAGE(PG8_SA(0, 1), a2 + hstep, voffA);
            PG8_WAIT_L(8); PG8_BAR; PG8_WAIT_L(0); PG8_MMA(0, 0, At, B0); PG8_BAR; PG8_SCHED;
            PG8_LDB(B1, 1, 1); PG8_STAGE(PG8_SB(1, 0), b3, voffB);
            PG8_BAR; PG8_WAIT_L(0); PG8_MMA(0, 1, At, B1); PG8_BAR;
            PG8_LDA(At, 1, 1); PG8_STAGE(PG8_SA(1, 0), a3, voffA);
            PG8_BAR; PG8_WAIT_L(0); PG8_MMA(1, 0, At, B0); PG8_BAR; PG8_SCHED;
            PG8_STAGE(PG8_SB(1, 1), b3 + hstep, voffB);
            PG8_WAIT_V(6); PG8_BAR; PG8_MMA(1, 1, At, B1); PG8_BAR;
            }
        }
        if constexpr (ALIGN_EPI) { if (wr == 0) PG8_BAR; }
        E(acc, cur, wr, wc, fr, fq); S.done(cur);
        if (!has_next) break;
#pragma unroll
        for (int a = 0; a < 2; ++a)
#pragma unroll
            for (int b = 0; b < 2; ++b)
#pragma unroll
                for (int m = 0; m < 4; ++m)
#pragma unroll
                    for (int n = 0; n < 2; ++n) acc[a][b][m][n] = (f32x4){0.f, 0.f, 0.f, 0.f};
        cur = nxt; cA = nA; cB = nB; ++ui;
        if constexpr (ALIGN_EPI) { if (wr == 1) PG8_BAR; }
    }
    PG8_WAIT_V(0);
    if constexpr (!ALIGN_EPI) { if (wr == 0) PG8_BAR; }
    PG8_BAR;
#undef PG8_SA
#undef PG8_SB
#undef PG8_STAGE
#undef PG8_LDA
#undef PG8_LDB
#undef PG8_MMA
#undef PG8_WAIT_V
#undef PG8_WAIT_L
#undef PG8_BAR
#undef PG8_SCHED
}

template <class Epi, class Sched, bool SWAP>
__device__ __forceinline__ void gemm_naive(const Gemm g, const Sched& S, const Epi& E) {
    const int tid = threadIdx.x, wid = tid >> 6, lane = tid & 63, wr = wid >> 2, wc = wid & 3, fr = lane & 15, fq = lane >> 4;
    Unit u;
    for (int i = 0; S.next(i, u); ++i) {
        f32x4 acc[2][2][4][2];
#pragma unroll 1
        for (int ai = 0; ai < 2; ++ai)
#pragma unroll 1
            for (int bj = 0; bj < 2; ++bj)
#pragma unroll 1
                for (int m = 0; m < 4; ++m)
#pragma unroll 1
                    for (int n = 0; n < 2; ++n) {
                        f32x4 r;
#pragma unroll 1
                        for (int e = 0; e < 4; ++e) {
                            int row, col;
                            if (SWAP) { row = u.pm * 256 + ai * 128 + wr * 64 + m * 16 + 4 * fq + e; col = u.pn * 256 + bj * 128 + wc * 32 + n * 16 + fr; }
                            else { row = u.pm * 256 + ai * 128 + wr * 64 + m * 16 + fr; col = u.pn * 256 + bj * 128 + wc * 32 + n * 16 + 4 * fq + e; }
                            const bf16x8* a = (const bf16x8*)(g.A + (size_t)row * g.K); const bf16x8* b = (const bf16x8*)(g.Bt + (size_t)col * g.K);
                            float s = 0.f;
                            for (int k = 0; k < g.K / 8; ++k) { const bf16x8 av = a[k], bv = b[k];
#pragma unroll
                                for (int j = 0; j < 8; ++j) s += bf2f((bf16_t)av[j]) * bf2f((bf16_t)bv[j]); }
                            r[e] = s;
                        }
#pragma unroll
                        for (int a2 = 0; a2 < 2; ++a2)
#pragma unroll
                            for (int b2 = 0; b2 < 2; ++b2)
#pragma unroll
                                for (int m2 = 0; m2 < 4; ++m2)
#pragma unroll
                                    for (int n2 = 0; n2 < 2; ++n2) if (a2 == ai && b2 == bj && m2 == m && n2 == n) acc[a2][b2][m2][n2] = r;
                    }
        E(acc, u, wr, wc, fr, fq);
    }
}
}
using pg8::Unit;

struct EpiA {
    static constexpr bool PERM = false;
    const float* ssq; const int* pos; const f32x2* tabA; const f32x2* tabI;
    bf16_t *q, *k, *v, *qi, *ki; float* wi;
    __device__ __forceinline__ void operator()(const f32x4 (&acc)[2][2][4][2], const Unit& u, int wr, int wc, int fr, int fq) const {
        const int row0 = u.pm * 256 + wr * 64 + fr; const int pn = u.pn;
#pragma unroll
        for (int ai = 0; ai < 2; ++ai)
#pragma unroll
            for (int m = 0; m < 4; ++m) {
                const int row = row0 + ai * 128 + m * 16;
                const float rs = row_rstd(ssq, row);
                int p = pos[row]; p = p < 0 ? 0 : (p > SEQ - 1 ? SEQ - 1 : p);
                if (pn < 4) {
#pragma unroll
                    for (int bj = 0; bj < 2; ++bj) {
                        f32x4 a0 = acc[ai][bj][m][0] * rs, a1 = acc[ai][bj][m][1] * rs;
                        if (wc == 0) { const f32x2* tb = tabA + p * 16 + 4 * fq;
#pragma unroll
                            for (int e = 0; e < 4; ++e) { const f32x2 cs = tb[e]; const float x1 = a0[e], x2 = a1[e]; a0[e] = x1 * cs.x - x2 * cs.y; a1[e] = x2 * cs.x + x1 * cs.y; } }
                        a0 = a0 * QSCALE; a1 = a1 * QSCALE;
                        bf16_t* dst = q + (size_t)row * 1024 + pn * 256 + bj * 128 + wc * 32 + 4 * fq;
                        *(u32x2*)dst = pk4(a0); *(u32x2*)(dst + 16) = pk4(a1);
                    }
                } else if (pn == 4) {
                    { f32x4 a0 = acc[ai][0][m][0] * rs, a1 = acc[ai][0][m][1] * rs;
                      if (wc == 0) { const f32x2* tb = tabA + p * 16 + 4 * fq;
#pragma unroll
                          for (int e = 0; e < 4; ++e) { const f32x2 cs = tb[e]; const float x1 = a0[e], x2 = a1[e]; a0[e] = x1 * cs.x - x2 * cs.y; a1[e] = x2 * cs.x + x1 * cs.y; } }
                      bf16_t* dst = k + (size_t)row * 128 + wc * 32 + 4 * fq; *(u32x2*)dst = pk4(a0); *(u32x2*)(dst + 16) = pk4(a1); }
                    { const f32x4 a0 = acc[ai][1][m][0] * rs, a1 = acc[ai][1][m][1] * rs;
                      bf16_t* dst = v + (size_t)row * 128 + wc * 32 + 4 * fq; *(u32x2*)dst = pk4(a0); *(u32x2*)(dst + 16) = pk4(a1); }
                } else if (pn < 7) {
#pragma unroll
                    for (int bj = 0; bj < 2; ++bj) {
                        f32x4 a0 = acc[ai][bj][m][0] * rs; const f32x4 a1 = acc[ai][bj][m][1] * rs;
                        if ((wc & 1) == 0) { const f32x2* tb = tabI + p * 8 + 4 * (fq & 1);
#pragma unroll
                            for (int e = 0; e < 4; ++e) { const float other = __shfl_xor(a0[e], 32); const f32x2 cs = tb[e]; a0[e] = (fq < 2) ? (a0[e] * cs.x - other * cs.y) : (a0[e] * cs.x + other * cs.y); } }
                        bf16_t* dst = qi + (size_t)row * 512 + (pn - 5) * 256 + bj * 128 + wc * 32 + 4 * fq;
                        *(u32x2*)dst = pk4(a0); *(u32x2*)(dst + 16) = pk4(a1);
                    }
                } else {
                    if (wc < 2) {
                        f32x4 a0 = acc[ai][0][m][0] * rs; const f32x4 a1 = acc[ai][0][m][1] * rs;
                        if (wc == 0) { const f32x2* tb = tabI + p * 8 + 4 * (fq & 1);
#pragma unroll
                            for (int e = 0; e < 4; ++e) { const float other = __shfl_xor(a0[e], 32); const f32x2 cs = tb[e]; a0[e] = (fq < 2) ? (a0[e] * cs.x - other * cs.y) : (a0[e] * cs.x + other * cs.y); } }
                        bf16_t* dst = ki + (size_t)row * 64 + wc * 32 + 4 * fq; *(u32x2*)dst = pk4(a0); *(u32x2*)(dst + 16) = pk4(a1);
                    } else if (wc == 2) {
                        if (fq < 2) { const f32x4 a0 = acc[ai][0][m][0] * (rs * 0.04419417382415922f); *(f32x4*)(wi + (size_t)row * 8 + 4 * fq) = a0; }
                    }
                }
            }
    }
};

struct EpiUp {
    static constexpr bool PERM = false;
    const float* ssq; bf16_t* hid;
    __device__ __forceinline__ void operator()(const f32x4 (&acc)[2][2][4][2], const Unit& u, int wr, int wc, int fr, int fq) const {
        const int row0 = u.pm * 256 + wr * 64 + fr, col0 = u.pn * 256 + wc * 32 + 4 * fq;
#pragma unroll
        for (int ai = 0; ai < 2; ++ai)
#pragma unroll
            for (int m = 0; m < 4; ++m) {
                const int row = row0 + ai * 128 + m * 16; const float rs = row_rstd(ssq, row);
                bf16_t* rowp = hid + (size_t)row * FF + col0;
#pragma unroll
                for (int bj = 0; bj < 2; ++bj)
#pragma unroll
                    for (int n = 0; n < 2; ++n) { f32x4 a = acc[ai][bj][m][n] * rs;
#pragma unroll
                        for (int e = 0; e < 4; ++e) { const float r = fmaxf(a[e], 0.f); a[e] = r * r; }
                        *(u32x2*)(rowp + bj * 128 + n * 16) = pk4(a); }
            }
    }
};

struct EpiResid {
    static constexpr bool PERM = false;
    float* h; bf16_t* xb; float* ssq;
    __device__ __forceinline__ void operator()(const f32x4 (&acc)[2][2][4][2], const Unit& u, int wr, int wc, int fr, int fq) const {
        const int row0 = u.pm * 256 + wr * 64 + fr, col0 = u.pn * 256 + wc * 32 + 4 * fq;
#pragma unroll
        for (int ai = 0; ai < 2; ++ai)
#pragma unroll
            for (int m = 0; m < 4; ++m) {
                const int row = row0 + ai * 128 + m * 16; float s = 0.f;
#pragma unroll
                for (int bj = 0; bj < 2; ++bj)
#pragma unroll
                    for (int n = 0; n < 2; ++n) { const size_t off = (size_t)row * D + col0 + bj * 128 + n * 16;
                        const f32x4 hv = *(const f32x4*)(h + off) + acc[ai][bj][m][n];
                        *(f32x4*)(h + off) = hv; *(u32x2*)(xb + off) = pk4(hv);
                        s += (hv.x * hv.x + hv.y * hv.y) + (hv.z * hv.z + hv.w * hv.w); }
                s += __shfl_xor(s, 16); s += __shfl_xor(s, 32);
                if (fq == 0) ssq[(size_t)row * 16 + u.pn * 4 + wc] = s;
            }
    }
};

struct EpiBqk {
    static constexpr bool PERM = false;
    const float* ssq; const int* pos; const f32x2* tabR; bf16_t *q1, *k1;
    __device__ __forceinline__ void operator()(const f32x4 (&acc)[2][2][4][2], const Unit& u, int wr, int wc, int fr, int fq) const {
        const int row0 = u.pm * 256 + wr * 64 + fr; const bool isk = u.pn >= 4; bf16_t* dstb = isk ? k1 : q1; const float sc = isk ? 0.0625f : 1.0f; const int hd = u.pn & 3;
#pragma unroll
        for (int ai = 0; ai < 2; ++ai)
#pragma unroll
            for (int m = 0; m < 4; ++m) {
                const int row = row0 + ai * 128 + m * 16; const float rs = row_rstd(ssq, row) * sc;
                int p = pos[row]; p = p < 0 ? 0 : (p > SEQ - 1 ? SEQ - 1 : p);
#pragma unroll
                for (int n = 0; n < 2; ++n) { f32x4 x1 = acc[ai][0][m][n] * rs, x2 = acc[ai][1][m][n] * rs; const f32x2* tb = tabR + p * 128 + wc * 32 + n * 16 + 4 * fq;
#pragma unroll
                    for (int e = 0; e < 4; ++e) { const f32x2 cs = tb[e]; const float a = x1[e], b = x2[e]; x1[e] = a * cs.x - b * cs.y; x2[e] = b * cs.x + a * cs.y; }
                    bf16_t* dst = dstb + (size_t)row * 1024 + hd * 256 + wc * 32 + n * 16 + 4 * fq; *(u32x2*)dst = pk4(x1); *(u32x2*)(dst + 128) = pk4(x2); }
            }
    }
};
struct EpiBv {
    static constexpr bool PERM = false;
    const float* ssq; bf16_t* vT;
    __device__ __forceinline__ void operator()(const f32x4 (&acc)[2][2][4][2], const Unit& u, int wr, int wc, int fr, int fq) const {
        const int rowb = u.pm * 256 + wr * 64 + 4 * fq; const int b = u.pm >> 4;
#pragma unroll
        for (int ai = 0; ai < 2; ++ai)
#pragma unroll
            for (int m = 0; m < 4; ++m) {
                const int row = rowb + ai * 128 + m * 16; f32x4 rs;
#pragma unroll
                for (int e = 0; e < 4; ++e) rs[e] = row_rstd(ssq, row + e);
                const int t = row & (SEQ - 1);
#pragma unroll
                for (int bj = 0; bj < 2; ++bj)
#pragma unroll
                    for (int n = 0; n < 2; ++n) { const int c = u.pn * 256 + bj * 128 + wc * 32 + n * 16 + fr;
                        const f32x4 a = acc[ai][bj][m][n] * rs;
                        *(u32x2*)(vT + ((size_t)(b * 4 + (c >> 9)) * 512 + (c & 511)) * SEQ + t) = pk4(a); }
            }
    }
};
struct EpiGate {
    static constexpr bool PERM = false;
    const float* ssq; const float* stats; bf16_t* y;
    __device__ __forceinline__ void operator()(const f32x4 (&acc)[2][2][4][2], const Unit& u, int wr, int wc, int fr, int fq) const {
        const int row0 = u.pm * 256 + wr * 64 + fr, col0 = u.pn * 256 + wc * 32 + 4 * fq; const int hd = u.pn >> 1;
#pragma unroll
        for (int ai = 0; ai < 2; ++ai)
#pragma unroll
            for (int m = 0; m < 4; ++m) {
                const int row = row0 + ai * 128 + m * 16; const float rs = row_rstd(ssq, row);
                const f32x4* sp = (const f32x4*)(stats + ((size_t)row * 4 + hd) * 32);
                float sum = 0.f, sq = 0.f;
#pragma unroll
                for (int i = 0; i < 8; ++i) { const f32x4 sv = sp[i]; sum += sv.x + sv.z; sq += sv.y + sv.w; }
                const float mu = sum * (1.0f / 512.0f); const float var = fmaxf(sq * (1.0f / 512.0f) - mu * mu, 0.f); const float rh = rsqrtf(var + EPS);
                bf16_t* rowp = y + (size_t)row * 2048 + col0;
#pragma unroll
                for (int bj = 0; bj < 2; ++bj)
#pragma unroll
                    for (int n = 0; n < 2; ++n) { const f32x4 g = acc[ai][bj][m][n] * rs; const u32x2 yv = *(const u32x2*)(rowp + bj * 128 + n * 16);
                        f32x4 yf; yf.x = __uint_as_float(yv.x << 16); yf.y = __uint_as_float(yv.x & 0xffff0000u); yf.z = __uint_as_float(yv.y << 16); yf.w = __uint_as_float(yv.y & 0xffff0000u);
                        f32x4 o;
#pragma unroll
                        for (int e = 0; e < 4; ++e) { const float sg = g[e] / (1.0f + __expf(-g[e])); o[e] = sg * (yf[e] - mu) * rh; }
                        *(u32x2*)(rowp + bj * 128 + n * 16) = pk4(o); }
            }
    }
};

constexpr int NWAVES = 8, NTHREADS = NWAVES * 64;
constexpr int RING_BYTES = 131072, LDSCTL_OFF = RING_BYTES, MISC_OFF = LDSCTL_OFF + 320, LDS_BYTES = 147456;

struct Args {
    const float* x; const int* pos; const float* norm_mix_g; const float* norm_mlp_g; const float* w_in_a; const float* w_out_a; const float* w_in_b; const float* ret_norm_g;
    const float* w_out_b; const float* w_mlp_up; const float* w_mlp_down; const float* final_norm_g;
    float* out; unsigned char* ws; int ph_lo, ph_hi, li, pad;
};

#define XB_TMO      128
#define XB_XCNT(j)  (256  + 64 * (j))
#define XB_XSUB(j)  (1280 + 64 * (j))
#define XB_XGEN(j)  (2304 + 64 * (j))
#define XB_TOP      3328
#define XB_TOPGEN   3392
#define XCD_BAR_WORDS 3456
#define XB_SPIN_CAP (1u << 22)
constexpr int CW_BAR = 4096;
__device__ __forceinline__ unsigned xb_ld(unsigned* p)              { return __hip_atomic_load(p, __ATOMIC_RELAXED, __HIP_MEMORY_SCOPE_AGENT); }
__device__ __forceinline__ unsigned xb_add(unsigned* p, unsigned v) { return __hip_atomic_fetch_add(p, v, __ATOMIC_RELAXED, __HIP_MEMORY_SCOPE_AGENT); }
__device__ __forceinline__ unsigned xb_xcc_id() { return (unsigned)__builtin_amdgcn_s_getreg((3 << 11) | 20) & 0xFu; }
#define XB_SPIN(cond, bar) do { unsigned _sp = 0; while (cond) { __builtin_amdgcn_s_sleep(1); \
    if ((++_sp & 255u) == 0u) { if (xb_ld(&(bar)[XB_TMO])) break; if (_sp > XB_SPIN_CAP) { atomicAdd(&(bar)[XB_TMO], 1u); break; } } } } while (0)
struct XcdBarrier { unsigned* bar; unsigned x; volatile LAS unsigned* st; };
__device__ __forceinline__ XcdBarrier xcd_barrier_post(unsigned* bar, volatile LAS unsigned* st) {
    XcdBarrier b; b.bar = bar; b.x = xb_xcc_id(); b.st = st;
    if (threadIdx.x == 0) (void)xb_add(&bar[XB_XCNT(b.x)], 1u);
    return b;
}
__device__ __forceinline__ void xcd_barrier_complete(unsigned* bar, unsigned x, unsigned& nloc, unsigned& nx) {
    const unsigned G = gridDim.x * gridDim.y * gridDim.z;
    unsigned sum, cnt, mine, sp = 0u;
    for (;;) {
        sum = 0u; cnt = 0u; mine = 0u;
#pragma unroll
        for (unsigned j = 0; j < 16; ++j) { const unsigned c = xb_ld(&bar[XB_XCNT(j)]); sum += c; cnt += (c > 0u) ? 1u : 0u; mine = (j == x) ? c : mine; }
        if (sum == G) break;
        __builtin_amdgcn_s_sleep(1);
        if ((++sp & 255u) == 0u) { if (xb_ld(&bar[XB_TMO])) break; if (sp > XB_SPIN_CAP) { atomicAdd(&bar[XB_TMO], 1u); break; } }
    }
    nloc = mine > 0u ? mine : 1u; nx = cnt > 0u ? cnt : 1u;
}
__device__ __forceinline__ void xcd_barrier(const XcdBarrier& b) {
    asm volatile("s_waitcnt vmcnt(0)" ::: "memory");
    __syncthreads();
    if (threadIdx.x == 0) {
        unsigned* bar = b.bar;
        __builtin_amdgcn_s_waitcnt(0);
        unsigned nloc = b.st[0], nx = b.st[1];
        if (nloc == 0u) { xcd_barrier_complete(bar, b.x, nloc, nx); b.st[0] = nloc; b.st[1] = nx; }
        const unsigned old = xb_add(&bar[XB_XSUB(b.x)], 1u);
        const unsigned gen = old / nloc;
        if (old + 1u == (gen + 1u) * nloc) {
            __builtin_amdgcn_fence(__ATOMIC_RELEASE, "agent");
            asm volatile("s_waitcnt vmcnt(0)" ::: "memory");
            const unsigned og = xb_add(&bar[XB_TOP], 1u);
            const unsigned tg = og / nx;
            if (og + 1u == (tg + 1u) * nx) xb_add(&bar[XB_TOPGEN], 1u);
            else XB_SPIN(xb_ld(&bar[XB_TOPGEN]) == tg, bar);
            __builtin_amdgcn_fence(__ATOMIC_ACQUIRE, "agent");
            xb_add(&bar[XB_XGEN(b.x)], 1u);
            asm volatile("s_waitcnt vmcnt(0)" ::: "memory");
        } else {
            XB_SPIN(xb_ld(&bar[XB_XGEN(b.x)]) == gen, bar);
            __builtin_amdgcn_fence(__ATOMIC_ACQUIRE, "agent");
            asm volatile("s_waitcnt vmcnt(0)" ::: "memory");
        }
    }
    __syncthreads();
}

typedef float f32x16 __attribute__((ext_vector_type(16)));
#define MFMA32(a, b, c) __builtin_amdgcn_mfma_f32_32x32x16_bf16((a), (b), (c), 0, 0, 0)
constexpr int ST_STRIDE = 528, ST_BUF = 64 * ST_STRIDE;

enum Phase { PH_PROLOGUE = 0, PH_GEMM_A, PH_DSA, PH_OUT_A, PH_UP0, PH_DOWN0, PH_GEMM_B, PH_R1, PH_RET, PH_XB2, PH_GATE, PH_OUT_B, PH_UP1, PH_DOWN1, PH_FINAL, PH_COUNT };

__device__ __forceinline__ void transpose_item(const float* W, const float* gain, int K, int N, int Npad, bf16_t* WT, LAS float* scr, int item, int lane) {
    const int nblk = Npad / 32, kb = item / nblk, nb = item % nblk, k0 = 64 * kb, n0 = 32 * nb;
    const int nn = n0 + (lane & 31);
#pragma unroll 8
    for (int i = 0; i < 32; ++i) { const int kk = 2 * i + (lane >> 5); float v = 0.f; if (nn < N) { v = W[(size_t)(k0 + kk) * N + nn]; if (gain) v *= gain[k0 + kk]; } scr[kk * 33 + (lane & 31)] = v; }
    asm volatile("s_waitcnt lgkmcnt(0)" ::: "memory");
    const int c = lane & 7;
#pragma unroll
    for (int j = 0; j < 4; ++j) { const int n = (lane >> 3) + 8 * j; const LAS float* s = scr + (8 * c) * 33 + n;
        u32x4 o; o.x = pk2(s[0 * 33], s[1 * 33]); o.y = pk2(s[2 * 33], s[3 * 33]); o.z = pk2(s[4 * 33], s[5 * 33]); o.w = pk2(s[6 * 33], s[7 * 33]);
        *(u32x4*)(WT + (size_t)(n0 + n) * K + k0 + 8 * c) = o; }
    asm volatile("s_waitcnt lgkmcnt(0)" ::: "memory");
}


typedef short v4i16_t __attribute__((ext_vector_type(4)));
constexpr int DSA_SEL_OFF = RING_BYTES + 1024, DSA_RED_OFF = DSA_SEL_OFF + 4096, DSA_TOT_OFF = DSA_RED_OFF + 512;
static_assert(DSA_TOT_OFF + 256 <= LDS_BYTES, "DSA LDS map");
__device__ __forceinline__ unsigned okey(float f) { unsigned u = __float_as_uint(f); if ((u << 1) == 0u) u = 0u; return (u & 0x80000000u) ? ~u : (u | 0x80000000u); }
#define MFMA16(a, b, c) __builtin_amdgcn_mfma_f32_16x16x32_bf16((a), (b), (c), 0, 0, 0)

template <class Tv> __device__ __forceinline__ Tv ldu(const void* ubase, unsigned voff) { return *(const Tv*)((const char*)ubase + voff); }

__device__ __forceinline__ void dsa_phase(LAS unsigned char* lds, const bf16_t* __restrict__ q, const bf16_t* __restrict__ k, const bf16_t* __restrict__ v, const bf16_t* __restrict__ qi, const bf16_t* __restrict__ ki,
                                          const float* __restrict__ wi, bf16_t* __restrict__ o, int vcu, int G, int tid_, int lane_, int wave) {
    LAS unsigned short* selbuf = (LAS unsigned short*)(lds + DSA_SEL_OFF);
    LAS unsigned* red = (LAS unsigned*)(lds + DSA_RED_OFF);
    LAS unsigned* tot = (LAS unsigned*)(lds + DSA_TOT_OFF);
    const int npu = 2048;
    const bool even = (npu % G) == 0; const int per = even ? npu / G : 0;
    int par = 0;
    for (int it = 0;; ++it) {
        int pu; if (even) { if (it >= per) break; pu = vcu * per + it; } else { pu = it * G + vcu; if (pu >= npu) break; }
        const int b = pu >> 8, pr = pu & 255;
#pragma unroll 1
        for (int which = 0; which < 2; ++which) {
            int lane = lane_; asm volatile("" : "+v"(lane));
            const int tid = wave * 64 + lane;
            const int hf = lane >> 5, l31 = lane & 31, fr = lane & 15, fq = lane >> 4;
            LAS unsigned char* vbuf = lds + wave * 16384;
            const int g = which ? 511 - pr : pr; const int t0 = 8 * g; const size_t tok0 = (size_t)b * SEQ + t0;
            __syncthreads();
            if (t0 + 7 < TOPK) {
                for (int i = tid; i < 2048; i += NTHREADS) { const int ql = i >> 8, p = i & 255; selbuf[i] = (unsigned short)((p <= t0 + ql) ? p : 0xFFFF); }
            } else {
                const int nkt = ((t0 + 7) >> 5) + 1;
                const unsigned kvoff = (unsigned)(l31 * 128 + 16 * hf);
                const bf16_t* qib = qi + tok0 * 512; const float* wib = wi + tok0 * 8;
                bf16x8 af[2][4]; f32x4 wlo[2][2], whi[2][2];
#pragma unroll
                for (int rt = 0; rt < 2; ++rt) {
                    const int qla = 4 * rt + 2 * ((l31 >> 2) & 1) + (l31 >> 4), hd = (l31 & 3) + 4 * ((l31 >> 3) & 1);
                    const unsigned aoff = (unsigned)((qla * 512 + hd * 64 + 8 * hf) * 2);
#pragma unroll
                    for (int sk = 0; sk < 4; ++sk) af[rt][sk] = ldu<bf16x8>(qib, aoff + 32 * sk);
#pragma unroll
                    for (int j = 0; j < 2; ++j) { const unsigned woff = (unsigned)((4 * rt + 2 * hf + j) * 32); wlo[rt][j] = ldu<f32x4>(wib, woff); whi[rt][j] = ldu<f32x4>(wib, woff + 16); }
                }
                unsigned key[16][4];
#pragma unroll
                for (int i = 0; i < 16; ++i) {
                    const int kt = wave + 8 * i;
                    if (kt < nkt) {
                        const bf16_t* bpu = ki + ((size_t)b * SEQ + 32 * kt) * 64;
                        bf16x8 bfr[4];
#pragma unroll
                        for (int sk = 0; sk < 4; ++sk) bfr[sk] = ldu<bf16x8>(bpu, kvoff + 32 * sk);
                        const int kidx = 32 * kt + l31;
#pragma unroll
                        for (int rt = 0; rt < 2; ++rt) {
                            f32x16 acc;
#pragma unroll
                            for (int r = 0; r < 16; ++r) acc[r] = 0.f;
#pragma unroll
                            for (int sk = 0; sk < 4; ++sk) acc = MFMA32(af[rt][sk], bfr[sk], acc);
#pragma unroll
                            for (int j = 0; j < 2; ++j) {
                                float sc = 0.f;
#pragma unroll
                                for (int h = 0; h < 4; ++h) sc += fmaxf(acc[8 * j + h], 0.f) * wlo[rt][j][h];
#pragma unroll
                                for (int h = 0; h < 4; ++h) sc += fmaxf(acc[8 * j + 4 + h], 0.f) * whi[rt][j][h];
                                const int tq = t0 + 4 * rt + 2 * hf + j;
                                key[i][rt * 2 + j] = (kidx <= tq) ? okey(sc) : 0u;
                            }
                        }
                    } else {
#pragma unroll
                        for (int q4 = 0; q4 < 4; ++q4) key[i][q4] = 0u;
                    }
                }
#define DSA_REDUCE(PRED, TOT) do { unsigned c01 = 0u, c23 = 0u; \
        _Pragma("unroll") for (int i = 0; i < 16; ++i) { c01 += (PRED(i, 0) ? 1u : 0u) + (PRED(i, 1) ? 0x10000u : 0u); c23 += (PRED(i, 2) ? 1u : 0u) + (PRED(i, 3) ? 0x10000u : 0u); } \
        _Pragma("unroll") for (int o_ = 1; o_ < 32; o_ <<= 1) { c01 += __shfl_xor(c01, o_); c23 += __shfl_xor(c23, o_); } \
        if (l31 == 0) { LAS unsigned* rp = red + (par * 8 + wave) * 8 + 2 * hf; rp[0] = c01 & 0xffffu; rp[1] = c01 >> 16; rp[4] = c23 & 0xffffu; rp[5] = c23 >> 16; } \
        __syncthreads(); \
        TOT[0] = 0u; TOT[1] = 0u; TOT[2] = 0u; TOT[3] = 0u; \
        _Pragma("unroll") for (int w_ = 0; w_ < 8; ++w_) { const LAS unsigned* rp = red + (par * 8 + w_) * 8 + 2 * hf; const u32x2 x_ = *(const LAS u32x2*)rp, y_ = *(const LAS u32x2*)(rp + 4); TOT[0] += x_.x; TOT[1] += x_.y; TOT[2] += y_.x; TOT[3] += y_.y; } \
        par ^= 1; } while (0)
                unsigned lo_[4], hi_[4], thr[4], mid[4], icut[4]; bool done[4], tie[4];
#pragma unroll
                for (int q4 = 0; q4 < 4; ++q4) { lo_[q4] = 0u; hi_[q4] = 0xFFFFFFFFu; thr[q4] = 0u; done[q4] = false; tie[q4] = false; icut[q4] = 0u; }
#pragma unroll 1
                for (int iter = 0; iter < 40; ++iter) {
#pragma unroll
                    for (int q4 = 0; q4 < 4; ++q4) mid[q4] = lo_[q4] + ((hi_[q4] - lo_[q4]) >> 1);
                    unsigned tt[4];
#define P_GT(i, q4) (key[i][q4] > mid[q4])
                    DSA_REDUCE(P_GT, tt);
#undef P_GT
                    bool all = true;
#pragma unroll
                    for (int q4 = 0; q4 < 4; ++q4) {
                        if (!done[q4]) {
                            if (tt[q4] == (unsigned)TOPK) { thr[q4] = mid[q4]; done[q4] = true; }
                            else { if (tt[q4] < (unsigned)TOPK) hi_[q4] = mid[q4]; else lo_[q4] = mid[q4] + 1u;
                                   if (lo_[q4] == hi_[q4]) { thr[q4] = lo_[q4]; done[q4] = true; tie[q4] = true; } }
                        }
                        all = all && done[q4];
                    }
                    if (!__any(!all)) break;
                }
                const bool anytie = __any(tie[0] || tie[1] || tie[2] || tie[3]);
                if (anytie) {
                    unsigned cgt[4], need[4], ilo[4], ihi[4];
#define P_GT2(i, q4) (key[i][q4] > thr[q4])
                    DSA_REDUCE(P_GT2, cgt);
#undef P_GT2
#pragma unroll
                    for (int q4 = 0; q4 < 4; ++q4) { need[q4] = (unsigned)TOPK - cgt[q4]; ilo[q4] = 0u; ihi[q4] = (unsigned)(SEQ - 1); }
#pragma unroll 1
                    for (int iter = 0; iter < 12; ++iter) {
#pragma unroll
                        for (int q4 = 0; q4 < 4; ++q4) mid[q4] = (ilo[q4] + ihi[q4]) >> 1;
                        unsigned ce[4];
#define P_EQ(i, q4) (key[i][q4] == thr[q4] && (unsigned)(32 * (wave + 8 * i) + l31) <= mid[q4])
                        DSA_REDUCE(P_EQ, ce);
#undef P_EQ
#pragma unroll
                        for (int q4 = 0; q4 < 4; ++q4) { if (ce[q4] >= need[q4]) ihi[q4] = mid[q4]; else ilo[q4] = mid[q4] + 1u; }
                    }
#pragma unroll
                    for (int q4 = 0; q4 < 4; ++q4) icut[q4] = ihi[q4];
                }
#define P_SEL(i, q4) (key[i][q4] > thr[q4] || (tie[q4] && key[i][q4] == thr[q4] && (unsigned)(32 * (wave + 8 * i) + l31) <= icut[q4]))
                {
                    unsigned n01 = 0u, n23 = 0u;
#pragma unroll
                    for (int i = 0; i < 16; ++i) { n01 += (P_SEL(i, 0) ? 1u : 0u) + (P_SEL(i, 1) ? 0x10000u : 0u); n23 += (P_SEL(i, 2) ? 1u : 0u) + (P_SEL(i, 3) ? 0x10000u : 0u); }
                    unsigned x01 = n01, x23 = n23;
#pragma unroll
                    for (int o_ = 1; o_ < 32; o_ <<= 1) { const unsigned t01 = __shfl_up(x01, o_, 32), t23 = __shfl_up(x23, o_, 32); if (l31 >= o_) { x01 += t01; x23 += t23; } }
                    if (l31 == 31) { LAS unsigned* tp = tot + wave * 8 + 2 * hf; tp[0] = x01 & 0xffffu; tp[1] = x01 >> 16; tp[4] = x23 & 0xffffu; tp[5] = x23 >> 16; }
                    __syncthreads();
                    unsigned pos[4]; pos[0] = (x01 - n01) & 0xffffu; pos[1] = (x01 - n01) >> 16; pos[2] = (x23 - n23) & 0xffffu; pos[3] = (x23 - n23) >> 16;
#pragma unroll
                    for (int w_ = 0; w_ < 8; ++w_) if (w_ < wave) { const LAS unsigned* tp = tot + w_ * 8 + 2 * hf; pos[0] += tp[0]; pos[1] += tp[1]; pos[2] += tp[4]; pos[3] += tp[5]; }
#pragma unroll
                    for (int i = 0; i < 16; ++i)
#pragma unroll
                        for (int q4 = 0; q4 < 4; ++q4) if (P_SEL(i, q4)) { const int ql = 4 * (q4 >> 1) + 2 * hf + (q4 & 1); selbuf[ql * 256 + (pos[q4] & 255u)] = (unsigned short)(32 * (wave + 8 * i) + l31); pos[q4]++; }
                }
#undef P_SEL
#undef DSA_REDUCE
            }
            __syncthreads();
            {
                const size_t tok = tok0 + wave; const int t = t0 + wave;
                const LAS unsigned short* sel = selbuf + wave * 256;
                const bf16_t* qb = q + tok * 1024; const bf16_t* kb = k + (size_t)b * SEQ * 128; const bf16_t* vb = v + (size_t)b * SEQ * 128;
                bf16x8 qf[4];
                { const unsigned qoff = (unsigned)(((fr & 7) * 128 + 8 * fq) * 2);
#pragma unroll
                  for (int sk = 0; sk < 4; ++sk) qf[sk] = ldu<bf16x8>(qb, qoff + 64 * sk); }
                f32x4 lg[16];
#pragma unroll
                for (int kt = 0; kt < 16; ++kt) {
                    unsigned ix = sel[16 * kt + fr]; ix = (ix == 0xFFFFu) ? 0u : ix;
                    const unsigned koff = ix * 256u + 16u * fq;
                    f32x4 acc = (f32x4){0.f, 0.f, 0.f, 0.f};
#pragma unroll
                    for (int sk = 0; sk < 4; ++sk) { const bf16x8 ka = ldu<bf16x8>(kb, koff + 64 * sk); acc = MFMA16(ka, qf[sk], acc); }
#pragma unroll
                    for (int r = 0; r < 4; ++r) { const int p = 16 * kt + 4 * fq + r; lg[kt][r] = (t >= TOPK - 1 || p <= t) ? acc[r] : -INFINITY; }
                }
                float mx = -INFINITY;
#pragma unroll
                for (int kt = 0; kt < 16; ++kt) mx = fmaxf(fmaxf(mx, fmaxf(lg[kt][0], lg[kt][1])), fmaxf(lg[kt][2], lg[kt][3]));
                mx = fmaxf(mx, __shfl_xor(mx, 16)); mx = fmaxf(mx, __shfl_xor(mx, 32));
                float sm = 0.f;
#pragma unroll
                for (int kt = 0; kt < 16; ++kt)
#pragma unroll
                    for (int r = 0; r < 4; ++r) { const float e = exp2f(lg[kt][r] - mx); lg[kt][r] = e; sm += e; }
                sm += __shfl_xor(sm, 16); sm += __shfl_xor(sm, 32);
                bf16x8 pb[8];
#pragma unroll
                for (int u = 0; u < 8; ++u) { u32x4 w; w.x = pk2(lg[2 * u][0], lg[2 * u][1]); w.y = pk2(lg[2 * u][2], lg[2 * u][3]); w.z = pk2(lg[2 * u + 1][0], lg[2 * u + 1][1]); w.w = pk2(lg[2 * u + 1][2], lg[2 * u + 1][3]);
                    pb[u] = __builtin_bit_cast(bf16x8, w); }
                f32x4 oacc[8];
#pragma unroll
                for (int dt = 0; dt < 8; ++dt) oacc[dt] = (f32x4){0.f, 0.f, 0.f, 0.f};
                u32x4 vr[8];
#define V_LOAD(u) do { _Pragma("unroll") for (int i = 0; i < 8; ++i) { const int rr = fq + 4 * i; unsigned ix = sel[32 * (u) + rr]; ix = (ix == 0xFFFFu) ? 0u : ix; vr[i] = ldu<u32x4>(vb, ix * 256u + 16u * fr); } } while (0)
#define V_WRITE(buf) do { _Pragma("unroll") for (int i = 0; i < 8; ++i) { const int rr = fq + 4 * i; *(LAS u32x4*)(vbuf + (buf) * 8192 + rr * 256 + 16 * (fr ^ ((rr & 7) << 1))) = vr[i]; } } while (0)
                V_LOAD(0); V_WRITE(0);
                const int qq = fr >> 2, pp = fr & 3;
#pragma unroll
                for (int u = 0; u < 8; ++u) {
                    if (u + 1 < 8) V_LOAD(u + 1);
                    const LAS unsigned char* vbase = vbuf + (u & 1) * 8192;
                    const int rA = 4 * fq + qq, rB = 16 + 4 * fq + qq;
#pragma unroll
                    for (int dt = 0; dt < 8; ++dt) {
                        const int ch = 2 * dt + (pp >> 1);
                        const v4i16_t alo = __builtin_amdgcn_ds_read_tr16_b64_v4i16((LAS v4i16_t*)(vbase + rA * 256 + 16 * (ch ^ ((rA & 7) << 1)) + 8 * (pp & 1)));
                        const v4i16_t ahi = __builtin_amdgcn_ds_read_tr16_b64_v4i16((LAS v4i16_t*)(vbase + rB * 256 + 16 * (ch ^ ((rB & 7) << 1)) + 8 * (pp & 1)));
                        bf16x8 va; va[0] = alo[0]; va[1] = alo[1]; va[2] = alo[2]; va[3] = alo[3]; va[4] = ahi[0]; va[5] = ahi[1]; va[6] = ahi[2]; va[7] = ahi[3];
                        oacc[dt] = MFMA16(va, pb[u], oacc[dt]);
                    }
                    if (u + 1 < 8) V_WRITE((u + 1) & 1);
                }
#undef V_LOAD
#undef V_WRITE
                const float inv = 1.0f / sm;
                if (fr < 8) { bf16_t* op = o + tok * 1024 + fr * 128 + 4 * fq;
#pragma unroll
                    for (int dt = 0; dt < 8; ++dt) *(u32x2*)(op + 16 * dt) = pk4(oacc[dt] * inv); }
            }
        }
    }
}

__global__ void __launch_bounds__(NTHREADS, 2) mk_fwd(Args a) {
    extern __shared__ __attribute__((aligned(16))) unsigned char lds_raw[];
    LAS unsigned char* lds = (LAS unsigned char*)lds_raw;
    const int tid = threadIdx.x, lane = tid & 63, wave = __builtin_amdgcn_readfirstlane(tid >> 6);
    const int G = gridDim.x, bx = blockIdx.x;
    const int vcu = (G % 8 == 0) ? (bx % 8) * (G / 8) + bx / 8 : bx;
    unsigned char* ws = a.ws;
    float* ssq = (float*)(ws + WS_SSQ);
    const int lo = a.ph_lo, hi = a.ph_hi;
#define IN(k) (lo <= (k) && (k) < hi)
#define SEAM(k) do { if (IN(k) && IN((k) + 1)) xcd_barrier(bar); } while (0)
    for (int u = tid; u < (LDS_BYTES - LDSCTL_OFF) / 4; u += NTHREADS) ((LAS unsigned*)(lds + LDSCTL_OFF))[u] = 0u;
    __syncthreads();
    XcdBarrier bar; bar.bar = (unsigned*)(ws + WS_CTL) + CW_BAR + a.li * XCD_BAR_WORDS; bar.x = 0; bar.st = nullptr;
    if (hi - lo > 1) { cg::this_grid().sync(); bar = xcd_barrier_post(bar.bar, (volatile LAS unsigned*)(lds + MISC_OFF) + 8); }

    if (IN(PH_PROLOGUE)) {
        LAS float* scr = (LAS float*)(lds + wave * 16384);
        const int gw = vcu * NWAVES + wave, NGW = G * NWAVES;
        int base = 0;
#define CONV(Wp, gp, K_, N_, Np_, dst) do { const int n_ = ((K_) / 64) * ((Np_) / 32); int first = gw - (base % NGW); if (first < 0) first += NGW; \
            for (int it = first; it < n_; it += NGW) transpose_item(Wp, gp, K_, N_, Np_, (bf16_t*)(ws + (dst)), scr, it, lane); base += n_; } while (0)
        CONV(a.w_in_a, a.norm_mix_g, D, A_IN, A_PAD, WS_WA);
        CONV(a.w_out_a, (const float*)nullptr, D, D, D, WS_WOA);
        CONV(a.w_mlp_up, a.norm_mlp_g, D, FF, FF, WS_WUP0);
        CONV(a.w_mlp_down, (const float*)nullptr, FF, D, D, WS_WDN0);
        CONV(a.w_in_b, a.norm_mix_g + D, D, B_IN, B_IN, WS_WB);
        CONV(a.w_out_b, a.ret_norm_g, 2048, D, D, WS_WOB);
        CONV(a.w_mlp_up + (size_t)D * FF, a.norm_mlp_g + D, D, FF, FF, WS_WUP1);
        CONV(a.w_mlp_down + (size_t)FF * D, (const float*)nullptr, FF, D, D, WS_WDN1);
#undef CONV
        bf16_t* xb = (bf16_t*)(ws + WS_XBHI);
        for (int row = gw; row < T; row += NGW) {
            const f32x4* xr = (const f32x4*)(a.x + (size_t)row * D) + lane; f32x4* hr = (f32x4*)(a.out + (size_t)row * D) + lane; u32x2* xo = (u32x2*)(xb + (size_t)row * D) + lane;
            float s = 0.f;
#pragma unroll
            for (int j = 0; j < 4; ++j) { const f32x4 v = xr[64 * j]; hr[64 * j] = v; xo[64 * j] = pk4(v); s += (v.x * v.x + v.y * v.y) + (v.z * v.z + v.w * v.w); }
            s = wave_sum(s);
            if (lane < 16) ssq[(size_t)row * 16 + lane] = (lane == 0) ? s : 0.f;
        }
        const int gt = vcu * NTHREADS + tid, NGT = G * NTHREADS;
        f32x2* tabA = (f32x2*)(ws + WS_TABA); f32x2* tabI = (f32x2*)(ws + WS_TABI); f32x2* tabR = (f32x2*)(ws + WS_TABR);
        for (int i = gt; i < SEQ * 152; i += NGT) {
            const int p = i / 152, r = i % 152; double inv; f32x2* dst;
            if (r < 16) { inv = pow(500000.0, -(double)r / 16.0); dst = tabA + p * 16 + r; }
            else if (r < 24) { inv = pow(500000.0, -(double)(r - 16) / 8.0); dst = tabI + p * 8 + (r - 16); }
            else { inv = pow(10000.0, -(double)(r - 24) / 128.0); dst = tabR + p * 128 + (r - 24); }
            const double ang = (double)p * inv; f32x2 cs; cs.x = (float)cos(ang); cs.y = (float)sin(ang); *dst = cs;
        }
    }

    SEAM(PH_PROLOGUE);
#ifdef GEMM_NAIVE
#define RUN_GEMM(EPI, SWAPV, g, E) do { pg8::StaticOrder S_; S_.init((g).M, (g).N, G, bx); pg8::gemm_naive<EPI, pg8::StaticOrder, SWAPV>(g, S_, E); } while (0)
#else
#define RUN_GEMM(EPI, SWAPV, g, E) do { pg8::StaticOrder S_; S_.init((g).M, (g).N, G, bx); pg8::gemm_phase<EPI, pg8::StaticOrder, true, true, SWAPV>(lds, g, S_, E); } while (0)
#endif

    if (IN(PH_GEMM_A)) {
        pg8::Gemm g{(const bf16_t*)(ws + WS_XBHI), (const bf16_t*)(ws + WS_WA), T, A_PAD, D};
        EpiA E{ssq, a.pos, (const f32x2*)(ws + WS_TABA), (const f32x2*)(ws + WS_TABI), (bf16_t*)(ws + WS_Q), (bf16_t*)(ws + WS_K), (bf16_t*)(ws + WS_V), (bf16_t*)(ws + WS_QI), (bf16_t*)(ws + WS_KI), (float*)(ws + WS_WI)};
        RUN_GEMM(EpiA, false, g, E);
    }
    SEAM(PH_GEMM_A);
    if (IN(PH_DSA)) dsa_phase(lds, (const bf16_t*)(ws + WS_Q), (const bf16_t*)(ws + WS_K), (const bf16_t*)(ws + WS_V), (const bf16_t*)(ws + WS_QI), (const bf16_t*)(ws + WS_KI), (const float*)(ws + WS_WI), (bf16_t*)(ws + WS_O), vcu, G, tid, lane, wave);
    SEAM(PH_DSA);
    if (IN(PH_OUT_A)) {
        pg8::Gemm g{(const bf16_t*)(ws + WS_O), (const bf16_t*)(ws + WS_WOA), T, D, D};
        EpiResid E{a.out, (bf16_t*)(ws + WS_XBHI), ssq};
        RUN_GEMM(EpiResid, false, g, E);
    }
    SEAM(PH_OUT_A);
    if (IN(PH_UP0)) {
        pg8::Gemm g{(const bf16_t*)(ws + WS_XBHI), (const bf16_t*)(ws + WS_WUP0), T, FF, D};
        EpiUp E{ssq, (bf16_t*)(ws + WS_HID0)};
        RUN_GEMM(EpiUp, false, g, E);
    }
    SEAM(PH_UP0);
    if (IN(PH_DOWN0)) {
        pg8::Gemm g{(const bf16_t*)(ws + WS_HID0), (const bf16_t*)(ws + WS_WDN0), T, D, FF};
        EpiResid E{a.out, (bf16_t*)(ws + WS_XBHI), ssq};
        RUN_GEMM(EpiResid, false, g, E);
    }
    SEAM(PH_DOWN0);
    if (IN(PH_GEMM_B)) {
        { pg8::Gemm g{(const bf16_t*)(ws + WS_XBHI), (const bf16_t*)(ws + WS_WB), T, 2048, D};
          EpiBqk E{ssq, a.pos, (const f32x2*)(ws + WS_TABR), (bf16_t*)(ws + WS_Q1), (bf16_t*)(ws + WS_K1)};
          RUN_GEMM(EpiBqk, false, g, E); }
        { pg8::Gemm g{(const bf16_t*)(ws + WS_XBHI), (const bf16_t*)(ws + WS_WB) + (size_t)2048 * D, T, 2048, D};
          EpiBv E{ssq, (bf16_t*)(ws + WS_VT)};
          RUN_GEMM(EpiBv, true, g, E); }
    }
    SEAM(PH_GEMM_B);
    if (IN(PH_R1)) {
        const bf16_t* q1 = (const bf16_t*)(ws + WS_Q1); bf16_t* k1 = (bf16_t*)(ws + WS_K1); bf16_t* inner = (bf16_t*)(ws + WS_INNER);
        const int hf = lane >> 5, l31 = lane & 31;
        for (int u = vcu; u < 1024; u += G) {
            const int c = u & 31, bh = u >> 5, h = bh & 3, b = bh >> 2;
            const size_t row0 = (size_t)b * SEQ + (size_t)c * 128;
            const float l2g = log2f(1.0f - exp2f(-5.0f - (float)h));
            for (int ti = wave; ti < 10; ti += 8) {
                int mt, nt; if (ti < 4) { mt = 0; nt = ti; } else if (ti < 7) { mt = 1; nt = ti - 3; } else if (ti < 9) { mt = 2; nt = ti - 5; } else { mt = 3; nt = 3; }
                f32x16 acc;
#pragma unroll
                for (int r = 0; r < 16; ++r) acc[r] = 0.f;
                const bf16_t* ap = k1 + (row0 + 32 * mt + l31) * 1024 + h * 256 + 8 * hf;
                const bf16_t* bp = q1 + (row0 + 32 * nt + l31) * 1024 + h * 256 + 8 * hf;
#pragma unroll
                for (int sk = 0; sk < 16; ++sk) { const bf16x8 av = *(const bf16x8*)(ap + 16 * sk), bv = *(const bf16x8*)(bp + 16 * sk); acc = MFMA32(av, bv, acc); }
                const int n = 32 * nt + l31;
                bf16_t* orow = inner + ((size_t)u * 128 + n) * 128;
#pragma unroll
                for (int rg = 0; rg < 4; ++rg) { const int m0 = 32 * mt + 8 * rg + 4 * hf; f32x4 vv;
#pragma unroll
                    for (int j = 0; j < 4; ++j) { const int m = m0 + j; vv[j] = (m <= n) ? acc[4 * rg + j] * exp2f(-(float)(m + 1) * l2g) : 0.f; }
                    *(u32x2*)(orow + m0) = pk4(vv); }
            }
            const int d = tid & 255, mh = tid >> 8;
            u32x4 pk[8];
#pragma unroll
            for (int i = 0; i < 8; ++i) { const int m0 = 8 * (8 * mh + i); float f[8];
#pragma unroll
                for (int j = 0; j < 8; ++j) f[j] = bf2f(k1[(row0 + m0 + j) * 1024 + h * 256 + d]) * exp2f((float)(127 - (m0 + j)) * l2g);
                pk[i].x = pk2(f[0], f[1]); pk[i].y = pk2(f[2], f[3]); pk[i].z = pk2(f[4], f[5]); pk[i].w = pk2(f[6], f[7]); }
            asm volatile("s_waitcnt vmcnt(0)" ::: "memory");
            __syncthreads();
#pragma unroll
            for (int i = 0; i < 8; ++i) { const int m0 = 8 * (8 * mh + i); *(u32x4*)(k1 + (row0 + (d >> 1)) * 1024 + h * 256 + (d & 1) * 128 + m0) = pk[i]; }
        }
    }
    SEAM(PH_R1);
    if (IN(PH_RET)) {
        const bf16_t* q1 = (const bf16_t*)(ws + WS_Q1); const bf16_t* kz = (const bf16_t*)(ws + WS_K1); const bf16_t* inner = (const bf16_t*)(ws + WS_INNER); const bf16_t* vT = (const bf16_t*)(ws + WS_VT);
        bf16_t* y = (bf16_t*)(ws + WS_Y); float* stats = (float*)(ws + WS_STATS);
        const int hf = lane >> 5, l31 = lane & 31, wn = wave >> 1, we = wave & 1;
        for (int u = vcu; u < 256; u += G) {
            const int bh = u >> 3, sl = u & 7, b = bh >> 2, h = bh & 3;
            const float l2g = log2f(1.0f - exp2f(-5.0f - (float)h)); const float gC = exp2f(128.0f * l2g);
            const float xi = exp2f((float)(32 * wn + l31 + 1) * l2g);
            f32x16 S0, S1;
#pragma unroll
            for (int r = 0; r < 16; ++r) { S0[r] = 0.f; S1[r] = 0.f; }
            __syncthreads();
            for (int i = tid; i < ST_BUF / 4; i += NTHREADS) ((LAS unsigned*)lds)[i] = 0u;
            __syncthreads();
            int cur = 0;
            const bf16_t* vTp = vT + ((size_t)bh * 512 + 64 * sl + 32 * we + l31) * SEQ + 8 * hf;
            const int dA = 64 * wn + l31;
            for (int c = 0; c < 32; ++c) {
                const size_t row0 = (size_t)b * SEQ + (size_t)c * 128;
                bf16x8 vf[8];
#pragma unroll
                for (int sk = 0; sk < 8; ++sk) vf[sk] = *(const bf16x8*)(vTp + c * 128 + 16 * sk);
                f32x16 o;
#pragma unroll
                for (int r = 0; r < 16; ++r) o[r] = 0.f;
                const int n = 32 * wn + l31;
                const bf16_t* ip = inner + (((size_t)(bh * 32 + c)) * 128 + n) * 128 + 8 * hf;
#pragma unroll
                for (int mt = 0; mt < 4; ++mt) if (mt <= wn) {
#pragma unroll
                    for (int s2 = 0; s2 < 2; ++s2) { const bf16x8 bv = *(const bf16x8*)(ip + 32 * mt + 16 * s2); o = MFMA32(vf[2 * mt + s2], bv, o); } }
                const bf16_t* qp = q1 + (row0 + n) * 1024 + h * 256 + 8 * hf;
                const LAS unsigned char* stp = lds + cur * ST_BUF + (32 * we + l31) * ST_STRIDE + 16 * hf;
#pragma unroll
                for (int sk = 0; sk < 16; ++sk) { const bf16x8 av = *(const LAS bf16x8*)(stp + 32 * sk); const bf16x8 bv = *(const bf16x8*)(qp + 16 * sk); o = MFMA32(av, bv, o); }
                float s1 = 0.f, s2q = 0.f;
#pragma unroll
                for (int r = 0; r < 16; ++r) { o[r] *= xi; s1 += o[r]; s2q += o[r] * o[r]; }
                s1 += __shfl_xor(s1, 32); s2q += __shfl_xor(s2q, 32);
                if (hf == 0) { f32x2 sv; sv.x = s1; sv.y = s2q; *(f32x2*)(stats + (((row0 + n) * 4 + h) * 16 + 2 * sl + we) * 2) = sv; }
                bf16_t* yp = y + (row0 + n) * 2048 + h * 512 + 64 * sl + 32 * we + 4 * hf;
#pragma unroll
                for (int rg = 0; rg < 4; ++rg) { f32x4 vv; vv.x = o[4 * rg]; vv.y = o[4 * rg + 1]; vv.z = o[4 * rg + 2]; vv.w = o[4 * rg + 3]; *(u32x2*)(yp + 8 * rg) = pk4(vv); }
                const bf16_t* kp0 = kz + (row0 + (dA >> 1)) * 1024 + h * 256 + (dA & 1) * 128 + 8 * hf;
                const bf16_t* kp1 = kz + (row0 + ((dA + 32) >> 1)) * 1024 + h * 256 + (dA & 1) * 128 + 8 * hf;
#pragma unroll
                for (int r = 0; r < 16; ++r) { S0[r] *= gC; S1[r] *= gC; }
#pragma unroll
                for (int sk = 0; sk < 8; ++sk) { const bf16x8 a0 = *(const bf16x8*)(kp0 + 16 * sk), a1 = *(const bf16x8*)(kp1 + 16 * sk); S0 = MFMA32(a0, vf[sk], S0); S1 = MFMA32(a1, vf[sk], S1); }
                LAS unsigned char* stw = lds + (cur ^ 1) * ST_BUF + (32 * we + l31) * ST_STRIDE + (64 * wn + 4 * hf) * 2;
#pragma unroll
                for (int rg = 0; rg < 4; ++rg) { f32x4 v0, v1; v0.x = S0[4 * rg]; v0.y = S0[4 * rg + 1]; v0.z = S0[4 * rg + 2]; v0.w = S0[4 * rg + 3]; v1.x = S1[4 * rg]; v1.y = S1[4 * rg + 1]; v1.z = S1[4 * rg + 2]; v1.w = S1[4 * rg + 3];
                    *(LAS u32x2*)(stw + 16 * rg) = pk4(v0); *(LAS u32x2*)(stw + 64 + 16 * rg) = pk4(v1); }
                __syncthreads();
                cur ^= 1;
            }
        }
    }
    SEAM(PH_RET);
    if (IN(PH_XB2)) {
        const int gw = vcu * NWAVES + wave, NGW = G * NWAVES; bf16_t* xb = (bf16_t*)(ws + WS_XBLO);
        for (int row = gw; row < T; row += NGW) {
            const f32x4* hr = (const f32x4*)(a.out + (size_t)row * D) + lane; u32x2* xo = (u32x2*)(xb + (size_t)row * D) + lane;
#pragma unroll
            for (int j = 0; j < 4; ++j) xo[64 * j] = pk4(hr[64 * j]);
        }
    }
    SEAM(PH_XB2);
    if (IN(PH_GATE)) {
        pg8::Gemm g{(const bf16_t*)(ws + WS_XBLO), (const bf16_t*)(ws + WS_WB) + (size_t)4096 * D, T, 2048, D};
        EpiGate E{ssq, (const float*)(ws + WS_STATS), (bf16_t*)(ws + WS_Y)};
        RUN_GEMM(EpiGate, false, g, E);
    }
    SEAM(PH_GATE);
    if (IN(PH_OUT_B)) {
        pg8::Gemm g{(const bf16_t*)(ws + WS_Y), (const bf16_t*)(ws + WS_WOB), T, D, 2048};
        EpiResid E{a.out, (bf16_t*)(ws + WS_XBLO), ssq};
        RUN_GEMM(EpiResid, false, g, E);
    }
    SEAM(PH_OUT_B);
    if (IN(PH_UP1)) {
        pg8::Gemm g{(const bf16_t*)(ws + WS_XBLO), (const bf16_t*)(ws + WS_WUP1), T, FF, D};
        EpiUp E{ssq, (bf16_t*)(ws + WS_HID1)};
        RUN_GEMM(EpiUp, false, g, E);
    }
    SEAM(PH_UP1);
    if (IN(PH_DOWN1)) {
        pg8::Gemm g{(const bf16_t*)(ws + WS_HID1), (const bf16_t*)(ws + WS_WDN1), T, D, FF};
        EpiResid E{a.out, (bf16_t*)(ws + WS_XBLO), ssq};
        RUN_GEMM(EpiResid, false, g, E);
    }
    SEAM(PH_DOWN1);
    if (IN(PH_FINAL)) {
        const int gw = vcu * NWAVES + wave, NGW = G * NWAVES;
        for (int row = gw; row < T; row += NGW) {
            const float rs = row_rstd(ssq, row);
            f32x4* hr = (f32x4*)(a.out + (size_t)row * D) + lane; const f32x4* gr = (const f32x4*)a.final_norm_g + lane;
#pragma unroll
            for (int j = 0; j < 4; ++j) hr[64 * j] = hr[64 * j] * rs * gr[64 * j];
        }
    }
#undef IN
#undef SEAM
}


__device__ __forceinline__ int block_sum_256(int v, int* red) {
    for (int o = 1; o < 64; o <<= 1) v += __shfl_xor(v, o);
    __syncthreads();
    if ((threadIdx.x & 63) == 0) red[threadIdx.x >> 6] = v;
    __syncthreads();
    return red[0] + red[1] + red[2] + red[3];
}

__global__ void __launch_bounds__(256) k_dsa_simple(const bf16_t* __restrict__ q, const bf16_t* __restrict__ k, const bf16_t* __restrict__ v, const bf16_t* __restrict__ qi, const bf16_t* __restrict__ ki,
                                                    const float* __restrict__ wi, bf16_t* __restrict__ o) {
    __shared__ float s_qi[512]; __shared__ float s_w[8]; __shared__ unsigned s_key[SEQ]; __shared__ int s_sel[TOPK]; __shared__ float s_q[1024]; __shared__ float s_p[8][TOPK];
    __shared__ int s_red[4]; __shared__ int s_cnt; __shared__ float s_mx[8], s_sm[8];
    const int tid = threadIdx.x;
    for (int tok = blockIdx.x; tok < T; tok += gridDim.x) {
        const int b = tok / SEQ, t = tok % SEQ; const int n = t + 1;
        __syncthreads();
        for (int i = tid; i < 512; i += 256) s_qi[i] = bf2f(qi[(size_t)tok * 512 + i]);
        for (int i = tid; i < 1024; i += 256) s_q[i] = bf2f(q[(size_t)tok * 1024 + i]);
        if (tid < 8) s_w[tid] = wi[(size_t)tok * 8 + tid];
        if (tid == 0) s_cnt = 0;
        __syncthreads();
        if (n <= TOPK) {
            s_sel[tid] = (tid < n) ? tid : -1;
        } else {
            for (int j = tid; j < n; j += 256) {
                const bf16_t* kr = ki + ((size_t)b * SEQ + j) * 64; float kv[64];
#pragma unroll
                for (int d = 0; d < 64; ++d) kv[d] = bf2f(kr[d]);
                float sc = 0.f;
#pragma unroll
                for (int h = 0; h < 8; ++h) { float dsum = 0.f;
#pragma unroll
                    for (int d = 0; d < 64; ++d) dsum += s_qi[h * 64 + d] * kv[d];
                    sc += fmaxf(dsum, 0.f) * s_w[h]; }
                s_key[j] = okey(sc);
            }
            __syncthreads();
            unsigned lo_ = 0u, hi_ = 0xFFFFFFFFu, thr = 0u; bool exact = false;
            for (;;) {
                const unsigned mid = lo_ + ((hi_ - lo_) >> 1);
                int c = 0; for (int j = tid; j < n; j += 256) c += (s_key[j] > mid) ? 1 : 0;
                c = block_sum_256(c, s_red);
                if (c == TOPK) { thr = mid; exact = true; break; }
                if (c < TOPK) hi_ = mid; else lo_ = mid + 1u;
                if (lo_ == hi_) { thr = lo_; break; }
            }
            for (int j = tid; j < n; j += 256) if (s_key[j] > thr) { const int p = atomicAdd(&s_cnt, 1); s_sel[p] = j; }
            __syncthreads();
            if (!exact && tid == 0) { int c = s_cnt; for (int j = 0; j < n && c < TOPK; ++j) if (s_key[j] == thr) s_sel[c++] = j; s_cnt = c; }
            __syncthreads();
        }
        __syncthreads();
        { const int j = s_sel[tid];
          if (j >= 0) { const bf16_t* kr = k + ((size_t)b * SEQ + j) * 128; float acc8[8];
#pragma unroll
              for (int h = 0; h < 8; ++h) acc8[h] = 0.f;
              for (int d = 0; d < 128; ++d) { const float kd = bf2f(kr[d]);
#pragma unroll
                  for (int h = 0; h < 8; ++h) acc8[h] += s_q[h * 128 + d] * kd; }
#pragma unroll
              for (int h = 0; h < 8; ++h) s_p[h][tid] = acc8[h];
          } else {
#pragma unroll
              for (int h = 0; h < 8; ++h) s_p[h][tid] = -INFINITY; } }
        __syncthreads();
        { const int w = tid >> 6, l = tid & 63;
          for (int h = w * 2; h < w * 2 + 2; ++h) { float m = -INFINITY; for (int j = l; j < TOPK; j += 64) m = fmaxf(m, s_p[h][j]);
              for (int off = 1; off < 64; off <<= 1) m = fmaxf(m, __shfl_xor(m, off));
              float s = 0.f; for (int j = l; j < TOPK; j += 64) { const float e = exp2f(s_p[h][j] - m); s_p[h][j] = e; s += e; }
              s = wave_sum(s); if (l == 0) { s_mx[h] = m; s_sm[h] = s; } } }
        __syncthreads();
        { const int d = tid & 127, hh = (tid >> 7) * 4; float a0 = 0.f, a1 = 0.f, a2 = 0.f, a3 = 0.f;
          for (int jj = 0; jj < TOPK; ++jj) { const int j = s_sel[jj]; if (j < 0) continue; const float vv = bf2f(v[((size_t)b * SEQ + j) * 128 + d]);
              a0 += s_p[hh][jj] * vv; a1 += s_p[hh + 1][jj] * vv; a2 += s_p[hh + 2][jj] * vv; a3 += s_p[hh + 3][jj] * vv; }
          bf16_t* orow = o + (size_t)tok * 1024;
          orow[(hh + 0) * 128 + d] = (bf16_t)f2bf(a0 / s_sm[hh]); orow[(hh + 1) * 128 + d] = (bf16_t)f2bf(a1 / s_sm[hh + 1]);
          orow[(hh + 2) * 128 + d] = (bf16_t)f2bf(a2 / s_sm[hh + 2]); orow[(hh + 3) * 128 + d] = (bf16_t)f2bf(a3 / s_sm[hh + 3]); }
    }
}

constexpr int DSPLIT = 4;
__global__ void __launch_bounds__(256) k_ret_simple(const bf16_t* __restrict__ q1, const bf16_t* __restrict__ k1, const bf16_t* __restrict__ vT, bf16_t* __restrict__ y) {
    const int bh = blockIdx.x >> 3, eb = blockIdx.x & 7, b = bh >> 2, h = bh & 3;
    const int e = eb * 64 + (threadIdx.x & 63), dq = __builtin_amdgcn_readfirstlane(threadIdx.x >> 6);
    const float gamma = 1.0f - exp2f(-5.0f - (float)h);
    float Sst[64];
#pragma unroll
    for (int d = 0; d < 64; ++d) Sst[d] = 0.f;
    __shared__ float s_part[4][64];
    const bf16_t* vrow = vT + ((size_t)(b * 4 + h) * 512 + e) * SEQ;
    for (int t0 = 0; t0 < SEQ; t0 += 8) {
        const bf16x8 v8 = *(const bf16x8*)(vrow + t0);
#pragma unroll
        for (int tt = 0; tt < 8; ++tt) {
            const size_t row = (size_t)b * SEQ + t0 + tt;
            const bf16_t* qr = q1 + row * 1024 + h * 256 + dq * 64; const bf16_t* kr = k1 + row * 1024 + h * 256 + dq * 64;
            const float vv = bf2f((bf16_t)v8[tt]); float o = 0.f;
#pragma unroll
            for (int d = 0; d < 64; ++d) { Sst[d] = gamma * Sst[d] + bf2f(kr[d]) * vv; o += bf2f(qr[d]) * Sst[d]; }
            s_part[dq][threadIdx.x & 63] = o;
            __syncthreads();
            if (dq == 0) { const int l = threadIdx.x; const float tot = (s_part[0][l] + s_part[1][l]) + (s_part[2][l] + s_part[3][l]); y[row * 2048 + h * 512 + e] = (bf16_t)f2bf(tot); }
            __syncthreads();
        }
    }
}
__global__ void __launch_bounds__(256) k_stats_simple(const bf16_t* __restrict__ y, float* __restrict__ stats) {
    const int i = blockIdx.x * 256 + threadIdx.x; if (i >= T * 64) return;
    const bf16_t* p = y + (size_t)i * 32; float s = 0.f, q = 0.f;
    for (int e = 0; e < 32; ++e) { const float v = bf2f(p[e]); s += v; q += v * v; }
    stats[(size_t)i * 2] = s; stats[(size_t)i * 2 + 1] = q;
}

extern "C" void kernel_launch(void* const* d_in, const int* in_sizes, int n_in, void* d_out, int out_size, void* d_ws, size_t ws_size, hipStream_t stream) {
    static int grid = 0;
    if (grid == 0) {
        if (n_in != 12 || out_size != T * D || ws_size < WS_END) { fprintf(stderr, "kernel_launch: unexpected shapes (n_in %d out %d ws %zu)\n", n_in, out_size, ws_size); grid = -1; return; }
        int dev = 0, cus = 0;
        if (hipGetDevice(&dev) != hipSuccess || hipDeviceGetAttribute(&cus, hipDeviceAttributeMultiprocessorCount, dev) != hipSuccess) { grid = -1; return; }
        if (hipFuncSetAttribute((const void*)mk_fwd, hipFuncAttributeMaxDynamicSharedMemorySize, LDS_BYTES) != hipSuccess) { fprintf(stderr, "kernel_launch: hipFuncSetAttribute failed\n"); grid = -1; return; }
        (void)hipGetLastError();
        grid = cus;
    }
    if (grid < 0) return;
    unsigned char* ws = (unsigned char*)d_ws;
    Args a{};
    a.x = (const float*)d_in[0]; a.pos = (const int*)d_in[1]; a.norm_mix_g = (const float*)d_in[2]; a.norm_mlp_g = (const float*)d_in[3]; a.w_in_a = (const float*)d_in[4]; a.w_out_a = (const float*)d_in[5];
    a.w_in_b = (const float*)d_in[6]; a.ret_norm_g = (const float*)d_in[7]; a.w_out_b = (const float*)d_in[8]; a.w_mlp_up = (const float*)d_in[9]; a.w_mlp_down = (const float*)d_in[10]; a.final_norm_g = (const float*)d_in[11];
    a.out = (float*)d_out; a.ws = ws;
    if (hipMemsetAsync(ws + WS_CTL, 0, CTL_ZERO_BYTES, stream) != hipSuccess) { fprintf(stderr, "kernel_launch: memset failed\n"); return; }
    int li = 0;
    auto seg = [&](int lo, int hi) {
        a.ph_lo = lo; a.ph_hi = hi; a.li = li++;
        if (hi - lo > 1) { void* args[] = {&a}; hipError_t e = hipLaunchCooperativeKernel((const void*)mk_fwd, dim3(grid), dim3(NTHREADS), args, LDS_BYTES, stream);
            if (e != hipSuccess) fprintf(stderr, "cooperative launch failed: %s\n", hipGetErrorString(e)); }
        else hipLaunchKernelGGL(mk_fwd, dim3(grid), dim3(NTHREADS), LDS_BYTES, stream, a);
    };
#ifdef SIMPLE_DSA
    seg(PH_PROLOGUE, PH_DSA);
    k_dsa_simple<<<2048, 256, 0, stream>>>((const bf16_t*)(ws + WS_Q), (const bf16_t*)(ws + WS_K), (const bf16_t*)(ws + WS_V), (const bf16_t*)(ws + WS_QI), (const bf16_t*)(ws + WS_KI), (const float*)(ws + WS_WI), (bf16_t*)(ws + WS_O));
    seg(PH_OUT_A, PH_COUNT);
#else
    seg(PH_PROLOGUE, PH_COUNT);
#endif
}
#if 0
#ifdef SIMPLE_RET
    seg(PH_OUT_A, PH_R1);
    k_ret_simple<<<256, 256, 0, stream>>>((const bf16_t*)(ws + WS_Q1), (const bf16_t*)(ws + WS_K1), (const bf16_t*)(ws + WS_VT), (bf16_t*)(ws + WS_Y));
    k_stats_simple<<<(T * 64) / 256, 256, 0, stream>>>((const bf16_t*)(ws + WS_Y), (float*)(ws + WS_STATS));
    seg(PH_XB2, PH_COUNT);
#else
    seg(PH_OUT_A, PH_COUNT);
#endif
}
#endif
```

```cpp
#include <hip/hip_runtime.h>
#include <hip/hip_cooperative_groups.h>
#include <cstdio>
#include <cstdint>
namespace cg = cooperative_groups;

#define LAS __attribute__((address_space(3)))
#define GAS __attribute__((address_space(1)))
typedef unsigned short bf16_t;
typedef short bf16x8 __attribute__((ext_vector_type(8)));
typedef float f32x4 __attribute__((ext_vector_type(4)));
typedef float f32x2 __attribute__((ext_vector_type(2)));
typedef unsigned u32x4 __attribute__((ext_vector_type(4)));
typedef unsigned u32x2 __attribute__((ext_vector_type(2)));

constexpr int NB = 8, SEQ = 4096, T = NB * SEQ, D = 1024, FF = 4096;
constexpr int A_IN = 1864, A_PAD = 2048, B_IN = 6144;
constexpr int TOPK = 256;
constexpr float EPS = 1e-6f;
constexpr float QSCALE = 0.08838834764831845f * 1.4426950408889634f;

constexpr size_t MiB = 1u << 20;
constexpr size_t WS_CTL = 0, CTL_ZERO_BYTES = 1 * MiB;
constexpr size_t WS_SSQ = 1 * MiB;
constexpr size_t WS_WI = 3 * MiB;
constexpr size_t WS_TABA = 4 * MiB;
constexpr size_t WS_TABI = 4 * MiB + 512 * 1024;
constexpr size_t WS_TABR = 5 * MiB;
constexpr size_t WS_STATS = 9 * MiB;
constexpr size_t WS_WA = 26 * MiB, WS_WOA = 30 * MiB, WS_WUP0 = 32 * MiB, WS_WDN0 = 40 * MiB, WS_WB = 48 * MiB, WS_WOB = 60 * MiB, WS_WUP1 = 64 * MiB, WS_WDN1 = 72 * MiB;
constexpr size_t WS_Q = 80 * MiB, WS_K = 144 * MiB, WS_V = 152 * MiB, WS_QI = 160 * MiB, WS_KI = 192 * MiB, WS_SEL = 196 * MiB, WS_O = 212 * MiB;
constexpr size_t WS_HID0 = 80 * MiB, WS_XBHI = 448 * MiB;
constexpr size_t WS_Q1 = 80 * MiB, WS_K1 = 144 * MiB, WS_VT = 208 * MiB, WS_INNER = 336 * MiB, WS_Y = 384 * MiB, WS_XBLO = 80 * MiB, WS_HID1 = 144 * MiB;
constexpr size_t WS_END = 512 * MiB;

__device__ __forceinline__ float bf2f(bf16_t v) { return __uint_as_float((unsigned)v << 16); }
__device__ __forceinline__ unsigned f2bf(float f) { unsigned u = __float_as_uint(f); return (u + 0x7fffu + ((u >> 16) & 1u)) >> 16; }
__device__ __forceinline__ unsigned pk2(float lo, float hi) { return f2bf(lo) | (f2bf(hi) << 16); }
__device__ __forceinline__ u32x2 pk4(f32x4 v) { u32x2 r; r.x = pk2(v.x, v.y); r.y = pk2(v.z, v.w); return r; }
__device__ __forceinline__ float wave_sum(float v) {
#pragma unroll
    for (int o = 1; o < 64; o <<= 1) v += __shfl_xor(v, o);
    return v;
}
__device__ __forceinline__ float row_rstd(const float* ssq16, int row) {
    const f32x4* p = (const f32x4*)(ssq16 + (size_t)row * 16);
    const f32x4 a = p[0], b = p[1], c = p[2], d = p[3];
    const float s = (((a.x + a.y) + (a.z + a.w)) + ((b.x + b.y) + (b.z + b.w))) + (((c.x + c.y) + (c.z + c.w)) + ((d.x + d.y) + (d.z + d.w)));
    return rsqrtf(s * (1.0f / 1024.0f) + EPS);
}

namespace pg8 {
#define PG8_LAS __attribute__((address_space(3)))
constexpr int BM = 256, BK = 64, HALF = 128, HTB = HALF * BK * 2, STAGE_BYTES = 8 * HTB, NXCD = 8, WGM = 8;
__host__ __device__ __forceinline__ int lds_byte(int r, int c) { const int st = (r >> 4) * 2 + (c >> 5), rr = r & 15, cc = c & 31, ob = rr * 64 + cc * 2; return st * 1024 + (ob ^ (((ob >> 9) & 1) << 5)); }
__host__ __device__ __forceinline__ void stage_rc(int b, int& R, int& C) { const int st = b / 1024, sb = b % 1024, swz = sb ^ (((sb >> 9) & 1) << 5); R = (st >> 1) * 16 + swz / 64; C = (st & 1) * 32 + (swz % 64) / 2; }
__host__ __device__ __forceinline__ int perm32(int rho) { const int n = rho >> 4, i = rho & 15; return 8 * (i >> 2) + 4 * n + (i & 3); }
struct Unit { int pm, pn; };
struct Gemm { const bf16_t* A; const bf16_t* Bt; int M, N, K; };
struct StaticOrder {
    int nM, nN, nwg, G, c;
    __host__ __device__ void init(int M, int N, int G_, int c_) { nM = M / BM; nN = N / BM; nwg = nM * nN; G = G_; c = c_; }
    __host__ __device__ bool next(int i, Unit& u) const {
        const long L = (long)i * G + c; if (L >= nwg) return false;
        int wgid = (int)L; { const int q = nwg / NXCD, r = nwg % NXCD, xcd = wgid % NXCD, off = wgid / NXCD; wgid = (xcd < r ? xcd * (q + 1) : r * (q + 1) + (xcd - r) * q) + off; }
        const int nig = WGM * nN, gid = wgid / nig, fm = gid * WGM, gsz = (nM - fm) < WGM ? (nM - fm) : WGM;
        u.pm = fm + ((wgid % nig) % gsz); u.pn = (wgid % nig) / gsz; return true;
    }
    __device__ __forceinline__ void a_ready(const Unit&) const {}
    __device__ __forceinline__ void done(const Unit&) const {}
};

template <class Epi, class Sched, bool ALIGN_EPI, bool SP2, bool SWAP>
__device__ __forceinline__ void gemm_phase(PG8_LAS unsigned char* lds, const Gemm g, const Sched& S, const Epi& E) {
    const int tid = threadIdx.x, wid = __builtin_amdgcn_readfirstlane(tid >> 6), lane = tid & 63, wr = wid >> 2, wc = wid & 3, fr = lane & 15, fq = lane >> 4;
    const int K = g.K, nt = K / BK;
    unsigned voffA[2], voffB[2];
#pragma unroll
    for (int i = 0; i < 2; ++i) { int R, C; stage_rc(tid * 16 + i * 8192, R, C); const int Rb = Epi::PERM ? ((R & ~31) + perm32(R & 31)) : R;
        voffA[i] = (unsigned)(R * K + C) * 2u; voffB[i] = (unsigned)(Rb * K + C) * 2u; }
    const size_t kstep = (size_t)(BK * 2);
    const size_t hstep = (size_t)HALF * K * 2;
    const size_t tstep = 2 * hstep;
    const unsigned ldsw = (unsigned)wid * 1024u;
    const int aoff = lds_byte(wr * 64 + fr, fq * 8), boff = lds_byte(wc * 32 + fr, fq * 8);
#define PG8_SA(b, h) (((b) * 2 + (h)) * HTB)
#define PG8_SB(b, h) ((4 + (b) * 2 + (h)) * HTB)
#define PG8_STAGE(bufoff, gbase, voff) do { _Pragma("unroll") for (int _i = 0; _i < 2; ++_i) \
        __builtin_amdgcn_global_load_lds((const unsigned*)((const char*)(gbase) + (voff)[_i]), (PG8_LAS unsigned*)(lds + (bufoff) + ldsw + _i * 8192), 16, 0, 0); } while (0)
#define PG8_LDA(dst, b, h) do { _Pragma("unroll") for (int m = 0; m < 4; ++m) _Pragma("unroll") for (int k = 0; k < 2; ++k) dst[m][k] = *(const PG8_LAS bf16x8*)(lds + PG8_SA(b, h) + aoff + m * 2048 + k * 1024); } while (0)
#define PG8_LDB(dst, b, h) do { _Pragma("unroll") for (int n = 0; n < 2; ++n) _Pragma("unroll") for (int k = 0; k < 2; ++k) dst[n][k] = *(const PG8_LAS bf16x8*)(lds + PG8_SB(b, h) + boff + n * 2048 + k * 1024); } while (0)
#define PG8_MMA(ai, bj, At, Bt) do { __builtin_amdgcn_s_setprio(1); _Pragma("unroll") for (int m = 0; m < 4; ++m) _Pragma("unroll") for (int n = 0; n < 2; ++n) _Pragma("unroll") for (int k = 0; k < 2; ++k) { \
        if constexpr (SWAP) acc[ai][bj][m][n] = __builtin_amdgcn_mfma_f32_16x16x32_bf16(At[m][k], Bt[n][k], acc[ai][bj][m][n], 0, 0, 0); \
        else acc[ai][bj][m][n] = __builtin_amdgcn_mfma_f32_16x16x32_bf16(Bt[n][k], At[m][k], acc[ai][bj][m][n], 0, 0, 0); } __builtin_amdgcn_s_setprio(0); } while (0)
#define PG8_WAIT_V(n) asm volatile("s_waitcnt vmcnt(" #n ")" ::: "memory")
#define PG8_WAIT_L(n) asm volatile("s_waitcnt lgkmcnt(" #n ")" ::: "memory")
#define PG8_BAR __builtin_amdgcn_s_barrier()
#define PG8_SCHED __builtin_amdgcn_sched_barrier(0)
    Unit cur, nxt; int ui = 0;
    if (!S.next(0, cur)) return;
    f32x4 acc[2][2][4][2];
#pragma unroll
    for (int a = 0; a < 2; ++a)
#pragma unroll
        for (int b = 0; b < 2; ++b)
#pragma unroll
            for (int m = 0; m < 4; ++m)
#pragma unroll
                for (int n = 0; n < 2; ++n) acc[a][b][m][n] = (f32x4){0.f, 0.f, 0.f, 0.f};
    bf16x8 At[4][2], B0[2][2], B1[2][2];
    const char* cA = (const char*)g.A + (size_t)cur.pm * tstep; const char* cB = (const char*)g.Bt + (size_t)cur.pn * tstep;
    S.a_ready(cur);
    if constexpr (SP2) {
        PG8_STAGE(PG8_SB(0, 0), cB, voffB); PG8_STAGE(PG8_SB(0, 1), cB + hstep, voffB); PG8_STAGE(PG8_SA(0, 0), cA, voffA); PG8_STAGE(PG8_SA(0, 1), cA + hstep, voffA);
        if (wr == 1) PG8_BAR;
        PG8_WAIT_V(2); PG8_BAR;
        PG8_STAGE(PG8_SB(1, 0), cB + kstep, voffB); PG8_STAGE(PG8_SA(1, 0), cA + kstep, voffA); PG8_STAGE(PG8_SB(1, 1), cB + hstep + kstep, voffB);
        PG8_WAIT_V(6); PG8_BAR;
    } else {
        PG8_STAGE(PG8_SB(0, 0), cB, voffB); PG8_STAGE(PG8_SA(0, 0), cA, voffA); PG8_STAGE(PG8_SB(0, 1), cB + hstep, voffB); PG8_STAGE(PG8_SA(0, 1), cA + hstep, voffA);
        if (wr == 1) PG8_BAR;
        PG8_WAIT_V(4); PG8_BAR;
        PG8_STAGE(PG8_SB(1, 0), cB + kstep, voffB); PG8_STAGE(PG8_SA(1, 0), cA + kstep, voffA); PG8_STAGE(PG8_SB(1, 1), cB + hstep + kstep, voffB);
        PG8_WAIT_V(6); PG8_BAR;
    }
    for (;;) {
        const bool has_next = S.next(ui + 1, nxt);
        const char* nA = has_next ? (const char*)g.A + (size_t)nxt.pm * tstep : cA; const char* nB = has_next ? (const char*)g.Bt + (size_t)nxt.pn * tstep : cB;
        for (int t = 0; t < nt; t += 2) {
            const bool last = (t == nt - 2);
            const char* a1 = cA + (size_t)(t + 1) * kstep;
            const char* a2 = last ? nA : cA + (size_t)(t + 2) * kstep; const char* b2 = last ? nB : cB + (size_t)(t + 2) * kstep;
            const char* a3 = a2 + kstep; const char* b3 = b2 + kstep;
            if (last && has_next) S.a_ready(nxt);
            if constexpr (SP2) {
            PG8_LDB(B0, 0, 0); PG8_LDB(B1, 0, 1); PG8_SCHED; PG8_LDA(At, 0, 0); PG8_STAGE(PG8_SA(1, 1), a1 + hstep, voffA);
            PG8_WAIT_V(8); PG8_WAIT_L(0); PG8_BAR; PG8_MMA(0, 0, At, B0); PG8_MMA(0, 1, At, B1); PG8_BAR; PG8_SCHED;
            PG8_LDA(At, 0, 1); PG8_STAGE(PG8_SB(0, 0), b2, voffB); PG8_STAGE(PG8_SB(0, 1), b2 + hstep, voffB); PG8_STAGE(PG8_SA(0, 0), a2, voffA);
            PG8_WAIT_V(8); PG8_WAIT_L(0); PG8_BAR; PG8_MMA(1, 0, At, B0); PG8_MMA(1, 1, At, B1); PG8_BAR; PG8_SCHED;
            PG8_LDB(B0, 1, 0); PG8_LDB(B1, 1, 1); PG8_SCHED; PG8_LDA(At, 1, 0); PG8_STAGE(PG8_SA(0, 1), a2 + hstep, voffA);
            PG8_WAIT_V(8); PG8_WAIT_L(0); PG8_BAR; PG8_MMA(0, 0, At, B0); PG8_MMA(0, 1, At, B1); PG8_BAR; PG8_SCHED;
            PG8_LDA(At, 1, 1); PG8_STAGE(PG8_SB(1, 0), b3, voffB); PG8_STAGE(PG8_SB(1, 1), b3 + hstep, voffB); PG8_STAGE(PG8_SA(1, 0), a3, voffA);
            PG8_WAIT_V(8); PG8_WAIT_L(0); PG8_BAR; PG8_MMA(1, 0, At, B0); PG8_MMA(1, 1, At, B1); PG8_BAR; PG8_SCHED;
            } else {
            PG8_LDB(B0, 0, 0); PG8_SCHED; PG8_LDA(At, 0, 0); PG8_STAGE(PG8_SA(1, 1), a1 + hstep, voffA);
            PG8_WAIT_L(8); PG8_BAR; PG8_WAIT_L(0); PG8_MMA(0, 0, At, B0); PG8_BAR; PG8_SCHED;
            PG8_LDB(B1, 0, 1); PG8_STAGE(PG8_SB(0, 0), b2, voffB);
            PG8_BAR; PG8_WAIT_L(0); PG8_MMA(0, 1, At, B1); PG8_BAR;
            PG8_LDA(At, 0, 1); PG8_STAGE(PG8_SA(0, 0), a2, voffA);
            PG8_BAR; PG8_WAIT_L(0); PG8_MMA(1, 0, At, B0); PG8_BAR; PG8_SCHED;
            PG8_STAGE(PG8_SB(0, 1), b2 + hstep, voffB);
            PG8_WAIT_V(6); PG8_BAR; PG8_MMA(1, 1, At, B1); PG8_BAR;
            PG8_LDB(B0, 1, 0); PG8_SCHED; PG8_LDA(At, 1, 0); PG8_STAGE(PG8_SA(0, 1), a2 + hstep, voffA);
            PG8_WAIT_L(8); PG8_BAR; PG8_WAIT_L(0); PG8_MMA(0, 0, At, B0); PG8_BAR; PG8_SCHED;
            PG8_LDB(B1, 1, 1); PG8_STAGE(PG8_SB(1, 0), b3, voffB);
            PG8_BAR; PG8_WAIT_L(0); PG8_MMA(0, 1, At, B1); PG8_BAR;
            PG8_LDA(At, 1, 1); PG8_STAGE(PG8_SA(1, 0), a3, voffA);
            PG8_BAR; PG8_WAIT_L(0); PG8_MMA(1, 0, At, B0); PG8_BAR; PG8_SCHED;
            PG8_STAGE(PG8_SB(1, 1), b3 + hstep, voffB);
            PG8_WAIT_V(6); PG8_BAR; PG8_MMA(1, 1, At, B1); PG8_BAR;
            }
        }
        if constexpr (ALIGN_EPI) { if (wr == 0) PG8_BAR; }
        E(acc, cur, wr, wc, fr, fq); S.done(cur);
        if (!has_next) break;
#pragma unroll
        for (int a = 0; a < 2; ++a)
#pragma unroll
            for (int b = 0; b < 2; ++b)
#pragma unroll
                for (int m = 0; m < 4; ++m)
#pragma unroll
                    for (int n = 0; n < 2; ++n) acc[a][b][m][n] = (f32x4){0.f, 0.f, 0.f, 0.f};
        cur = nxt; cA = nA; cB = nB; ++ui;
        if constexpr (ALIGN_EPI) { if (wr == 1) PG8_BAR; }
    }
    PG8_WAIT_V(0);
    if constexpr (!ALIGN_EPI) { if (wr == 0) PG8_BAR; }
    PG8_BAR;
#undef PG8_SA
#undef PG8_SB
#undef PG8_STAGE
#undef PG8_LDA
#undef PG8_LDB
#undef PG8_MMA
#undef PG8_WAIT_V
#undef PG8_WAIT_L
#undef PG8_BAR
#undef PG8_SCHED
}

template <class Epi, class Sched, bool SWAP>
__device__ __forceinline__ void gemm_naive(const Gemm g, const Sched& S, const Epi& E) {
    const int tid = threadIdx.x, wid = tid >> 6, lane = tid & 63, wr = wid >> 2, wc = wid & 3, fr = lane & 15, fq = lane >> 4;
    Unit u;
    for (int i = 0; S.next(i, u); ++i) {
        f32x4 acc[2][2][4][2];
#pragma unroll 1
        for (int ai = 0; ai < 2; ++ai)
#pragma unroll 1
            for (int bj = 0; bj < 2; ++bj)
#pragma unroll 1
                for (int m = 0; m < 4; ++m)
#pragma unroll 1
                    for (int n = 0; n < 2; ++n) {
                        f32x4 r;
#pragma unroll 1
                        for (int e = 0; e < 4; ++e) {
                            int row, col;
                            if (SWAP) { row = u.pm * 256 + ai * 128 + wr * 64 + m * 16 + 4 * fq + e; col = u.pn * 256 + bj * 128 + wc * 32 + n * 16 + fr; }
                            else { row = u.pm * 256 + ai * 128 + wr * 64 + m * 16 + fr; col = u.pn * 256 + bj * 128 + wc * 32 + n * 16 + 4 * fq + e; }
                            const bf16x8* a = (const bf16x8*)(g.A + (size_t)row * g.K); const bf16x8* b = (const bf16x8*)(g.Bt + (size_t)col * g.K);
                            float s = 0.f;
                            for (int k = 0; k < g.K / 8; ++k) { const bf16x8 av = a[k], bv = b[k];
#pragma unroll
                                for (int j = 0; j < 8; ++j) s += bf2f((bf16_t)av[j]) * bf2f((bf16_t)bv[j]); }
                            r[e] = s;
                        }
#pragma unroll
                        for (int a2 = 0; a2 < 2; ++a2)
#pragma unroll
                            for (int b2 = 0; b2 < 2; ++b2)
#pragma unroll
                                for (int m2 = 0; m2 < 4; ++m2)
#pragma unroll
                                    for (int n2 = 0; n2 < 2; ++n2) if (a2 == ai && b2 == bj && m2 == m && n2 == n) acc[a2][b2][m2][n2] = r;
                    }
        E(acc, u, wr, wc, fr, fq);
    }
}
}
using pg8::Unit;

struct EpiA {
    static constexpr bool PERM = false;
    const float* ssq; const int* pos; const f32x2* tabA; const f32x2* tabI;
    bf16_t *q, *k, *v, *qi, *ki; float* wi; bool dry;
    __device__ __forceinline__ void operator()(const f32x4 (&acc)[2][2][4][2], const Unit& u, int wr, int wc, int fr, int fq) const {
        const int row0 = u.pm * 256 + wr * 64 + fr; const int pn = u.pn;
#pragma unroll
        for (int ai = 0; ai < 2; ++ai)
#pragma unroll
            for (int m = 0; m < 4; ++m) {
                const int row = row0 + ai * 128 + m * 16;
                const float rs = row_rstd(ssq, row);
                int p = pos[row]; p = p < 0 ? 0 : (p > SEQ - 1 ? SEQ - 1 : p);
                if (pn < 4) {
#pragma unroll
                    for (int bj = 0; bj < 2; ++bj) {
                        f32x4 a0 = acc[ai][bj][m][0] * rs, a1 = acc[ai][bj][m][1] * rs;
                        if (wc == 0) { const f32x2* tb = tabA + p * 16 + 4 * fq;
#pragma unroll
                            for (int e = 0; e < 4; ++e) { const f32x2 cs = tb[e]; const float x1 = a0[e], x2 = a1[e]; a0[e] = x1 * cs.x - x2 * cs.y; a1[e] = x2 * cs.x + x1 * cs.y; } }
                        a0 = a0 * QSCALE; a1 = a1 * QSCALE;
                        bf16_t* dst = q + (size_t)row * 1024 + pn * 256 + bj * 128 + wc * 32 + 4 * fq;
                        if (!dry) *(u32x2*)dst = pk4(a0); if (!dry) *(u32x2*)(dst + 16) = pk4(a1);
                    }
                } else if (pn == 4) {
                    { f32x4 a0 = acc[ai][0][m][0] * rs, a1 = acc[ai][0][m][1] * rs;
                      if (wc == 0) { const f32x2* tb = tabA + p * 16 + 4 * fq;
#pragma unroll
                          for (int e = 0; e < 4; ++e) { const f32x2 cs = tb[e]; const float x1 = a0[e], x2 = a1[e]; a0[e] = x1 * cs.x - x2 * cs.y; a1[e] = x2 * cs.x + x1 * cs.y; } }
                      bf16_t* dst = k + (size_t)row * 128 + wc * 32 + 4 * fq; if (!dry) *(u32x2*)dst = pk4(a0); if (!dry) *(u32x2*)(dst + 16) = pk4(a1); }
                    { const f32x4 a0 = acc[ai][1][m][0] * rs, a1 = acc[ai][1][m][1] * rs;
                      bf16_t* dst = v + (size_t)row * 128 + wc * 32 + 4 * fq; if (!dry) *(u32x2*)dst = pk4(a0); if (!dry) *(u32x2*)(dst + 16) = pk4(a1); }
                } else if (pn < 7) {
#pragma unroll
                    for (int bj = 0; bj < 2; ++bj) {
                        f32x4 a0 = acc[ai][bj][m][0] * rs; const f32x4 a1 = acc[ai][bj][m][1] * rs;
                        if ((wc & 1) == 0) { const f32x2* tb = tabI + p * 8 + 4 * (fq & 1);
#pragma unroll
                            for (int e = 0; e < 4; ++e) { const float other = __shfl_xor(a0[e], 32); const f32x2 cs = tb[e]; a0[e] = (fq < 2) ? (a0[e] * cs.x - other * cs.y) : (a0[e] * cs.x + other * cs.y); } }
                        bf16_t* dst = qi + (size_t)row * 512 + (pn - 5) * 256 + bj * 128 + wc * 32 + 4 * fq;
                        if (!dry) *(u32x2*)dst = pk4(a0); if (!dry) *(u32x2*)(dst + 16) = pk4(a1);
                    }
                } else {
                    if (wc < 2) {
                        f32x4 a0 = acc[ai][0][m][0] * rs; const f32x4 a1 = acc[ai][0][m][1] * rs;
                        if (wc == 0) { const f32x2* tb = tabI + p * 8 + 4 * (fq & 1);
#pragma unroll
                            for (int e = 0; e < 4; ++e) { const float other = __shfl_xor(a0[e], 32); const f32x2 cs = tb[e]; a0[e] = (fq < 2) ? (a0[e] * cs.x - other * cs.y) : (a0[e] * cs.x + other * cs.y); } }
                        bf16_t* dst = ki + (size_t)row * 64 + wc * 32 + 4 * fq; if (!dry) *(u32x2*)dst = pk4(a0); if (!dry) *(u32x2*)(dst + 16) = pk4(a1);
                    } else if (wc == 2) {
                        if (fq < 2) { const f32x4 a0 = acc[ai][0][m][0] * (rs * 0.04419417382415922f); if (!dry) *(f32x4*)(wi + (size_t)row * 8 + 4 * fq) = a0; }
                    }
                }
            }
    }
};

struct EpiUp {
    static constexpr bool PERM = false;
    const float* ssq; bf16_t* hid; bool dry;
    __device__ __forceinline__ void operator()(const f32x4 (&acc)[2][2][4][2], const Unit& u, int wr, int wc, int fr, int fq) const {
        const int row0 = u.pm * 256 + wr * 64 + fr, col0 = u.pn * 256 + wc * 32 + 4 * fq;
#pragma unroll
        for (int ai = 0; ai < 2; ++ai)
#pragma unroll
            for (int m = 0; m < 4; ++m) {
                const int row = row0 + ai * 128 + m * 16; const float rs = row_rstd(ssq, row);
                bf16_t* rowp = hid + (size_t)row * FF + col0;
#pragma unroll
                for (int bj = 0; bj < 2; ++bj)
#pragma unroll
                    for (int n = 0; n < 2; ++n) { f32x4 a = acc[ai][bj][m][n] * rs;
#pragma unroll
                        for (int e = 0; e < 4; ++e) { const float r = fmaxf(a[e], 0.f); a[e] = r * r; }
                        if (!dry) *(u32x2*)(rowp + bj * 128 + n * 16) = pk4(a); }
            }
    }
};

struct EpiResid {
    static constexpr bool PERM = false;
    float* h; bf16_t* xb; float* ssq; bool dry;
    __device__ __forceinline__ void operator()(const f32x4 (&acc)[2][2][4][2], const Unit& u, int wr, int wc, int fr, int fq) const {
        const int row0 = u.pm * 256 + wr * 64 + fr, col0 = u.pn * 256 + wc * 32 + 4 * fq;
#pragma unroll
        for (int ai = 0; ai < 2; ++ai)
#pragma unroll
            for (int m = 0; m < 4; ++m) {
                const int row = row0 + ai * 128 + m * 16; float s = 0.f;
#pragma unroll
                for (int bj = 0; bj < 2; ++bj)
#pragma unroll
                    for (int n = 0; n < 2; ++n) { const size_t off = (size_t)row * D + col0 + bj * 128 + n * 16;
                        const f32x4 hv = *(const f32x4*)(h + off) + acc[ai][bj][m][n];
                        if (!dry) *(f32x4*)(h + off) = hv; if (!dry) *(u32x2*)(xb + off) = pk4(hv);
                        s += (hv.x * hv.x + hv.y * hv.y) + (hv.z * hv.z + hv.w * hv.w); }
                s += __shfl_xor(s, 16); s += __shfl_xor(s, 32);
                if (fq == 0 && !dry) ssq[(size_t)row * 16 + u.pn * 4 + wc] = s;
            }
    }
};

struct EpiBqk {
    static constexpr bool PERM = false;
    const float* ssq; const int* pos; const f32x2* tabR; bf16_t *q1, *k1; bool dry;
    __device__ __forceinline__ void operator()(const f32x4 (&acc)[2][2][4][2], const Unit& u, int wr, int wc, int fr, int fq) const {
        const int row0 = u.pm * 256 + wr * 64 + fr; const bool isk = u.pn >= 4; bf16_t* dstb = isk ? k1 : q1; const float sc = isk ? 0.0625f : 1.0f; const int hd = u.pn & 3;
#pragma unroll
        for (int ai = 0; ai < 2; ++ai)
#pragma unroll
            for (int m = 0; m < 4; ++m) {
                const int row = row0 + ai * 128 + m * 16; const float rs = row_rstd(ssq, row) * sc;
                int p = pos[row]; p = p < 0 ? 0 : (p > SEQ - 1 ? SEQ - 1 : p);
#pragma unroll
                for (int n = 0; n < 2; ++n) { f32x4 x1 = acc[ai][0][m][n] * rs, x2 = acc[ai][1][m][n] * rs; const f32x2* tb = tabR + p * 128 + wc * 32 + n * 16 + 4 * fq;
#pragma unroll
                    for (int e = 0; e < 4; ++e) { const f32x2 cs = tb[e]; const float a = x1[e], b = x2[e]; x1[e] = a * cs.x - b * cs.y; x2[e] = b * cs.x + a * cs.y; }
                    bf16_t* dst = dstb + (size_t)row * 1024 + hd * 256 + wc * 32 + n * 16 + 4 * fq; if (!dry) *(u32x2*)dst = pk4(x1); if (!dry) *(u32x2*)(dst + 128) = pk4(x2); }
            }
    }
};
struct EpiBv {
    static constexpr bool PERM = false;
    const float* ssq; bf16_t* vT; bool dry;
    __device__ __forceinline__ void operator()(const f32x4 (&acc)[2][2][4][2], const Unit& u, int wr, int wc, int fr, int fq) const {
        const int rowb = u.pm * 256 + wr * 64 + 4 * fq; const int b = u.pm >> 4;
#pragma unroll
        for (int ai = 0; ai < 2; ++ai)
#pragma unroll
            for (int m = 0; m < 4; ++m) {
                const int row = rowb + ai * 128 + m * 16; f32x4 rs;
#pragma unroll
                for (int e = 0; e < 4; ++e) rs[e] = row_rstd(ssq, row + e);
                const int t = row & (SEQ - 1);
#pragma unroll
                for (int bj = 0; bj < 2; ++bj)
#pragma unroll
                    for (int n = 0; n < 2; ++n) { const int c = u.pn * 256 + bj * 128 + wc * 32 + n * 16 + fr;
                        const f32x4 a = acc[ai][bj][m][n] * rs;
                        if (!dry) *(u32x2*)(vT + ((size_t)(b * 4 + (c >> 9)) * 512 + (c & 511)) * SEQ + t) = pk4(a); }
            }
    }
};
struct EpiGate {
    static constexpr bool PERM = false;
    const float* ssq; const float* stats; bf16_t* y; bool dry;
    __device__ __forceinline__ void operator()(const f32x4 (&acc)[2][2][4][2], const Unit& u, int wr, int wc, int fr, int fq) const {
        const int row0 = u.pm * 256 + wr * 64 + fr, col0 = u.pn * 256 + wc * 32 + 4 * fq; const int hd = u.pn >> 1;
#pragma unroll
        for (int ai = 0; ai < 2; ++ai)
#pragma unroll
            for (int m = 0; m < 4; ++m) {
                const int row = row0 + ai * 128 + m * 16; const float rs = row_rstd(ssq, row);
                const f32x4* sp = (const f32x4*)(stats + ((size_t)row * 4 + hd) * 32);
                float sum = 0.f, sq = 0.f;
#pragma unroll
                for (int i = 0; i < 8; ++i) { const f32x4 sv = sp[i]; sum += sv.x + sv.z; sq += sv.y + sv.w; }
                const float mu = sum * (1.0f / 512.0f); const float var = fmaxf(sq * (1.0f / 512.0f) - mu * mu, 0.f); const float rh = rsqrtf(var + EPS);
                bf16_t* rowp = y + (size_t)row * 2048 + col0;
#pragma unroll
                for (int bj = 0; bj < 2; ++bj)
#pragma unroll
                    for (int n = 0; n < 2; ++n) { const f32x4 g = acc[ai][bj][m][n] * rs; const u32x2 yv = *(const u32x2*)(rowp + bj * 128 + n * 16);
                        f32x4 yf; yf.x = __uint_as_float(yv.x << 16); yf.y = __uint_as_float(yv.x & 0xffff0000u); yf.z = __uint_as_float(yv.y << 16); yf.w = __uint_as_float(yv.y & 0xffff0000u);
                        f32x4 o;
#pragma unroll
                        for (int e = 0; e < 4; ++e) { const float sg = g[e] / (1.0f + __expf(-g[e])); o[e] = sg * (yf[e] - mu) * rh; }
                        if (!dry) *(u32x2*)(rowp + bj * 128 + n * 16) = pk4(o); }
            }
    }
};

#ifndef PROBE_MASK
#define PROBE_MASK 0u
#endif
constexpr int NWAVES = 8, NTHREADS = NWAVES * 64;
constexpr int RING_BYTES = 131072, LDS_BYTES = 163840, LDSCTL_OFF = LDS_BYTES - 1024, MISC_OFF = LDSCTL_OFF + 320;

struct Args {
    const float* x; const int* pos; const float* norm_mix_g; const float* norm_mlp_g; const float* w_in_a; const float* w_out_a; const float* w_in_b; const float* ret_norm_g;
    const float* w_out_b; const float* w_mlp_up; const float* w_mlp_down; const float* final_norm_g;
    float* out; unsigned char* ws; int ph_lo, ph_hi, li, pad;
};

#define XB_TMO      128
#define XB_XCNT(j)  (256  + 64 * (j))
#define XB_XSUB(j)  (1280 + 64 * (j))
#define XB_XGEN(j)  (2304 + 64 * (j))
#define XB_TOP      3328
#define XB_TOPGEN   3392
#define XCD_BAR_WORDS 3456
#define XB_SPIN_CAP (1u << 22)
constexpr int CW_BAR = 4096;
__device__ __forceinline__ unsigned xb_ld(unsigned* p)              { return __hip_atomic_load(p, __ATOMIC_RELAXED, __HIP_MEMORY_SCOPE_AGENT); }
__device__ __forceinline__ unsigned xb_add(unsigned* p, unsigned v) { return __hip_atomic_fetch_add(p, v, __ATOMIC_RELAXED, __HIP_MEMORY_SCOPE_AGENT); }
__device__ __forceinline__ unsigned xb_xcc_id() { return (unsigned)__builtin_amdgcn_s_getreg((3 << 11) | 20) & 0xFu; }
#define XB_SPIN(cond, bar) do { unsigned _sp = 0; while (cond) { __builtin_amdgcn_s_sleep(1); \
    if ((++_sp & 255u) == 0u) { if (xb_ld(&(bar)[XB_TMO])) break; if (_sp > XB_SPIN_CAP) { atomicAdd(&(bar)[XB_TMO], 1u); break; } } } } while (0)
struct XcdBarrier { unsigned* bar; unsigned x; volatile LAS unsigned* st; };
__device__ __forceinline__ XcdBarrier xcd_barrier_post(unsigned* bar, volatile LAS unsigned* st) {
    XcdBarrier b; b.bar = bar; b.x = xb_xcc_id(); b.st = st;
    if (threadIdx.x == 0) (void)xb_add(&bar[XB_XCNT(b.x)], 1u);
    return b;
}
__device__ __forceinline__ void xcd_barrier_complete(unsigned* bar, unsigned x, unsigned& nloc, unsigned& nx) {
    const unsigned G = gridDim.x * gridDim.y * gridDim.z;
    unsigned sum, cnt, mine, sp = 0u;
    for (;;) {
        sum = 0u; cnt = 0u; mine = 0u;
#pragma unroll
        for (unsigned j = 0; j < 16; ++j) { const unsigned c = xb_ld(&bar[XB_XCNT(j)]); sum += c; cnt += (c > 0u) ? 1u : 0u; mine = (j == x) ? c : mine; }
        if (sum == G) break;
        __builtin_amdgcn_s_sleep(1);
        if ((++sp & 255u) == 0u) { if (xb_ld(&bar[XB_TMO])) break; if (sp > XB_SPIN_CAP) { atomicAdd(&bar[XB_TMO], 1u); break; } }
    }
    nloc = mine > 0u ? mine : 1u; nx = cnt > 0u ? cnt : 1u;
}
__device__ __forceinline__ void xcd_barrier(const XcdBarrier& b) {
    asm volatile("s_waitcnt vmcnt(0)" ::: "memory");
    __syncthreads();
    if (threadIdx.x == 0) {
        unsigned* bar = b.bar;
        __builtin_amdgcn_s_waitcnt(0);
        unsigned nloc = b.st[0], nx = b.st[1];
        if (nloc == 0u) { xcd_barrier_complete(bar, b.x, nloc, nx); b.st[0] = nloc; b.st[1] = nx; }
        const unsigned old = xb_add(&bar[XB_XSUB(b.x)], 1u);
        const unsigned gen = old / nloc;
        if (old + 1u == (gen + 1u) * nloc) {
            __builtin_amdgcn_fence(__ATOMIC_RELEASE, "agent");
            asm volatile("s_waitcnt vmcnt(0)" ::: "memory");
            const unsigned og = xb_add(&bar[XB_TOP], 1u);
            const unsigned tg = og / nx;
            if (og + 1u == (tg + 1u) * nx) xb_add(&bar[XB_TOPGEN], 1u);
            else XB_SPIN(xb_ld(&bar[XB_TOPGEN]) == tg, bar);
            __builtin_amdgcn_fence(__ATOMIC_ACQUIRE, "agent");
            xb_add(&bar[XB_XGEN(b.x)], 1u);
            asm volatile("s_waitcnt vmcnt(0)" ::: "memory");
        } else {
            XB_SPIN(xb_ld(&bar[XB_XGEN(b.x)]) == gen, bar);
            __builtin_amdgcn_fence(__ATOMIC_ACQUIRE, "agent");
            asm volatile("s_waitcnt vmcnt(0)" ::: "memory");
        }
    }
    __syncthreads();
}

typedef float f32x16 __attribute__((ext_vector_type(16)));
#define MFMA32(a, b, c) __builtin_amdgcn_mfma_f32_32x32x16_bf16((a), (b), (c), 0, 0, 0)
constexpr int ST_STRIDE = 528, ST_BUF = 64 * ST_STRIDE;
constexpr int RET_X = 0, RET_YV = 65536, RET_YI = 65536 + 16384, RET_ST = 114688;

enum Phase { PH_PROLOGUE = 0, PH_GEMM_A, PH_DSA, PH_OUT_A, PH_UP0, PH_DOWN0, PH_GEMM_B, PH_R1, PH_RET, PH_XB2, PH_GATE, PH_OUT_B, PH_UP1, PH_DOWN1, PH_FINAL, PH_COUNT };

__device__ __forceinline__ void transpose_item(const float* W, const float* gain, int K, int N, int Npad, bf16_t* WT, LAS float* scr, int item, int lane) {
    const int nblk = Npad / 32, kb = item / nblk, nb = item % nblk, k0 = 64 * kb, n0 = 32 * nb;
    const int nn = n0 + (lane & 31);
#pragma unroll 8
    for (int i = 0; i < 32; ++i) { const int kk = 2 * i + (lane >> 5); float v = 0.f; if (nn < N) { v = W[(size_t)(k0 + kk) * N + nn]; if (gain) v *= gain[k0 + kk]; } scr[kk * 33 + (lane & 31)] = v; }
    asm volatile("s_waitcnt lgkmcnt(0)" ::: "memory");
    const int c = lane & 7;
#pragma unroll
    for (int j = 0; j < 4; ++j) { const int n = (lane >> 3) + 8 * j; const LAS float* s = scr + (8 * c) * 33 + n;
        u32x4 o; o.x = pk2(s[0 * 33], s[1 * 33]); o.y = pk2(s[2 * 33], s[3 * 33]); o.z = pk2(s[4 * 33], s[5 * 33]); o.w = pk2(s[6 * 33], s[7 * 33]);
        *(u32x4*)(WT + (size_t)(n0 + n) * K + k0 + 8 * c) = o; }
    asm volatile("s_waitcnt lgkmcnt(0)" ::: "memory");
}


typedef short v4i16_t __attribute__((ext_vector_type(4)));
constexpr int DSA_SEL_OFF = RING_BYTES + 1024, DSA_RED_OFF = DSA_SEL_OFF + 4096, DSA_TOT_OFF = DSA_RED_OFF + 512, DSA_RES_OFF = DSA_TOT_OFF + 256;
static_assert(DSA_RES_OFF + 128 <= LDS_BYTES, "DSA LDS map");
__device__ __forceinline__ unsigned okey(float f) { unsigned u = __float_as_uint(f); if ((u << 1) == 0u) u = 0u; return (u & 0x80000000u) ? ~u : (u | 0x80000000u); }
#define MFMA16(a, b, c) __builtin_amdgcn_mfma_f32_16x16x32_bf16((a), (b), (c), 0, 0, 0)

template <class Tv> __device__ __forceinline__ Tv ldu(const void* ubase, unsigned voff) { return *(const Tv*)((const char*)ubase + voff); }

__device__ __forceinline__ void dsa_phase(LAS unsigned char* lds, const bf16_t* __restrict__ q, const bf16_t* __restrict__ k, const bf16_t* __restrict__ v, const bf16_t* __restrict__ qi, const bf16_t* __restrict__ ki,
                                          const float* __restrict__ wi, bf16_t* __restrict__ o, int vcu, int G, int tid_, int lane_, int wave) {
    LAS unsigned short* selbuf = (LAS unsigned short*)(lds + DSA_SEL_OFF);
    LAS unsigned* red = (LAS unsigned*)(lds + DSA_RED_OFF);
    LAS unsigned* tot = (LAS unsigned*)(lds + DSA_TOT_OFF);
    const int npu = 2048;
    const bool even = (npu % G) == 0; const int per = even ? npu / G : 0;
    int par = 0;
    for (int it = 0;; ++it) {
        int pu; if (even) { if (it >= per) break; pu = vcu * per + it; } else { pu = it * G + vcu; if (pu >= npu) break; }
        const int b = pu >> 8, pr = pu & 255;
#pragma unroll 1
        for (int which = 0; which < 2; ++which) {
            int lane = lane_; asm volatile("" : "+v"(lane));
            const int tid = wave * 64 + lane;
            const int hf = lane >> 5, l31 = lane & 31, fr = lane & 15, fq = lane >> 4;
            LAS unsigned char* vbuf = lds + wave * 16384;
            const int g = which ? 511 - pr : pr; const int t0 = 8 * g; const size_t tok0 = (size_t)b * SEQ + t0;
            for (int repi_ = 0; repi_ < 1 + (int)((PROBE_MASK >> 7) & 1u); ++repi_) {
            __syncthreads();
            if (t0 + 7 < TOPK) {
                for (int i = tid; i < 2048; i += NTHREADS) { const int ql = i >> 8, p = i & 255; selbuf[i] = (unsigned short)((p <= t0 + ql) ? p : 0xFFFF); }
            } else {
                const int nkt = ((t0 + 7) >> 5) + 1;
                const unsigned kvoff = (unsigned)(l31 * 128 + 16 * hf);
                const bf16_t* qib = qi + tok0 * 512; const float* wib = wi + tok0 * 8;
                bf16x8 af[2][4]; f32x4 wlo[2][2], whi[2][2];
#pragma unroll
                for (int rt = 0; rt < 2; ++rt) {
                    const int qla = 4 * rt + 2 * ((l31 >> 2) & 1) + (l31 >> 4), hd = (l31 & 3) + 4 * ((l31 >> 3) & 1);
                    const unsigned aoff = (unsigned)((qla * 512 + hd * 64 + 8 * hf) * 2);
#pragma unroll
                    for (int sk = 0; sk < 4; ++sk) af[rt][sk] = ldu<bf16x8>(qib, aoff + 32 * sk);
#pragma unroll
                    for (int j = 0; j < 2; ++j) { const unsigned woff = (unsigned)((4 * rt + 2 * hf + j) * 32); wlo[rt][j] = ldu<f32x4>(wib, woff); whi[rt][j] = ldu<f32x4>(wib, woff + 16); }
                }
                unsigned key[16][4];
                unsigned kvoff_ = kvoff;
#pragma unroll
                for (int i = 0; i < 16; ++i) {
                    const int kt = wave + 8 * i;
                    if (kt < nkt) {
                        const bf16_t* bpu = ki + ((size_t)b * SEQ + 32 * kt) * 64;
                        bf16x8 bfr[4];
#pragma unroll
                        for (int sk = 0; sk < 4; ++sk) bfr[sk] = ldu<bf16x8>(bpu, kvoff_ + 32 * sk);
                        const int kidx = 32 * kt + l31;
#pragma unroll
                        for (int rt = 0; rt < 2; ++rt) {
                            f32x16 acc;
#pragma unroll
                            for (int r = 0; r < 16; ++r) acc[r] = 0.f;
#pragma unroll
                            for (int sk = 0; sk < 4; ++sk) acc = MFMA32(af[rt][sk], bfr[sk], acc);
#pragma unroll
                            for (int j = 0; j < 2; ++j) {
                                float sc = 0.f;
#pragma unroll
                                for (int h = 0; h < 4; ++h) sc += fmaxf(acc[8 * j + h], 0.f) * wlo[rt][j][h];
#pragma unroll
                                for (int h = 0; h < 4; ++h) sc += fmaxf(acc[8 * j + 4 + h], 0.f) * whi[rt][j][h];
                                const int tq = t0 + 4 * rt + 2 * hf + j;
                                key[i][rt * 2 + j] = (kidx <= tq) ? okey(sc) : 0u;
                            }
                        }
                    } else {
#pragma unroll
                        for (int q4 = 0; q4 < 4; ++q4) key[i][q4] = 0u;
                    }
                }
#if (PROBE_MASK >> 10) & 1
                { unsigned ks_ = 0u;
#pragma unroll
                  for (int i = 0; i < 16; ++i) ks_ ^= key[i][0] ^ key[i][1] ^ key[i][2] ^ key[i][3];
                  asm volatile("" :: "v"(ks_)); }
                asm volatile("" : "+v"(kvoff_) :: "memory");
#pragma unroll
                for (int i = 0; i < 16; ++i) {
                    const int kt = wave + 8 * i;
                    if (kt < nkt) {
                        const bf16_t* bpu = ki + ((size_t)b * SEQ + 32 * kt) * 64;
                        bf16x8 bfr[4];
#pragma unroll
                        for (int sk = 0; sk < 4; ++sk) bfr[sk] = ldu<bf16x8>(bpu, kvoff_ + 32 * sk);
                        const int kidx = 32 * kt + l31;
#pragma unroll
                        for (int rt = 0; rt < 2; ++rt) {
                            f32x16 acc;
#pragma unroll
                            for (int r = 0; r < 16; ++r) acc[r] = 0.f;
#pragma unroll
                            for (int sk = 0; sk < 4; ++sk) acc = MFMA32(af[rt][sk], bfr[sk], acc);
#pragma unroll
                            for (int j = 0; j < 2; ++j) {
                                float sc = 0.f;
#pragma unroll
                                for (int h = 0; h < 4; ++h) sc += fmaxf(acc[8 * j + h], 0.f) * wlo[rt][j][h];
#pragma unroll
                                for (int h = 0; h < 4; ++h) sc += fmaxf(acc[8 * j + 4 + h], 0.f) * whi[rt][j][h];
                                const int tq = t0 + 4 * rt + 2 * hf + j;
                                key[i][rt * 2 + j] = (kidx <= tq) ? okey(sc) : 0u;
                            }
                        }
                    } else {
#pragma unroll
                        for (int q4 = 0; q4 < 4; ++q4) key[i][q4] = 0u;
                    }
                }
#endif
#define DSA_REDUCE(PRED, TOT) do { unsigned c01 = 0u, c23 = 0u; \
        _Pragma("unroll") for (int i = 0; i < 16; ++i) { c01 += (PRED(i, 0) ? 1u : 0u) + (PRED(i, 1) ? 0x10000u : 0u); c23 += (PRED(i, 2) ? 1u : 0u) + (PRED(i, 3) ? 0x10000u : 0u); } \
        _Pragma("unroll") for (int o_ = 1; o_ < 32; o_ <<= 1) { c01 += __shfl_xor(c01, o_); c23 += __shfl_xor(c23, o_); } \
        if (l31 == 0) { LAS unsigned* rp = red + (par * 8 + wave) * 8 + 2 * hf; rp[0] = c01 & 0xffffu; rp[1] = c01 >> 16; rp[4] = c23 & 0xffffu; rp[5] = c23 >> 16; } \
        __syncthreads(); \
        TOT[0] = 0u; TOT[1] = 0u; TOT[2] = 0u; TOT[3] = 0u; \
        _Pragma("unroll") for (int w_ = 0; w_ < 8; ++w_) { const LAS unsigned* rp = red + (par * 8 + w_) * 8 + 2 * hf; const u32x2 x_ = *(const LAS u32x2*)rp, y_ = *(const LAS u32x2*)(rp + 4); TOT[0] += x_.x; TOT[1] += x_.y; TOT[2] += y_.x; TOT[3] += y_.y; } \
        par ^= 1; } while (0)
                LAS unsigned* hist = (LAS unsigned*)lds;
                LAS unsigned* res = (LAS unsigned*)(lds + DSA_RES_OFF);
                unsigned thr[4], need[4], ceq[4], icut[4], mid[4]; bool tie[4];
#pragma unroll
                for (int q4 = 0; q4 < 4; ++q4) { thr[q4] = 0u; need[q4] = (unsigned)TOPK; ceq[q4] = 0u; }
                const int hb0 = (2 * hf) * 2048, hb1 = (2 * hf + 1) * 2048, hb2 = (4 + 2 * hf) * 2048, hb3 = (5 + 2 * hf) * 2048;
#define RADIX_PASS(SHIFT, BITS, FIRST) do { \
        for (int i_ = tid; i_ < 4096; i_ += NTHREADS) ((LAS u32x4*)hist)[i_] = (u32x4){0u, 0u, 0u, 0u}; \
        __syncthreads(); \
        _Pragma("unroll") for (int i = 0; i < 16; ++i) if (wave + 8 * i < nkt) { \
            { const unsigned k_ = key[i][0]; const unsigned m_ = (FIRST) ? 1u : ((((k_ >> ((SHIFT) + (BITS) - 1)) >> 1) == thr[0]) ? 1u : 0u); __hip_atomic_fetch_add(hist + hb0 + ((k_ >> (SHIFT)) & ((1u << (BITS)) - 1u)), m_, __ATOMIC_RELAXED, __HIP_MEMORY_SCOPE_WORKGROUP); } \
            { const unsigned k_ = key[i][1]; const unsigned m_ = (FIRST) ? 1u : ((((k_ >> ((SHIFT) + (BITS) - 1)) >> 1) == thr[1]) ? 1u : 0u); __hip_atomic_fetch_add(hist + hb1 + ((k_ >> (SHIFT)) & ((1u << (BITS)) - 1u)), m_, __ATOMIC_RELAXED, __HIP_MEMORY_SCOPE_WORKGROUP); } \
            { const unsigned k_ = key[i][2]; const unsigned m_ = (FIRST) ? 1u : ((((k_ >> ((SHIFT) + (BITS) - 1)) >> 1) == thr[2]) ? 1u : 0u); __hip_atomic_fetch_add(hist + hb2 + ((k_ >> (SHIFT)) & ((1u << (BITS)) - 1u)), m_, __ATOMIC_RELAXED, __HIP_MEMORY_SCOPE_WORKGROUP); } \
            { const unsigned k_ = key[i][3]; const unsigned m_ = (FIRST) ? 1u : ((((k_ >> ((SHIFT) + (BITS) - 1)) >> 1) == thr[3]) ? 1u : 0u); __hip_atomic_fetch_add(hist + hb3 + ((k_ >> (SHIFT)) & ((1u << (BITS)) - 1u)), m_, __ATOMIC_RELAXED, __HIP_MEMORY_SCOPE_WORKGROUP); } } \
        __syncthreads(); \
        {   \
          const LAS unsigned* hq = hist + wave * 2048; const unsigned K_ = (FIRST) ? (unsigned)TOPK : res[wave * 4 + 1]; \
          unsigned s_ = 0u; \
          _Pragma("unroll") for (int j_ = 0; j_ < 8; ++j_) { const u32x4 h4 = *(const LAS u32x4*)(hq + 32 * lane + 4 * j_); s_ += (h4.x + h4.y) + (h4.z + h4.w); } \
          unsigned x_ = s_; \
          _Pragma("unroll") for (int o_ = 1; o_ < 64; o_ <<= 1) { const unsigned t_ = __shfl_down(x_, o_); if (lane + o_ < 64) x_ += t_; } \
          const unsigned T_ = x_ - s_; \
          const unsigned long long bm_ = __ballot(T_ < K_ && x_ >= K_); \
          const int Ls_ = (int)__builtin_ctzll(bm_ | 0x8000000000000000ull); \
          const unsigned Ts_ = __shfl(T_, Ls_); \
          const unsigned hv_ = (lane < 32) ? hq[32 * Ls_ + lane] : 0u; \
          unsigned x2_ = hv_; \
          _Pragma("unroll") for (int o_ = 1; o_ < 32; o_ <<= 1) { const unsigned t_ = __shfl_down(x2_, o_); if (lane + o_ < 64) x2_ += t_; } \
          const unsigned T2_ = Ts_ + x2_ - hv_; \
          if (lane < 32 && T2_ < K_ && T2_ + hv_ >= K_) { LAS unsigned* rp = res + wave * 4; rp[0] = (unsigned)(32 * Ls_ + lane); rp[1] = K_ - T2_; rp[2] = hv_; } } \
        __syncthreads(); \
        _Pragma("unroll") for (int q4 = 0; q4 < 4; ++q4) { const int ql_ = 4 * (q4 >> 1) + 2 * hf + (q4 & 1); const u32x4 r4 = *(const LAS u32x4*)(res + ql_ * 4); thr[q4] = (thr[q4] << (BITS)) | r4.x; need[q4] = r4.y; ceq[q4] = r4.z; } \
    } while (0)
                RADIX_PASS(21, 11, true);
                RADIX_PASS(10, 11, false);
                RADIX_PASS(0, 10, false);
#if (PROBE_MASK >> 9) & 1
#pragma unroll
                for (int q4 = 0; q4 < 4; ++q4) thr[q4] = 0u;
                RADIX_PASS(21, 11, true);
                RADIX_PASS(10, 11, false);
                RADIX_PASS(0, 10, false);
#endif
#if (PROBE_MASK >> 12) & 1
#pragma unroll
                for (int q4 = 0; q4 < 4; ++q4) thr[q4] = 0u;
                RADIX_PASS(21, 11, true);
                thr[0] = 0u; thr[1] = 0u; thr[2] = 0u; thr[3] = 0u;
                RADIX_PASS(21, 11, true);
                RADIX_PASS(10, 11, false);
                RADIX_PASS(0, 10, false);
#endif
#undef RADIX_PASS
                bool anyt = false;
#pragma unroll
                for (int q4 = 0; q4 < 4; ++q4) { tie[q4] = need[q4] < ceq[q4]; icut[q4] = (unsigned)(SEQ - 1); anyt = anyt || tie[q4]; }
                const bool anytie = __any(anyt);
                if (anytie) {
                    unsigned ilo[4], ihi[4];
#pragma unroll
                    for (int q4 = 0; q4 < 4; ++q4) { ilo[q4] = 0u; ihi[q4] = (unsigned)(SEQ - 1); }
#pragma unroll 1
                    for (int iter = 0; iter < 12; ++iter) {
#pragma unroll
                        for (int q4 = 0; q4 < 4; ++q4) mid[q4] = (ilo[q4] + ihi[q4]) >> 1;
                        unsigned ce[4];
#define P_EQ(i, q4) (key[i][q4] == thr[q4] && (unsigned)(32 * (wave + 8 * i) + l31) <= mid[q4])
                        DSA_REDUCE(P_EQ, ce);
#undef P_EQ
#pragma unroll
                        for (int q4 = 0; q4 < 4; ++q4) { if (ce[q4] >= need[q4]) ihi[q4] = mid[q4]; else ilo[q4] = mid[q4] + 1u; }
                    }
#pragma unroll
                    for (int q4 = 0; q4 < 4; ++q4) if (tie[q4]) icut[q4] = ihi[q4];
                }
#define P_SEL(i, q4) (key[i][q4] > thr[q4] || (key[i][q4] == thr[q4] && (unsigned)(32 * (wave + 8 * i) + l31) <= icut[q4]))
                for (int repe_ = 0; repe_ < 1 + (int)((PROBE_MASK >> 11) & 1u); ++repe_) {
                    __syncthreads();
                    unsigned n01 = 0u, n23 = 0u;
#pragma unroll
                    for (int i = 0; i < 16; ++i) { n01 += (P_SEL(i, 0) ? 1u : 0u) + (P_SEL(i, 1) ? 0x10000u : 0u); n23 += (P_SEL(i, 2) ? 1u : 0u) + (P_SEL(i, 3) ? 0x10000u : 0u); }
                    unsigned x01 = n01, x23 = n23;
#pragma unroll
                    for (int o_ = 1; o_ < 32; o_ <<= 1) { const unsigned t01 = __shfl_up(x01, o_, 32), t23 = __shfl_up(x23, o_, 32); if (l31 >= o_) { x01 += t01; x23 += t23; } }
                    if (l31 == 31) { LAS unsigned* tp = tot + wave * 8 + 2 * hf; tp[0] = x01 & 0xffffu; tp[1] = x01 >> 16; tp[4] = x23 & 0xffffu; tp[5] = x23 >> 16; }
                    __syncthreads();
                    unsigned pos[4]; pos[0] = (x01 - n01) & 0xffffu; pos[1] = (x01 - n01) >> 16; pos[2] = (x23 - n23) & 0xffffu; pos[3] = (x23 - n23) >> 16;
#pragma unroll
                    for (int w_ = 0; w_ < 8; ++w_) if (w_ < wave) { const LAS unsigned* tp = tot + w_ * 8 + 2 * hf; pos[0] += tp[0]; pos[1] += tp[1]; pos[2] += tp[4]; pos[3] += tp[5]; }
#pragma unroll
                    for (int i = 0; i < 16; ++i)
#pragma unroll
                        for (int q4 = 0; q4 < 4; ++q4) if (P_SEL(i, q4)) { const int ql = 4 * (q4 >> 1) + 2 * hf + (q4 & 1); selbuf[ql * 256 + (pos[q4] & 255u)] = (unsigned short)(32 * (wave + 8 * i) + l31); pos[q4]++; }
                }
#undef P_SEL
#undef DSA_REDUCE
            }
            }
            __syncthreads();
            for (int repa_ = 0; repa_ < 1 + (int)((PROBE_MASK >> 8) & 1u); ++repa_) {
                const size_t tok = tok0 + wave; const int t = t0 + wave;
                const LAS unsigned short* sel = selbuf + wave * 256;
                const bf16_t* qb = q + tok * 1024; const bf16_t* kb = k + (size_t)b * SEQ * 128; const bf16_t* vb = v + (size_t)b * SEQ * 128;
                bf16x8 qf[4];
                { const unsigned qoff = (unsigned)(((fr & 7) * 128 + 8 * fq) * 2);
#pragma unroll
                  for (int sk = 0; sk < 4; ++sk) qf[sk] = ldu<bf16x8>(qb, qoff + 64 * sk); }
                f32x4 lg[16];
#pragma unroll
                for (int kt = 0; kt < 16; ++kt) {
                    unsigned ix = sel[16 * kt + fr]; ix = (ix == 0xFFFFu) ? 0u : ix;
                    const unsigned koff = ix * 256u + 16u * fq;
                    f32x4 acc = (f32x4){0.f, 0.f, 0.f, 0.f};
#pragma unroll
                    for (int sk = 0; sk < 4; ++sk) { const bf16x8 ka = ldu<bf16x8>(kb, koff + 64 * sk); acc = MFMA16(ka, qf[sk], acc); }
#pragma unroll
                    for (int r = 0; r < 4; ++r) { const int p = 16 * kt + 4 * fq + r; lg[kt][r] = (t >= TOPK - 1 || p <= t) ? acc[r] : -INFINITY; }
                }
                float mx = -INFINITY;
#pragma unroll
                for (int kt = 0; kt < 16; ++kt) mx = fmaxf(fmaxf(mx, fmaxf(lg[kt][0], lg[kt][1])), fmaxf(lg[kt][2], lg[kt][3]));
                mx = fmaxf(mx, __shfl_xor(mx, 16)); mx = fmaxf(mx, __shfl_xor(mx, 32));
                float sm = 0.f;
#pragma unroll
                for (int kt = 0; kt < 16; ++kt)
#pragma unroll
                    for (int r = 0; r < 4; ++r) { const float e = exp2f(lg[kt][r] - mx); lg[kt][r] = e; sm += e; }
                sm += __shfl_xor(sm, 16); sm += __shfl_xor(sm, 32);
                bf16x8 pb[8];
#pragma unroll
                for (int u = 0; u < 8; ++u) { u32x4 w; w.x = pk2(lg[2 * u][0], lg[2 * u][1]); w.y = pk2(lg[2 * u][2], lg[2 * u][3]); w.z = pk2(lg[2 * u + 1][0], lg[2 * u + 1][1]); w.w = pk2(lg[2 * u + 1][2], lg[2 * u + 1][3]);
                    pb[u] = __builtin_bit_cast(bf16x8, w); }
                f32x4 oacc[8];
#pragma unroll
                for (int dt = 0; dt < 8; ++dt) oacc[dt] = (f32x4){0.f, 0.f, 0.f, 0.f};
                u32x4 vr[8];
#define V_LOAD(u) do { _Pragma("unroll") for (int i = 0; i < 8; ++i) { const int rr = fq + 4 * i; unsigned ix = sel[32 * (u) + rr]; ix = (ix == 0xFFFFu) ? 0u : ix; vr[i] = ldu<u32x4>(vb, ix * 256u + 16u * fr); } } while (0)
#define V_WRITE(buf) do { _Pragma("unroll") for (int i = 0; i < 8; ++i) { const int rr = fq + 4 * i; *(LAS u32x4*)(vbuf + (buf) * 8192 + rr * 256 + 16 * (fr ^ ((rr & 7) << 1))) = vr[i]; } } while (0)
                V_LOAD(0); V_WRITE(0);
                const int qq = fr >> 2, pp = fr & 3;
#pragma unroll
                for (int u = 0; u < 8; ++u) {
                    if (u + 1 < 8) V_LOAD(u + 1);
                    const LAS unsigned char* vbase = vbuf + (u & 1) * 8192;
                    const int rA = 4 * fq + qq, rB = 16 + 4 * fq + qq;
#pragma unroll
                    for (int dt = 0; dt < 8; ++dt) {
                        const int ch = 2 * dt + (pp >> 1);
                        const v4i16_t alo = __builtin_amdgcn_ds_read_tr16_b64_v4i16((LAS v4i16_t*)(vbase + rA * 256 + 16 * (ch ^ ((rA & 7) << 1)) + 8 * (pp & 1)));
                        const v4i16_t ahi = __builtin_amdgcn_ds_read_tr16_b64_v4i16((LAS v4i16_t*)(vbase + rB * 256 + 16 * (ch ^ ((rB & 7) << 1)) + 8 * (pp & 1)));
                        bf16x8 va; va[0] = alo[0]; va[1] = alo[1]; va[2] = alo[2]; va[3] = alo[3]; va[4] = ahi[0]; va[5] = ahi[1]; va[6] = ahi[2]; va[7] = ahi[3];
                        oacc[dt] = MFMA16(va, pb[u], oacc[dt]);
                    }
                    if (u + 1 < 8) V_WRITE((u + 1) & 1);
                }
#undef V_LOAD
#undef V_WRITE
                const float inv = 1.0f / sm;
                if (fr < 8) { bf16_t* op = o + tok * 1024 + fr * 128 + 4 * fq;
#pragma unroll
                    for (int dt = 0; dt < 8; ++dt) *(u32x2*)(op + 16 * dt) = pk4(oacc[dt] * inv); }
            }
        }
    }
}

__global__ void __launch_bounds__(NTHREADS, 2) mk_fwd(Args a) {
    extern __shared__ __attribute__((aligned(16))) unsigned char lds_raw[];
    LAS unsigned char* lds = (LAS unsigned char*)lds_raw;
    const int tid = threadIdx.x, lane = tid & 63, wave = __builtin_amdgcn_readfirstlane(tid >> 6);
    const int G = gridDim.x, bx = blockIdx.x;
    const int vcu = (G % 8 == 0) ? (bx % 8) * (G / 8) + bx / 8 : bx;
    unsigned char* ws = a.ws;
    float* ssq = (float*)(ws + WS_SSQ);
    const int lo = a.ph_lo, hi = a.ph_hi;
#define IN(k) (lo <= (k) && (k) < hi)
#define SEAM(k) do { if (IN(k) && IN((k) + 1)) xcd_barrier(bar); } while (0)
    for (int u = tid; u < (LDS_BYTES - LDSCTL_OFF) / 4; u += NTHREADS) ((LAS unsigned*)(lds + LDSCTL_OFF))[u] = 0u;
    __syncthreads();
    XcdBarrier bar; bar.bar = (unsigned*)(ws + WS_CTL) + CW_BAR + a.li * XCD_BAR_WORDS; bar.x = 0; bar.st = nullptr;
    if (hi - lo > 1) { cg::this_grid().sync(); bar = xcd_barrier_post(bar.bar, (volatile LAS unsigned*)(lds + MISC_OFF) + 8); }

    if (IN(PH_PROLOGUE)) for (int rep_ = 0; rep_ < 1 + (int)((PROBE_MASK >> 3) & 1u); ++rep_) {
        LAS float* scr = (LAS float*)(lds + wave * 16384);
        const int gw = vcu * NWAVES + wave, NGW = G * NWAVES;
        int base = 0;
#define CONV(Wp, gp, K_, N_, Np_, dst) do { const int n_ = ((K_) / 64) * ((Np_) / 32); int first = gw - (base % NGW); if (first < 0) first += NGW; \
            for (int it = first; it < n_; it += NGW) transpose_item(Wp, gp, K_, N_, Np_, (bf16_t*)(ws + (dst)), scr, it, lane); base += n_; } while (0)
        CONV(a.w_in_a, a.norm_mix_g, D, A_IN, A_PAD, WS_WA);
        CONV(a.w_out_a, (const float*)nullptr, D, D, D, WS_WOA);
        CONV(a.w_mlp_up, a.norm_mlp_g, D, FF, FF, WS_WUP0);
        CONV(a.w_mlp_down, (const float*)nullptr, FF, D, D, WS_WDN0);
        CONV(a.w_in_b, a.norm_mix_g + D, D, B_IN, B_IN, WS_WB);
        CONV(a.w_out_b, a.ret_norm_g, 2048, D, D, WS_WOB);
        CONV(a.w_mlp_up + (size_t)D * FF, a.norm_mlp_g + D, D, FF, FF, WS_WUP1);
        CONV(a.w_mlp_down + (size_t)FF * D, (const float*)nullptr, FF, D, D, WS_WDN1);
#undef CONV
        bf16_t* xb = (bf16_t*)(ws + WS_XBHI);
        for (int row = gw; row < T; row += NGW) {
            const f32x4* xr = (const f32x4*)(a.x + (size_t)row * D) + lane; f32x4* hr = (f32x4*)(a.out + (size_t)row * D) + lane; u32x2* xo = (u32x2*)(xb + (size_t)row * D) + lane;
            float s = 0.f;
#pragma unroll
            for (int j = 0; j < 4; ++j) { const f32x4 v = xr[64 * j]; hr[64 * j] = v; xo[64 * j] = pk4(v); s += (v.x * v.x + v.y * v.y) + (v.z * v.z + v.w * v.w); }
            s = wave_sum(s);
            if (lane < 16) ssq[(size_t)row * 16 + lane] = (lane == 0) ? s : 0.f;
        }
        const int gt = vcu * NTHREADS + tid, NGT = G * NTHREADS;
        f32x2* tabA = (f32x2*)(ws + WS_TABA); f32x2* tabI = (f32x2*)(ws + WS_TABI); f32x2* tabR = (f32x2*)(ws + WS_TABR);
        for (int i = gt; i < SEQ * 152; i += NGT) {
            const int p = i / 152, r = i % 152; double inv; f32x2* dst;
            if (r < 16) { inv = pow(500000.0, -(double)r / 16.0); dst = tabA + p * 16 + r; }
            else if (r < 24) { inv = pow(500000.0, -(double)(r - 16) / 8.0); dst = tabI + p * 8 + (r - 16); }
            else { inv = pow(10000.0, -(double)(r - 24) / 128.0); dst = tabR + p * 128 + (r - 24); }
            const double ang = (double)p * inv; f32x2 cs; cs.x = (float)cos(ang); cs.y = (float)sin(ang); *dst = cs;
        }
    }

    SEAM(PH_PROLOGUE);
#ifdef GEMM_NAIVE
#define RUN_GEMM_REP(BIT, EPI, SWAPV, g, E) RUN_GEMM(EPI, SWAPV, g, E)
#define RUN_GEMM(EPI, SWAPV, g, E) do { pg8::StaticOrder S_; S_.init((g).M, (g).N, G, bx); pg8::gemm_naive<EPI, pg8::StaticOrder, SWAPV>(g, S_, E); } while (0)
#else
#define RUN_GEMM(EPI, SWAPV, g, E) do { pg8::StaticOrder S_; S_.init((g).M, (g).N, G, bx); pg8::gemm_phase<EPI, pg8::StaticOrder, true, true, SWAPV>(lds, g, S_, E); } while (0)
#define RUN_GEMM_REP(BIT, EPI, SWAPV, g, E) do { for (int rep_ = 0; rep_ < 1 + (int)((PROBE_MASK >> (BIT)) & 1u); ++rep_) RUN_GEMM(EPI, SWAPV, g, E); } while (0)
#endif

    if (IN(PH_GEMM_A)) {
        pg8::Gemm g{(const bf16_t*)(ws + WS_XBHI), (const bf16_t*)(ws + WS_WA), T, A_PAD, D};
        EpiA E{ssq, a.pos, (const f32x2*)(ws + WS_TABA), (const f32x2*)(ws + WS_TABI), (bf16_t*)(ws + WS_Q), (bf16_t*)(ws + WS_K), (bf16_t*)(ws + WS_V), (bf16_t*)(ws + WS_QI), (bf16_t*)(ws + WS_KI), (float*)(ws + WS_WI), false};
        RUN_GEMM_REP(5, EpiA, false, g, E);
    }
    SEAM(PH_GEMM_A);
    if (IN(PH_DSA)) for (int rep_ = 0; rep_ < 1 + (int)((PROBE_MASK >> 1) & 1u); ++rep_) dsa_phase(lds, (const bf16_t*)(ws + WS_Q), (const bf16_t*)(ws + WS_K), (const bf16_t*)(ws + WS_V), (const bf16_t*)(ws + WS_QI), (const bf16_t*)(ws + WS_KI), (const float*)(ws + WS_WI), (bf16_t*)(ws + WS_O), vcu, G, tid, lane, wave);
    SEAM(PH_DSA);
    if (IN(PH_OUT_A)) {
        pg8::Gemm g{(const bf16_t*)(ws + WS_O), (const bf16_t*)(ws + WS_WOA), T, D, D};
        EpiResid E{a.out, (bf16_t*)(ws + WS_XBHI), ssq, false};
        RUN_GEMM(EpiResid, false, g, E);
    }
    SEAM(PH_OUT_A);
    if (IN(PH_UP0)) {
        pg8::Gemm g{(const bf16_t*)(ws + WS_XBHI), (const bf16_t*)(ws + WS_WUP0), T, FF, D};
        EpiUp E{ssq, (bf16_t*)(ws + WS_HID0), false};
        RUN_GEMM_REP(0, EpiUp, false, g, E);
    }
    SEAM(PH_UP0);
    if (IN(PH_DOWN0)) {
        pg8::Gemm g{(const bf16_t*)(ws + WS_HID0), (const bf16_t*)(ws + WS_WDN0), T, D, FF};
        EpiResid E{a.out, (bf16_t*)(ws + WS_XBHI), ssq, false};
        RUN_GEMM(EpiResid, false, g, E);
    }
    SEAM(PH_DOWN0);
    if (IN(PH_GEMM_B)) {
        { pg8::Gemm g{(const bf16_t*)(ws + WS_XBHI), (const bf16_t*)(ws + WS_WB), T, 2048, D};
          EpiBqk E{ssq, a.pos, (const f32x2*)(ws + WS_TABR), (bf16_t*)(ws + WS_Q1), (bf16_t*)(ws + WS_K1), false};
          RUN_GEMM_REP(6, EpiBqk, false, g, E); }
        { pg8::Gemm g{(const bf16_t*)(ws + WS_XBHI), (const bf16_t*)(ws + WS_WB) + (size_t)2048 * D, T, 2048, D};
          EpiBv E{ssq, (bf16_t*)(ws + WS_VT), false};
          RUN_GEMM_REP(6, EpiBv, true, g, E); }
    }
    SEAM(PH_GEMM_B);
    if (IN(PH_R1)) {
        const bf16_t* q1 = (const bf16_t*)(ws + WS_Q1); bf16_t* k1 = (bf16_t*)(ws + WS_K1); bf16_t* inner = (bf16_t*)(ws + WS_INNER);
        const int hf = lane >> 5, l31 = lane & 31;
        for (int u = vcu; u < 1024; u += G) {
            const int c = u & 31, bh = u >> 5, h = bh & 3, b = bh >> 2;
            const size_t row0 = (size_t)b * SEQ + (size_t)c * 128;
            const float l2g = log2f(1.0f - exp2f(-5.0f - (float)h));
            for (int ti = wave; ti < 10; ti += 8) {
                int mt, nt; if (ti < 4) { mt = 0; nt = ti; } else if (ti < 7) { mt = 1; nt = ti - 3; } else if (ti < 9) { mt = 2; nt = ti - 5; } else { mt = 3; nt = 3; }
                f32x16 acc;
#pragma unroll
                for (int r = 0; r < 16; ++r) acc[r] = 0.f;
                const bf16_t* ap = k1 + (row0 + 32 * mt + l31) * 1024 + h * 256 + 8 * hf;
                const bf16_t* bp = q1 + (row0 + 32 * nt + l31) * 1024 + h * 256 + 8 * hf;
#pragma unroll
                for (int sk = 0; sk < 16; ++sk) { const bf16x8 av = *(const bf16x8*)(ap + 16 * sk), bv = *(const bf16x8*)(bp + 16 * sk); acc = MFMA32(av, bv, acc); }
                const int n = 32 * nt + l31;
                bf16_t* orow = inner + ((size_t)u * 128 + n) * 128;
#pragma unroll
                for (int rg = 0; rg < 4; ++rg) { const int m0 = 32 * mt + 8 * rg + 4 * hf; f32x4 vv;
#pragma unroll
                    for (int j = 0; j < 4; ++j) { const int m = m0 + j; vv[j] = (m <= n) ? acc[4 * rg + j] * exp2f(-(float)(m + 1) * l2g) : 0.f; }
                    *(u32x2*)(orow + m0) = pk4(vv); }
            }
            const int d = tid & 255, mh = tid >> 8;
            u32x4 pk[8];
#pragma unroll
            for (int i = 0; i < 8; ++i) { const int m0 = 8 * (8 * mh + i); float f[8];
#pragma unroll
                for (int j = 0; j < 8; ++j) f[j] = bf2f(k1[(row0 + m0 + j) * 1024 + h * 256 + d]) * exp2f((float)(127 - (m0 + j)) * l2g);
                pk[i].x = pk2(f[0], f[1]); pk[i].y = pk2(f[2], f[3]); pk[i].z = pk2(f[4], f[5]); pk[i].w = pk2(f[6], f[7]); }
            asm volatile("s_waitcnt vmcnt(0)" ::: "memory");
            __syncthreads();
#pragma unroll
            for (int i = 0; i < 8; ++i) { const int m0 = 8 * (8 * mh + i); *(u32x4*)(k1 + (row0 + (d >> 1)) * 1024 + h * 256 + (d & 1) * 128 + m0) = pk[i]; }
        }
    }
    SEAM(PH_R1);
    if (IN(PH_RET)) {
        const bf16_t* q1 = (const bf16_t*)(ws + WS_Q1); const bf16_t* kz = (const bf16_t*)(ws + WS_K1); const bf16_t* inner = (const bf16_t*)(ws + WS_INNER); const bf16_t* vT = (const bf16_t*)(ws + WS_VT);
        bf16_t* y = (bf16_t*)(ws + WS_Y); float* stats = (float*)(ws + WS_STATS);
        const int hf = lane >> 5, l31 = lane & 31, wn = wave >> 1, we = wave & 1;
        for (int rep_ = 0; rep_ < 1 + (int)((PROBE_MASK >> 2) & 1u); ++rep_)
        for (int u = vcu; u < 256; u += G) {
            const int bh = u >> 3, sl = u & 7, b = bh >> 2, h = bh & 3;
            const float l2g = log2f(1.0f - exp2f(-5.0f - (float)h)); const float gC = exp2f(128.0f * l2g);
            const float xi = exp2f((float)(32 * wn + l31 + 1) * l2g);
            f32x16 S0, S1;
#pragma unroll
            for (int r = 0; r < 16; ++r) { S0[r] = 0.f; S1[r] = 0.f; }
            __syncthreads();
            for (int i = tid; i < ST_BUF / 4; i += NTHREADS) ((LAS unsigned*)(lds + RET_ST))[i] = 0u;
            const int t5 = tid >> 5, s5 = tid & 31, t4 = tid >> 4, s4 = tid & 15;
            const unsigned gq = (unsigned)((t5 * 1024 + s5 * 8) * 2);
            const unsigned lq = (unsigned)(t5 * 512 + (((s5 & 16) | ((s5 & 15) ^ t5))) * 16);
            const unsigned lk = (unsigned)(t5 * 512 + (((s5 & 16) | ((s5 & 15) ^ ((2 * t5 + (s5 >> 4)) & 15)))) * 16);
            const unsigned gi = (unsigned)((t4 * 128 + s4 * 8) * 2);
            const unsigned li = (unsigned)(t4 * 256 + ((s4 ^ (t4 & 15))) * 16);
            const unsigned gv = (unsigned)((t4 * SEQ + s4 * 8) * 2);
            const bf16_t* qbase = q1 + (size_t)b * SEQ * 1024 + h * 256; const bf16_t* kbase = kz + (size_t)b * SEQ * 1024 + h * 256;
            const bf16_t* ibase = inner + (size_t)bh * 32 * 128 * 128; const bf16_t* vbase = vT + ((size_t)bh * 512 + 64 * sl) * SEQ;
            u32x4 rq[8], rk[8], ri[4], rv[2];
#define RET_LOAD_Y(c_) do { _Pragma("unroll") for (int i = 0; i < 4; ++i) ri[i] = ldu<u32x4>(ibase + ((size_t)(c_) * 128 + 32 * i) * 128, gi); \
                            _Pragma("unroll") for (int i = 0; i < 2; ++i) rv[i] = ldu<u32x4>(vbase + (size_t)(32 * i) * SEQ + (c_) * 128, gv); } while (0)
#define RET_LOAD_Q(c_) do { _Pragma("unroll") for (int i = 0; i < 8; ++i) rq[i] = ldu<u32x4>(qbase + ((size_t)(c_) * 128 + 16 * i) * 1024, gq); } while (0)
#define RET_LOAD_K(c_) do { _Pragma("unroll") for (int i = 0; i < 8; ++i) rk[i] = ldu<u32x4>(kbase + ((size_t)(c_) * 128 + 16 * i) * 1024, gq); } while (0)
            RET_LOAD_Y(0); RET_LOAD_Q(0);
            const int n = 32 * wn + l31, e = 32 * we + l31, dA = 64 * wn + l31;
            for (int c = 0; c < 32; ++c) {
                const size_t row0 = (size_t)b * SEQ + (size_t)c * 128;
#pragma unroll
                for (int i = 0; i < 4; ++i) *(LAS u32x4*)(lds + RET_YI + i * 8192 + li) = ri[i];
#pragma unroll
                for (int i = 0; i < 2; ++i) *(LAS u32x4*)(lds + RET_YV + i * 8192 + li) = rv[i];
#pragma unroll
                for (int i = 0; i < 8; ++i) *(LAS u32x4*)(lds + RET_X + i * 8192 + lq) = rq[i];
                __syncthreads();
                RET_LOAD_K(c);
                bf16x8 vf[8];
#pragma unroll
                for (int ks = 0; ks < 8; ++ks) vf[ks] = *(const LAS bf16x8*)(lds + RET_YV + e * 256 + (((2 * ks + hf) ^ (e & 15))) * 16);
                f32x16 o;
#pragma unroll
                for (int r = 0; r < 16; ++r) o[r] = 0.f;
#pragma unroll
                for (int mt = 0; mt < 4; ++mt) if (mt <= wn) {
#pragma unroll
                    for (int s2 = 0; s2 < 2; ++s2) { const int ks = 2 * mt + s2; const bf16x8 bv = *(const LAS bf16x8*)(lds + RET_YI + n * 256 + (((2 * ks + hf) ^ (n & 15))) * 16); o = MFMA32(vf[ks], bv, o); } }
                const LAS unsigned char* stp = lds + RET_ST + e * ST_STRIDE + 16 * hf;
#pragma unroll
                for (int sk = 0; sk < 16; ++sk) { const int slot = 2 * sk + hf; const bf16x8 av = *(const LAS bf16x8*)(stp + 32 * sk);
                    const bf16x8 bv = *(const LAS bf16x8*)(lds + RET_X + n * 512 + (((slot & 16) | ((slot & 15) ^ (n & 15)))) * 16); o = MFMA32(av, bv, o); }
                float s1 = 0.f, s2q = 0.f;
#pragma unroll
                for (int r = 0; r < 16; ++r) { o[r] *= xi; s1 += o[r]; s2q += o[r] * o[r]; }
                s1 += __shfl_xor(s1, 32); s2q += __shfl_xor(s2q, 32);
                if (hf == 0) { f32x2 sv; sv.x = s1; sv.y = s2q; *(f32x2*)(stats + (((row0 + n) * 4 + h) * 16 + 2 * sl + we) * 2) = sv; }
                bf16_t* yp = y + (row0 + n) * 2048 + h * 512 + 64 * sl + 32 * we + 4 * hf;
#pragma unroll
                for (int rg = 0; rg < 4; ++rg) { f32x4 vv; vv.x = o[4 * rg]; vv.y = o[4 * rg + 1]; vv.z = o[4 * rg + 2]; vv.w = o[4 * rg + 3]; *(u32x2*)(yp + 8 * rg) = pk4(vv); }
                __syncthreads();
#pragma unroll
                for (int i = 0; i < 8; ++i) *(LAS u32x4*)(lds + RET_X + i * 8192 + lk) = rk[i];
                if (c + 1 < 32) { RET_LOAD_Y(c + 1); RET_LOAD_Q(c + 1); }
                __syncthreads();
#pragma unroll
                for (int r = 0; r < 16; ++r) { S0[r] *= gC; S1[r] *= gC; }
#pragma unroll
                for (int sk = 0; sk < 8; ++sk) {
                    const int d0 = dA, d1 = dA + 32; const int sl0 = 16 * (d0 & 1) + 2 * sk + hf;
                    const bf16x8 a0 = *(const LAS bf16x8*)(lds + RET_X + (d0 >> 1) * 512 + (((sl0 & 16) | ((sl0 & 15) ^ (d0 & 15)))) * 16);
                    const bf16x8 a1 = *(const LAS bf16x8*)(lds + RET_X + (d1 >> 1) * 512 + (((sl0 & 16) | ((sl0 & 15) ^ (d1 & 15)))) * 16);
                    S0 = MFMA32(a0, vf[sk], S0); S1 = MFMA32(a1, vf[sk], S1); }
                LAS unsigned char* stw = lds + RET_ST + e * ST_STRIDE + (64 * wn + 4 * hf) * 2;
#pragma unroll
                for (int rg = 0; rg < 4; ++rg) { f32x4 v0, v1; v0.x = S0[4 * rg]; v0.y = S0[4 * rg + 1]; v0.z = S0[4 * rg + 2]; v0.w = S0[4 * rg + 3]; v1.x = S1[4 * rg]; v1.y = S1[4 * rg + 1]; v1.z = S1[4 * rg + 2]; v1.w = S1[4 * rg + 3];
                    *(LAS u32x2*)(stw + 16 * rg) = pk4(v0); *(LAS u32x2*)(stw + 64 + 16 * rg) = pk4(v1); }
                __syncthreads();
            }
#undef RET_LOAD_Y
#undef RET_LOAD_Q
#undef RET_LOAD_K
        }
    }
    SEAM(PH_RET);
    if (IN(PH_XB2)) for (int rep_ = 0; rep_ < 1 + 2 * (int)((PROBE_MASK >> 4) & 1u); ++rep_) {
        const int gw = vcu * NWAVES + wave, NGW = G * NWAVES; bf16_t* xb = (bf16_t*)(ws + WS_XBLO);
        for (int row = gw; row < T; row += NGW) {
            const f32x4* hr = (const f32x4*)(a.out + (size_t)row * D) + lane; u32x2* xo = (u32x2*)(xb + (size_t)row * D) + lane;
#pragma unroll
            for (int j = 0; j < 4; ++j) xo[64 * j] = pk4(hr[64 * j]);
        }
    }
    SEAM(PH_XB2);
    if (IN(PH_GATE)) {
        pg8::Gemm g{(const bf16_t*)(ws + WS_XBLO), (const bf16_t*)(ws + WS_WB) + (size_t)4096 * D, T, 2048, D};
        EpiGate E{ssq, (const float*)(ws + WS_STATS), (bf16_t*)(ws + WS_Y), false};
        RUN_GEMM(EpiGate, false, g, E);
    }
    SEAM(PH_GATE);
    if (IN(PH_OUT_B)) {
        pg8::Gemm g{(const bf16_t*)(ws + WS_Y), (const bf16_t*)(ws + WS_WOB), T, D, 2048};
        EpiResid E{a.out, (bf16_t*)(ws + WS_XBLO), ssq, false};
        RUN_GEMM(EpiResid, false, g, E);
    }
    SEAM(PH_OUT_B);
    if (IN(PH_UP1)) {
        pg8::Gemm g{(const bf16_t*)(ws + WS_XBLO), (const bf16_t*)(ws + WS_WUP1), T, FF, D};
        EpiUp E{ssq, (bf16_t*)(ws + WS_HID1), false};
        RUN_GEMM_REP(0, EpiUp, false, g, E);
    }
    SEAM(PH_UP1);
    if (IN(PH_DOWN1)) {
        pg8::Gemm g{(const bf16_t*)(ws + WS_HID1), (const bf16_t*)(ws + WS_WDN1), T, D, FF};
        EpiResid E{a.out, (bf16_t*)(ws + WS_XBLO), ssq, false};
        RUN_GEMM(EpiResid, false, g, E);
    }
    SEAM(PH_DOWN1);
    if (IN(PH_FINAL)) {
        const int gw = vcu * NWAVES + wave, NGW = G * NWAVES;
        for (int row = gw; row < T; row += NGW) {
            const float rs = row_rstd(ssq, row);
            f32x4* hr = (f32x4*)(a.out + (size_t)row * D) + lane; const f32x4* gr = (const f32x4*)a.final_norm_g + lane;
#pragma unroll
            for (int j = 0; j < 4; ++j) hr[64 * j] = hr[64 * j] * rs * gr[64 * j];
        }
    }
#undef IN
#undef SEAM
}


__device__ __forceinline__ int block_sum_256(int v, int* red) {
    for (int o = 1; o < 64; o <<= 1) v += __shfl_xor(v, o);
    __syncthreads();
    if ((threadIdx.x & 63) == 0) red[threadIdx.x >> 6] = v;
    __syncthreads();
    return red[0] + red[1] + red[2] + red[3];
}

__global__ void __launch_bounds__(256) k_dsa_simple(const bf16_t* __restrict__ q, const bf16_t* __restrict__ k, const bf16_t* __restrict__ v, const bf16_t* __restrict__ qi, const bf16_t* __restrict__ ki,
                                                    const float* __restrict__ wi, bf16_t* __restrict__ o) {
    __shared__ float s_qi[512]; __shared__ float s_w[8]; __shared__ unsigned s_key[SEQ]; __shared__ int s_sel[TOPK]; __shared__ float s_q[1024]; __shared__ float s_p[8][TOPK];
    __shared__ int s_red[4]; __shared__ int s_cnt; __shared__ float s_mx[8], s_sm[8];
    const int tid = threadIdx.x;
    for (int tok = blockIdx.x; tok < T; tok += gridDim.x) {
        const int b = tok / SEQ, t = tok % SEQ; const int n = t + 1;
        __syncthreads();
        for (int i = tid; i < 512; i += 256) s_qi[i] = bf2f(qi[(size_t)tok * 512 + i]);
        for (int i = tid; i < 1024; i += 256) s_q[i] = bf2f(q[(size_t)tok * 1024 + i]);
        if (tid < 8) s_w[tid] = wi[(size_t)tok * 8 + tid];
        if (tid == 0) s_cnt = 0;
        __syncthreads();
        if (n <= TOPK) {
            s_sel[tid] = (tid < n) ? tid : -1;
        } else {
            for (int j = tid; j < n; j += 256) {
                const bf16_t* kr = ki + ((size_t)b * SEQ + j) * 64; float kv[64];
#pragma unroll
                for (int d = 0; d < 64; ++d) kv[d] = bf2f(kr[d]);
                float sc = 0.f;
#pragma unroll
                for (int h = 0; h < 8; ++h) { float dsum = 0.f;
#pragma unroll
                    for (int d = 0; d < 64; ++d) dsum += s_qi[h * 64 + d] * kv[d];
                    sc += fmaxf(dsum, 0.f) * s_w[h]; }
                s_key[j] = okey(sc);
            }
            __syncthreads();
            unsigned lo_ = 0u, hi_ = 0xFFFFFFFFu, thr = 0u; bool exact = false;
            for (;;) {
                const unsigned mid = lo_ + ((hi_ - lo_) >> 1);
                int c = 0; for (int j = tid; j < n; j += 256) c += (s_key[j] > mid) ? 1 : 0;
                c = block_sum_256(c, s_red);
                if (c == TOPK) { thr = mid; exact = true; break; }
                if (c < TOPK) hi_ = mid; else lo_ = mid + 1u;
                if (lo_ == hi_) { thr = lo_; break; }
            }
            for (int j = tid; j < n; j += 256) if (s_key[j] > thr) { const int p = atomicAdd(&s_cnt, 1); s_sel[p] = j; }
            __syncthreads();
            if (!exact && tid == 0) { int c = s_cnt; for (int j = 0; j < n && c < TOPK; ++j) if (s_key[j] == thr) s_sel[c++] = j; s_cnt = c; }
            __syncthreads();
        }
        __syncthreads();
        { const int j = s_sel[tid];
          if (j >= 0) { const bf16_t* kr = k + ((size_t)b * SEQ + j) * 128; float acc8[8];
#pragma unroll
              for (int h = 0; h < 8; ++h) acc8[h] = 0.f;
              for (int d = 0; d < 128; ++d) { const float kd = bf2f(kr[d]);
#pragma unroll
                  for (int h = 0; h < 8; ++h) acc8[h] += s_q[h * 128 + d] * kd; }
#pragma unroll
              for (int h = 0; h < 8; ++h) s_p[h][tid] = acc8[h];
          } else {
#pragma unroll
              for (int h = 0; h < 8; ++h) s_p[h][tid] = -INFINITY; } }
        __syncthreads();
        { const int w = tid >> 6, l = tid & 63;
          for (int h = w * 2; h < w * 2 + 2; ++h) { float m = -INFINITY; for (int j = l; j < TOPK; j += 64) m = fmaxf(m, s_p[h][j]);
              for (int off = 1; off < 64; off <<= 1) m = fmaxf(m, __shfl_xor(m, off));
              float s = 0.f; for (int j = l; j < TOPK; j += 64) { const float e = exp2f(s_p[h][j] - m); s_p[h][j] = e; s += e; }
              s = wave_sum(s); if (l == 0) { s_mx[h] = m; s_sm[h] = s; } } }
        __syncthreads();
        { const int d = tid & 127, hh = (tid >> 7) * 4; float a0 = 0.f, a1 = 0.f, a2 = 0.f, a3 = 0.f;
          for (int jj = 0; jj < TOPK; ++jj) { const int j = s_sel[jj]; if (j < 0) continue; const float vv = bf2f(v[((size_t)b * SEQ + j) * 128 + d]);
              a0 += s_p[hh][jj] * vv; a1 += s_p[hh + 1][jj] * vv; a2 += s_p[hh + 2][jj] * vv; a3 += s_p[hh + 3][jj] * vv; }
          bf16_t* orow = o + (size_t)tok * 1024;
          orow[(hh + 0) * 128 + d] = (bf16_t)f2bf(a0 / s_sm[hh]); orow[(hh + 1) * 128 + d] = (bf16_t)f2bf(a1 / s_sm[hh + 1]);
          orow[(hh + 2) * 128 + d] = (bf16_t)f2bf(a2 / s_sm[hh + 2]); orow[(hh + 3) * 128 + d] = (bf16_t)f2bf(a3 / s_sm[hh + 3]); }
    }
}

constexpr int DSPLIT = 4;
__global__ void __launch_bounds__(256) k_ret_simple(const bf16_t* __restrict__ q1, const bf16_t* __restrict__ k1, const bf16_t* __restrict__ vT, bf16_t* __restrict__ y) {
    const int bh = blockIdx.x >> 3, eb = blockIdx.x & 7, b = bh >> 2, h = bh & 3;
    const int e = eb * 64 + (threadIdx.x & 63), dq = __builtin_amdgcn_readfirstlane(threadIdx.x >> 6);
    const float gamma = 1.0f - exp2f(-5.0f - (float)h);
    float Sst[64];
#pragma unroll
    for (int d = 0; d < 64; ++d) Sst[d] = 0.f;
    __shared__ float s_part[4][64];
    const bf16_t* vrow = vT + ((size_t)(b * 4 + h) * 512 + e) * SEQ;
    for (int t0 = 0; t0 < SEQ; t0 += 8) {
        const bf16x8 v8 = *(const bf16x8*)(vrow + t0);
#pragma unroll
        for (int tt = 0; tt < 8; ++tt) {
            const size_t row = (size_t)b * SEQ + t0 + tt;
            const bf16_t* qr = q1 + row * 1024 + h * 256 + dq * 64; const bf16_t* kr = k1 + row * 1024 + h * 256 + dq * 64;
            const float vv = bf2f((bf16_t)v8[tt]); float o = 0.f;
#pragma unroll
            for (int d = 0; d < 64; ++d) { Sst[d] = gamma * Sst[d] + bf2f(kr[d]) * vv; o += bf2f(qr[d]) * Sst[d]; }
            s_part[dq][threadIdx.x & 63] = o;
            __syncthreads();
            if (dq == 0) { const int l = threadIdx.x; const float tot = (s_part[0][l] + s_part[1][l]) + (s_part[2][l] + s_part[3][l]); y[row * 2048 + h * 512 + e] = (bf16_t)f2bf(tot); }
            __syncthreads();
        }
    }
}
__global__ void __launch_bounds__(256) k_stats_simple(const bf16_t* __restrict__ y, float* __restrict__ stats) {
    const int i = blockIdx.x * 256 + threadIdx.x; if (i >= T * 64) return;
    const bf16_t* p = y + (size_t)i * 32; float s = 0.f, q = 0.f;
    for (int e = 0; e < 32; ++e) { const float v = bf2f(p[e]); s += v; q += v * v; }
    stats[(size_t)i * 2] = s; stats[(size_t)i * 2 + 1] = q;
}

extern "C" void kernel_launch(void* const* d_in, const int* in_sizes, int n_in, void* d_out, int out_size, void* d_ws, size_t ws_size, hipStream_t stream) {
    static int grid = 0;
    if (grid == 0) {
        if (n_in != 12 || out_size != T * D || ws_size < WS_END) { fprintf(stderr, "kernel_launch: unexpected shapes (n_in %d out %d ws %zu)\n", n_in, out_size, ws_size); grid = -1; return; }
        int dev = 0, cus = 0;
        if (hipGetDevice(&dev) != hipSuccess || hipDeviceGetAttribute(&cus, hipDeviceAttributeMultiprocessorCount, dev) != hipSuccess) { grid = -1; return; }
        if (hipFuncSetAttribute((const void*)mk_fwd, hipFuncAttributeMaxDynamicSharedMemorySize, LDS_BYTES) != hipSuccess) { fprintf(stderr, "kernel_launch: hipFuncSetAttribute failed\n"); grid = -1; return; }
        (void)hipGetLastError();
        grid = cus;
    }
    if (grid < 0) return;
    unsigned char* ws = (unsigned char*)d_ws;
    Args a{};
    a.x = (const float*)d_in[0]; a.pos = (const int*)d_in[1]; a.norm_mix_g = (const float*)d_in[2]; a.norm_mlp_g = (const float*)d_in[3]; a.w_in_a = (const float*)d_in[4]; a.w_out_a = (const float*)d_in[5];
    a.w_in_b = (const float*)d_in[6]; a.ret_norm_g = (const float*)d_in[7]; a.w_out_b = (const float*)d_in[8]; a.w_mlp_up = (const float*)d_in[9]; a.w_mlp_down = (const float*)d_in[10]; a.final_norm_g = (const float*)d_in[11];
    a.out = (float*)d_out; a.ws = ws;
    if (hipMemsetAsync(ws + WS_CTL, 0, CTL_ZERO_BYTES, stream) != hipSuccess) { fprintf(stderr, "kernel_launch: memset failed\n"); return; }
    int li = 0;
    auto seg = [&](int lo, int hi) {
        a.ph_lo = lo; a.ph_hi = hi; a.li = li++;
        if (hi - lo > 1) { void* args[] = {&a}; hipError_t e = hipLaunchCooperativeKernel((const void*)mk_fwd, dim3(grid), dim3(NTHREADS), args, LDS_BYTES, stream);
            if (e != hipSuccess) fprintf(stderr, "cooperative launch failed: %s\n", hipGetErrorString(e)); }
        else hipLaunchKernelGGL(mk_fwd, dim3(grid), dim3(NTHREADS), LDS_BYTES, stream, a);
    };
#ifdef SIMPLE_DSA
    seg(PH_PROLOGUE, PH_DSA);
    k_dsa_simple<<<2048, 256, 0, stream>>>((const bf16_t*)(ws + WS_Q), (const bf16_t*)(ws + WS_K), (const bf16_t*)(ws + WS_V), (const bf16_t*)(ws + WS_QI), (const bf16_t*)(ws + WS_KI), (const float*)(ws + WS_WI), (bf16_t*)(ws + WS_O));
    seg(PH_OUT_A, PH_COUNT);
#else
#ifdef PROBE_PRE_PHASE
    seg(PROBE_PRE_PHASE, PROBE_PRE_PHASE + 1);
#endif
    seg(PH_PROLOGUE, PH_COUNT);
#ifdef PROBE_EXTRA_PHASE
    seg(PROBE_EXTRA_PHASE, PROBE_EXTRA_PHASE + 1);
#endif
#endif
}
#if 0
#ifdef SIMPLE_RET
    seg(PH_OUT_A, PH_R1);
    k_ret_simple<<<256, 256, 0, stream>>>((const bf16_t*)(ws + WS_Q1), (const bf16_t*)(ws + WS_K1), (const bf16_t*)(ws + WS_VT), (bf16_t*)(ws + WS_Y));
    k_stats_simple<<<(T * 64) / 256, 256, 0, stream>>>((const bf16_t*)(ws + WS_Y), (float*)(ws + WS_STATS));
    seg(PH_XB2, PH_COUNT);
#else
    seg(PH_OUT_A, PH_COUNT);
#endif
}
#endif
```

```cpp
#include <hip/hip_runtime.h>
#include <hip/hip_cooperative_groups.h>
#include <cstdio>
#include <cstdint>
namespace cg = cooperative_groups;

#define LAS __attribute__((address_space(3)))
#define GAS __attribute__((address_space(1)))
typedef unsigned short bf16_t;
typedef short bf16x8 __attribute__((ext_vector_type(8)));
typedef float f32x4 __attribute__((ext_vector_type(4)));
typedef float f32x2 __attribute__((ext_vector_type(2)));
typedef unsigned u32x4 __attribute__((ext_vector_type(4)));
typedef unsigned u32x2 __attribute__((ext_vector_type(2)));

constexpr int NB = 8, SEQ = 4096, T = NB * SEQ, D = 1024, FF = 4096;
constexpr int A_IN = 1864, A_PAD = 2048, B_IN = 6144;
constexpr int TOPK = 256;
constexpr float EPS = 1e-6f;
constexpr float QSCALE = 0.08838834764831845f * 1.4426950408889634f;

constexpr size_t MiB = 1u << 20;
constexpr size_t WS_CTL = 0, CTL_ZERO_BYTES = 1 * MiB;
constexpr size_t WS_SSQ = 1 * MiB;
constexpr size_t WS_WI = 3 * MiB;
constexpr size_t WS_TABA = 4 * MiB;
constexpr size_t WS_TABI = 4 * MiB + 512 * 1024;
constexpr size_t WS_TABR = 5 * MiB;
constexpr size_t WS_STATS = 9 * MiB;
constexpr size_t WS_WA = 26 * MiB, WS_WOA = 30 * MiB, WS_WUP0 = 32 * MiB, WS_WDN0 = 40 * MiB, WS_WB = 48 * MiB, WS_WOB = 60 * MiB, WS_WUP1 = 64 * MiB, WS_WDN1 = 72 * MiB;
constexpr size_t WS_Q = 80 * MiB, WS_K = 144 * MiB, WS_V = 152 * MiB, WS_QI = 160 * MiB, WS_KI = 192 * MiB, WS_SEL = 196 * MiB, WS_O = 212 * MiB;
constexpr size_t WS_HID0 = 80 * MiB, WS_XBHI = 448 * MiB;
constexpr size_t WS_Q1 = 80 * MiB, WS_K1 = 144 * MiB, WS_VT = 208 * MiB, WS_INNER = 336 * MiB, WS_Y = 384 * MiB, WS_XBLO = 80 * MiB, WS_HID1 = 144 * MiB;
constexpr size_t WS_END = 512 * MiB;

__device__ __forceinline__ float bf2f(bf16_t v) { return __uint_as_float((unsigned)v << 16); }
__device__ __forceinline__ unsigned f2bf(float f) { unsigned u = __float_as_uint(f); return (u + 0x7fffu + ((u >> 16) & 1u)) >> 16; }
typedef __bf16 bf16x2_t __attribute__((ext_vector_type(2)));
__device__ __forceinline__ unsigned pk2(float lo, float hi) { const f32x2 v = {lo, hi}; const bf16x2_t b = __builtin_convertvector(v, bf16x2_t); return __builtin_bit_cast(unsigned, b); }
__device__ __forceinline__ u32x2 pk4(f32x4 v) { u32x2 r; r.x = pk2(v.x, v.y); r.y = pk2(v.z, v.w); return r; }
__device__ __forceinline__ float wave_sum(float v) {
#pragma unroll
    for (int o = 1; o < 64; o <<= 1) v += __shfl_xor(v, o);
    return v;
}
__device__ __forceinline__ float row_rstd(const float* ssq16, int row) {
    const f32x4* p = (const f32x4*)(ssq16 + (size_t)row * 16);
    const f32x4 a = p[0], b = p[1], c = p[2], d = p[3];
    const float s = (((a.x + a.y) + (a.z + a.w)) + ((b.x + b.y) + (b.z + b.w))) + (((c.x + c.y) + (c.z + c.w)) + ((d.x + d.y) + (d.z + d.w)));
    return rsqrtf(s * (1.0f / 1024.0f) + EPS);
}

namespace pg8 {
#define PG8_LAS __attribute__((address_space(3)))
constexpr int BM = 256, BK = 64, HALF = 128, HTB = HALF * BK * 2, STAGE_BYTES = 8 * HTB, NXCD = 8, WGM = 8;
__host__ __device__ __forceinline__ int lds_byte(int r, int c) { const int st = (r >> 4) * 2 + (c >> 5), rr = r & 15, cc = c & 31, ob = rr * 64 + cc * 2; return st * 1024 + (ob ^ (((ob >> 9) & 1) << 5)); }
__host__ __device__ __forceinline__ void stage_rc(int b, int& R, int& C) { const int st = b / 1024, sb = b % 1024, swz = sb ^ (((sb >> 9) & 1) << 5); R = (st >> 1) * 16 + swz / 64; C = (st & 1) * 32 + (swz % 64) / 2; }
__host__ __device__ __forceinline__ int perm32(int rho) { const int n = rho >> 4, i = rho & 15; return 8 * (i >> 2) + 4 * n + (i & 3); }
struct Unit { int pm, pn; };
struct Gemm { const bf16_t* A; const bf16_t* Bt; int M, N, K; };
struct StaticOrder {
    int nM, nN, nwg, G, c;
    __host__ __device__ void init(int M, int N, int G_, int c_) { nM = M / BM; nN = N / BM; nwg = nM * nN; G = G_; c = c_; }
    __host__ __device__ bool next(int i, Unit& u) const {
        const long L = (long)i * G + c; if (L >= nwg) return false;
        int wgid = (int)L; { const int q = nwg / NXCD, r = nwg % NXCD, xcd = wgid % NXCD, off = wgid / NXCD; wgid = (xcd < r ? xcd * (q + 1) : r * (q + 1) + (xcd - r) * q) + off; }
        const int nig = WGM * nN, gid = wgid / nig, fm = gid * WGM, gsz = (nM - fm) < WGM ? (nM - fm) : WGM;
        u.pm = fm + ((wgid % nig) % gsz); u.pn = (wgid % nig) / gsz; return true;
    }
    __device__ __forceinline__ void a_ready(const Unit&) const {}
    __device__ __forceinline__ void done(const Unit&) const {}
};

template <class Epi, class Sched, bool ALIGN_EPI, bool SP2, bool SWAP>
__device__ __forceinline__ void gemm_phase(PG8_LAS unsigned char* lds, const Gemm g, const Sched& S, const Epi& E) {
    const int tid = threadIdx.x, wid = __builtin_amdgcn_readfirstlane(tid >> 6), lane = tid & 63, wr = wid >> 2, wc = wid & 3, fr = lane & 15, fq = lane >> 4;
    const int K = g.K, nt = K / BK;
    unsigned voffA[2], voffB[2];
#pragma unroll
    for (int i = 0; i < 2; ++i) { int R, C; stage_rc(tid * 16 + i * 8192, R, C); const int Rb = Epi::PERM ? ((R & ~31) + perm32(R & 31)) : R;
        voffA[i] = (unsigned)(R * K + C) * 2u; voffB[i] = (unsigned)(Rb * K + C) * 2u; }
    const size_t kstep = (size_t)(BK * 2);
    const size_t hstep = (size_t)HALF * K * 2;
    const size_t tstep = 2 * hstep;
    const unsigned ldsw = (unsigned)wid * 1024u;
    const int aoff = lds_byte(wr * 64 + fr, fq * 8), boff = lds_byte(wc * 32 + fr, fq * 8);
#define PG8_SA(b, h) (((b) * 2 + (h)) * HTB)
#define PG8_SB(b, h) ((4 + (b) * 2 + (h)) * HTB)
#define PG8_STAGE(bufoff, gbase, voff) do { _Pragma("unroll") for (int _i = 0; _i < 2; ++_i) \
        __builtin_amdgcn_global_load_lds((const unsigned*)((const char*)(gbase) + (voff)[_i]), (PG8_LAS unsigned*)(lds + (bufoff) + ldsw + _i * 8192), 16, 0, 0); } while (0)
#define PG8_LDA(dst, b, h) do { _Pragma("unroll") for (int m = 0; m < 4; ++m) _Pragma("unroll") for (int k = 0; k < 2; ++k) dst[m][k] = *(const PG8_LAS bf16x8*)(lds + PG8_SA(b, h) + aoff + m * 2048 + k * 1024); } while (0)
#define PG8_LDB(dst, b, h) do { _Pragma("unroll") for (int n = 0; n < 2; ++n) _Pragma("unroll") for (int k = 0; k < 2; ++k) dst[n][k] = *(const PG8_LAS bf16x8*)(lds + PG8_SB(b, h) + boff + n * 2048 + k * 1024); } while (0)
#define PG8_MMA(ai, bj, At, Bt) do { __builtin_amdgcn_s_setprio(1); _Pragma("unroll") for (int m = 0; m < 4; ++m) _Pragma("unroll") for (int n = 0; n < 2; ++n) _Pragma("unroll") for (int k = 0; k < 2; ++k) { \
        if constexpr (SWAP) acc[ai][bj][m][n] = __builtin_amdgcn_mfma_f32_16x16x32_bf16(At[m][k], Bt[n][k], acc[ai][bj][m][n], 0, 0, 0); \
        else acc[ai][bj][m][n] = __builtin_amdgcn_mfma_f32_16x16x32_bf16(Bt[n][k], At[m][k], acc[ai][bj][m][n], 0, 0, 0); } __builtin_amdgcn_s_setprio(0); } while (0)
#define PG8_WAIT_V(n) asm volatile("s_waitcnt vmcnt(" #n ")" ::: "memory")
#define PG8_WAIT_L(n) asm volatile("s_waitcnt lgkmcnt(" #n ")" ::: "memory")
#define PG8_BAR __builtin_amdgcn_s_barrier()
#define PG8_SCHED __builtin_amdgcn_sched_barrier(0)
    Unit cur, nxt; int ui = 0;
    if (!S.next(0, cur)) return;
    f32x4 acc[2][2][4][2];
#pragma unroll
    for (int a = 0; a < 2; ++a)
#pragma unroll
        for (int b = 0; b < 2; ++b)
#pragma unroll
            for (int m = 0; m < 4; ++m)
#pragma unroll
                for (int n = 0; n < 2; ++n) acc[a][b][m][n] = (f32x4){0.f, 0.f, 0.f, 0.f};
    bf16x8 At[4][2], B0[2][2], B1[2][2];
    const char* cA = (const char*)g.A + (size_t)cur.pm * tstep; const char* cB = (const char*)g.Bt + (size_t)cur.pn * tstep;
    S.a_ready(cur);
    if constexpr (SP2) {
        PG8_STAGE(PG8_SB(0, 0), cB, voffB); PG8_STAGE(PG8_SB(0, 1), cB + hstep, voffB); PG8_STAGE(PG8_SA(0, 0), cA, voffA); PG8_STAGE(PG8_SA(0, 1), cA + hstep, voffA);
        if (wr == 1) PG8_BAR;
        PG8_WAIT_V(2); PG8_BAR;
        PG8_STAGE(PG8_SB(1, 0), cB + kstep, voffB); PG8_STAGE(PG8_SA(1, 0), cA + kstep, voffA); PG8_STAGE(PG8_SB(1, 1), cB + hstep + kstep, voffB);
        PG8_WAIT_V(6); PG8_BAR;
    } else {
        PG8_STAGE(PG8_SB(0, 0), cB, voffB); PG8_STAGE(PG8_SA(0, 0), cA, voffA); PG8_STAGE(PG8_SB(0, 1), cB + hstep, voffB); PG8_STAGE(PG8_SA(0, 1), cA + hstep, voffA);
        if (wr == 1) PG8_BAR;
        PG8_WAIT_V(4); PG8_BAR;
        PG8_STAGE(PG8_SB(1, 0), cB + kstep, voffB); PG8_STAGE(PG8_SA(1, 0), cA + kstep, voffA); PG8_STAGE(PG8_SB(1, 1), cB + hstep + kstep, voffB);
        PG8_WAIT_V(6); PG8_BAR;
    }
    for (;;) {
        const bool has_next = S.next(ui + 1, nxt);
        const char* nA = has_next ? (const char*)g.A + (size_t)nxt.pm * tstep : cA; const char* nB = has_next ? (const char*)g.Bt + (size_t)nxt.pn * tstep : cB;
        for (int t = 0; t < nt; t += 2) {
            const bool last = (t == nt - 2);
            const char* a1 = cA + (size_t)(t + 1) * kstep;
            const char* a2 = last ? nA : cA + (size_t)(t + 2) * kstep; const char* b2 = last ? nB : cB + (size_t)(t + 2) * kstep;
            const char* a3 = a2 + kstep; const char* b3 = b2 + kstep;
            if (last && has_next) S.a_ready(nxt);
            if constexpr (SP2) {
            PG8_LDB(B0, 0, 0); PG8_LDB(B1, 0, 1); PG8_SCHED; PG8_LDA(At, 0, 0); PG8_STAGE(PG8_SA(1, 1), a1 + hstep, voffA);
            PG8_WAIT_V(8); PG8_WAIT_L(0); PG8_BAR; PG8_MMA(0, 0, At, B0); PG8_MMA(0, 1, At, B1); PG8_BAR; PG8_SCHED;
            PG8_LDA(At, 0, 1); PG8_STAGE(PG8_SB(0, 0), b2, voffB); PG8_STAGE(PG8_SB(0, 1), b2 + hstep, voffB); PG8_STAGE(PG8_SA(0, 0), a2, voffA);
            PG8_WAIT_V(8); PG8_WAIT_L(0); PG8_BAR; PG8_MMA(1, 0, At, B0); PG8_MMA(1, 1, At, B1); PG8_BAR; PG8_SCHED;
            PG8_LDB(B0, 1, 0); PG8_LDB(B1, 1, 1); PG8_SCHED; PG8_LDA(At, 1, 0); PG8_STAGE(PG8_SA(0, 1), a2 + hstep, voffA);
            PG8_WAIT_V(8); PG8_WAIT_L(0); PG8_BAR; PG8_MMA(0, 0, At, B0); PG8_MMA(0, 1, At, B1); PG8_BAR; PG8_SCHED;
            PG8_LDA(At, 1, 1); PG8_STAGE(PG8_SB(1, 0), b3, voffB); PG8_STAGE(PG8_SB(1, 1), b3 + hstep, voffB); PG8_STAGE(PG8_SA(1, 0), a3, voffA);
            PG8_WAIT_V(8); PG8_WAIT_L(0); PG8_BAR; PG8_MMA(1, 0, At, B0); PG8_MMA(1, 1, At, B1); PG8_BAR; PG8_SCHED;
            } else {
            PG8_LDB(B0, 0, 0); PG8_SCHED; PG8_LDA(At, 0, 0); PG8_STAGE(PG8_SA(1, 1), a1 + hstep, voffA);
            PG8_WAIT_L(8); PG8_BAR; PG8_WAIT_L(0); PG8_MMA(0, 0, At, B0); PG8_BAR; PG8_SCHED;
            PG8_LDB(B1, 0, 1); PG8_STAGE(PG8_SB(0, 0), b2, voffB);
            PG8_BAR; PG8_WAIT_L(0); PG8_MMA(0, 1, At, B1); PG8_BAR;
            PG8_LDA(At, 0, 1); PG8_STAGE(PG8_SA(0, 0), a2, voffA);
            PG8_BAR; PG8_WAIT_L(0); PG8_MMA(1, 0, At, B0); PG8_BAR; PG8_SCHED;
            PG8_STAGE(PG8_SB(0, 1), b2 + hstep, voffB);
            PG8_WAIT_V(6); PG8_BAR; PG8_MMA(1, 1, At, B1); PG8_BAR;
            PG8_LDB(B0, 1, 0); PG8_SCHED; PG8_LDA(At, 1, 0); PG8_STAGE(PG8_SA(0, 1), a2 + hstep, voffA);
            PG8_WAIT_L(8); PG8_BAR; PG8_WAIT_L(0); PG8_MMA(0, 0, At, B0); PG8_BAR; PG8_SCHED;
            PG8_LDB(B1, 1, 1); PG8_STAGE(PG8_SB(1, 0), b3, voffB);
            PG8_BAR; PG8_WAIT_L(0); PG8_MMA(0, 1, At, B1); PG8_BAR;
            PG8_LDA(At, 1, 1); PG8_STAGE(PG8_SA(1, 0), a3, voffA);
            PG8_BAR; PG8_WAIT_L(0); PG8_MMA(1, 0, At, B0); PG8_BAR; PG8_SCHED;
            PG8_STAGE(PG8_SB(1, 1), b3 + hstep, voffB);
            PG8_WAIT_V(6); PG8_BAR; PG8_MMA(1, 1, At, B1); PG8_BAR;
            }
        }
        if constexpr (ALIGN_EPI) { if (wr == 0) PG8_BAR; }
        E(acc, cur, wr, wc, fr, fq); S.done(cur);
        if (!has_next) break;
#pragma unroll
        for (int a = 0; a < 2; ++a)
#pragma unroll
            for (int b = 0; b < 2; ++b)
#pragma unroll
                for (int m = 0; m < 4; ++m)
#pragma unroll
                    for (int n = 0; n < 2; ++n) acc[a][b][m][n] = (f32x4){0.f, 0.f, 0.f, 0.f};
        cur = nxt; cA = nA; cB = nB; ++ui;
        if constexpr (ALIGN_EPI) { if (wr == 1) PG8_BAR; }
    }
    PG8_WAIT_V(0);
    if constexpr (!ALIGN_EPI) { if (wr == 0) PG8_BAR; }
    PG8_BAR;
#undef PG8_SA
#undef PG8_SB
#undef PG8_STAGE
#undef PG8_LDA
#undef PG8_LDB
#undef PG8_MMA
#undef PG8_WAIT_V
#undef PG8_WAIT_L
#undef PG8_BAR
#undef PG8_SCHED
}

template <class Epi, class Sched, bool SWAP>
__device__ __forceinline__ void gemm_naive(const Gemm g, const Sched& S, const Epi& E) {
    const int tid = threadIdx.x, wid = tid >> 6, lane = tid & 63, wr = wid >> 2, wc = wid & 3, fr = lane & 15, fq = lane >> 4;
    Unit u;
    for (int i = 0; S.next(i, u); ++i) {
        f32x4 acc[2][2][4][2];
#pragma unroll 1
        for (int ai = 0; ai < 2; ++ai)
#pragma unroll 1
            for (int bj = 0; bj < 2; ++bj)
#pragma unroll 1
                for (int m = 0; m < 4; ++m)
#pragma unroll 1
                    for (int n = 0; n < 2; ++n) {
                        f32x4 r;
#pragma unroll 1
                        for (int e = 0; e < 4; ++e) {
                            int row, col;
                            if (SWAP) { row = u.pm * 256 + ai * 128 + wr * 64 + m * 16 + 4 * fq + e; col = u.pn * 256 + bj * 128 + wc * 32 + n * 16 + fr; }
                            else { row = u.pm * 256 + ai * 128 + wr * 64 + m * 16 + fr; col = u.pn * 256 + bj * 128 + wc * 32 + n * 16 + 4 * fq + e; }
                            const bf16x8* a = (const bf16x8*)(g.A + (size_t)row * g.K); const bf16x8* b = (const bf16x8*)(g.Bt + (size_t)col * g.K);
                            float s = 0.f;
                            for (int k = 0; k < g.K / 8; ++k) { const bf16x8 av = a[k], bv = b[k];
#pragma unroll
                                for (int j = 0; j < 8; ++j) s += bf2f((bf16_t)av[j]) * bf2f((bf16_t)bv[j]); }
                            r[e] = s;
                        }
#pragma unroll
                        for (int a2 = 0; a2 < 2; ++a2)
#pragma unroll
                            for (int b2 = 0; b2 < 2; ++b2)
#pragma unroll
                                for (int m2 = 0; m2 < 4; ++m2)
#pragma unroll
                                    for (int n2 = 0; n2 < 2; ++n2) if (a2 == ai && b2 == bj && m2 == m && n2 == n) acc[a2][b2][m2][n2] = r;
                    }
        E(acc, u, wr, wc, fr, fq);
    }
}
}
using pg8::Unit;

struct EpiA {
    static constexpr bool PERM = false;
    const float* ssq; const int* pos; const f32x2* tabA; const f32x2* tabI;
    bf16_t *q, *k, *v, *qi, *ki; float* wi; bool dry;
    __device__ __forceinline__ void operator()(const f32x4 (&acc)[2][2][4][2], const Unit& u, int wr, int wc, int fr, int fq) const {
        const int row0 = u.pm * 256 + wr * 64 + fr; const int pn = u.pn;
#pragma unroll
        for (int ai = 0; ai < 2; ++ai)
#pragma unroll
            for (int m = 0; m < 4; ++m) {
                const int row = row0 + ai * 128 + m * 16;
                const float rs = row_rstd(ssq, row);
                int p = pos[row]; p = p < 0 ? 0 : (p > SEQ - 1 ? SEQ - 1 : p);
                if (pn < 4) {
#pragma unroll
                    for (int bj = 0; bj < 2; ++bj) {
                        f32x4 a0 = acc[ai][bj][m][0] * rs, a1 = acc[ai][bj][m][1] * rs;
                        if (wc == 0) { const f32x2* tb = tabA + p * 16 + 4 * fq;
#pragma unroll
                            for (int e = 0; e < 4; ++e) { const f32x2 cs = tb[e]; const float x1 = a0[e], x2 = a1[e]; a0[e] = x1 * cs.x - x2 * cs.y; a1[e] = x2 * cs.x + x1 * cs.y; } }
                        a0 = a0 * QSCALE; a1 = a1 * QSCALE;
                        bf16_t* dst = q + (size_t)row * 1024 + pn * 256 + bj * 128 + wc * 32 + 4 * fq;
                        if (!dry) *(u32x2*)dst = pk4(a0); if (!dry) *(u32x2*)(dst + 16) = pk4(a1);
                    }
                } else if (pn == 4) {
                    { f32x4 a0 = acc[ai][0][m][0] * rs, a1 = acc[ai][0][m][1] * rs;
                      if (wc == 0) { const f32x2* tb = tabA + p * 16 + 4 * fq;
#pragma unroll
                          for (int e = 0; e < 4; ++e) { const f32x2 cs = tb[e]; const float x1 = a0[e], x2 = a1[e]; a0[e] = x1 * cs.x - x2 * cs.y; a1[e] = x2 * cs.x + x1 * cs.y; } }
                      bf16_t* dst = k + (size_t)row * 128 + wc * 32 + 4 * fq; if (!dry) *(u32x2*)dst = pk4(a0); if (!dry) *(u32x2*)(dst + 16) = pk4(a1); }
                    { const f32x4 a0 = acc[ai][1][m][0] * rs, a1 = acc[ai][1][m][1] * rs;
                      bf16_t* dst = v + (size_t)row * 128 + wc * 32 + 4 * fq; if (!dry) *(u32x2*)dst = pk4(a0); if (!dry) *(u32x2*)(dst + 16) = pk4(a1); }
                } else if (pn < 7) {
#pragma unroll
                    for (int bj = 0; bj < 2; ++bj) {
                        f32x4 a0 = acc[ai][bj][m][0] * rs; const f32x4 a1 = acc[ai][bj][m][1] * rs;
                        if ((wc & 1) == 0) { const f32x2* tb = tabI + p * 8 + 4 * (fq & 1);
#pragma unroll
                            for (int e = 0; e < 4; ++e) { const float other = __shfl_xor(a0[e], 32); const f32x2 cs = tb[e]; a0[e] = (fq < 2) ? (a0[e] * cs.x - other * cs.y) : (a0[e] * cs.x + other * cs.y); } }
                        bf16_t* dst = qi + (size_t)row * 512 + (pn - 5) * 256 + bj * 128 + wc * 32 + 4 * fq;
                        if (!dry) *(u32x2*)dst = pk4(a0); if (!dry) *(u32x2*)(dst + 16) = pk4(a1);
                    }
                } else {
                    if (wc < 2) {
                        f32x4 a0 = acc[ai][0][m][0] * rs; const f32x4 a1 = acc[ai][0][m][1] * rs;
                        if (wc == 0) { const f32x2* tb = tabI + p * 8 + 4 * (fq & 1);
#pragma unroll
                            for (int e = 0; e < 4; ++e) { const float other = __shfl_xor(a0[e], 32); const f32x2 cs = tb[e]; a0[e] = (fq < 2) ? (a0[e] * cs.x - other * cs.y) : (a0[e] * cs.x + other * cs.y); } }
                        bf16_t* dst = ki + (size_t)row * 64 + wc * 32 + 4 * fq; if (!dry) *(u32x2*)dst = pk4(a0); if (!dry) *(u32x2*)(dst + 16) = pk4(a1);
                    } else if (wc == 2) {
                        if (fq < 2) { const f32x4 a0 = acc[ai][0][m][0] * (rs * 0.04419417382415922f); if (!dry) *(f32x4*)(wi + (size_t)row * 8 + 4 * fq) = a0; }
                    }
                }
            }
    }
};

struct EpiUp {
    static constexpr bool PERM = true;
    const float* ssq; bf16_t* hid; bool dry;
    __device__ __forceinline__ void operator()(const f32x4 (&acc)[2][2][4][2], const Unit& u, int wr, int wc, int fr, int fq) const {
        const int row0 = u.pm * 256 + wr * 64 + fr, col0 = u.pn * 256 + wc * 32 + 8 * fq;
#pragma unroll
        for (int ai = 0; ai < 2; ++ai)
#pragma unroll
            for (int m = 0; m < 4; ++m) {
                const int row = row0 + ai * 128 + m * 16; const float rs = row_rstd(ssq, row);
                bf16_t* rowp = hid + (size_t)row * FF + col0;
#pragma unroll
                for (int bj = 0; bj < 2; ++bj) { f32x4 a0 = acc[ai][bj][m][0] * rs, a1 = acc[ai][bj][m][1] * rs;
#pragma unroll
                    for (int e = 0; e < 4; ++e) { const float r0 = fmaxf(a0[e], 0.f), r1 = fmaxf(a1[e], 0.f); a0[e] = r0 * r0; a1[e] = r1 * r1; }
                    u32x4 w; w.x = pk2(a0[0], a0[1]); w.y = pk2(a0[2], a0[3]); w.z = pk2(a1[0], a1[1]); w.w = pk2(a1[2], a1[3]);
                    *(u32x4*)(rowp + bj * 128) = w; }
            }
    }
};

struct EpiResid {
    static constexpr bool PERM = true;
    const float* hin; float* h; bf16_t* xb; float* ssq; bool dry;
    __device__ __forceinline__ void operator()(const f32x4 (&acc)[2][2][4][2], const Unit& u, int wr, int wc, int fr, int fq) const {
        const int row0 = u.pm * 256 + wr * 64 + fr, col0 = u.pn * 256 + wc * 32 + 8 * fq;
#pragma unroll
        for (int ai = 0; ai < 2; ++ai)
#pragma unroll
            for (int m = 0; m < 4; ++m) {
                const int row = row0 + ai * 128 + m * 16; float s = 0.f;
#pragma unroll
                for (int bj = 0; bj < 2; ++bj) { const size_t off = (size_t)row * D + col0 + bj * 128;
                    const f32x4 h0 = *(const f32x4*)(hin + off) + acc[ai][bj][m][0], h1 = *(const f32x4*)(hin + off + 4) + acc[ai][bj][m][1];
                    *(f32x4*)(h + off) = h0; *(f32x4*)(h + off + 4) = h1;
                    u32x4 w; w.x = pk2(h0[0], h0[1]); w.y = pk2(h0[2], h0[3]); w.z = pk2(h1[0], h1[1]); w.w = pk2(h1[2], h1[3]);
                    *(u32x4*)(xb + off) = w;
                    s += ((h0.x * h0.x + h0.y * h0.y) + (h0.z * h0.z + h0.w * h0.w)) + ((h1.x * h1.x + h1.y * h1.y) + (h1.z * h1.z + h1.w * h1.w)); }
                s += __shfl_xor(s, 16); s += __shfl_xor(s, 32);
                if (fq == 0) ssq[(size_t)row * 16 + u.pn * 4 + wc] = s;
            }
    }
};

struct EpiBqk {
    static constexpr bool PERM = true;
    const float* ssq; const int* pos; const f32x2* tabR; bf16_t *q1, *k1; bool dry;
    __device__ __forceinline__ void operator()(const f32x4 (&acc)[2][2][4][2], const Unit& u, int wr, int wc, int fr, int fq) const {
        const int row0 = u.pm * 256 + wr * 64 + fr; const bool isk = u.pn >= 4; bf16_t* dstb = isk ? k1 : q1; const float sc = isk ? 0.0625f : 1.0f; const int hd = u.pn & 3;
#pragma unroll
        for (int ai = 0; ai < 2; ++ai)
#pragma unroll
            for (int m = 0; m < 4; ++m) {
                const int row = row0 + ai * 128 + m * 16; const float rs = row_rstd(ssq, row) * sc;
                int p = pos[row]; p = p < 0 ? 0 : (p > SEQ - 1 ? SEQ - 1 : p);
                const f32x2* tb = tabR + p * 128 + wc * 32 + 8 * fq; float x1[8], x2[8];
#pragma unroll
                for (int e = 0; e < 4; ++e) { x1[e] = acc[ai][0][m][0][e] * rs; x1[4 + e] = acc[ai][0][m][1][e] * rs; x2[e] = acc[ai][1][m][0][e] * rs; x2[4 + e] = acc[ai][1][m][1][e] * rs; }
#pragma unroll
                for (int e = 0; e < 8; ++e) { const f32x2 cs = tb[e]; const float a = x1[e], b = x2[e]; x1[e] = a * cs.x - b * cs.y; x2[e] = b * cs.x + a * cs.y; }
                bf16_t* dst = dstb + (size_t)row * 1024 + hd * 256 + wc * 32 + 8 * fq;
                u32x4 w1, w2; w1.x = pk2(x1[0], x1[1]); w1.y = pk2(x1[2], x1[3]); w1.z = pk2(x1[4], x1[5]); w1.w = pk2(x1[6], x1[7]); w2.x = pk2(x2[0], x2[1]); w2.y = pk2(x2[2], x2[3]); w2.z = pk2(x2[4], x2[5]); w2.w = pk2(x2[6], x2[7]);
                *(u32x4*)dst = w1; *(u32x4*)(dst + 128) = w2;
            }
    }
};
struct EpiBv {
    static constexpr bool PERM = false;
    const float* ssq; bf16_t* vT; bool dry;
    __device__ __forceinline__ void operator()(const f32x4 (&acc)[2][2][4][2], const Unit& u, int wr, int wc, int fr, int fq) const {
        const int rowb = u.pm * 256 + wr * 64 + 4 * fq; const int b = u.pm >> 4;
#pragma unroll
        for (int ai = 0; ai < 2; ++ai)
#pragma unroll
            for (int m = 0; m < 4; ++m) {
                const int row = rowb + ai * 128 + m * 16; f32x4 rs;
#pragma unroll
                for (int e = 0; e < 4; ++e) rs[e] = row_rstd(ssq, row + e);
                const int t = row & (SEQ - 1);
#pragma unroll
                for (int bj = 0; bj < 2; ++bj)
#pragma unroll
                    for (int n = 0; n < 2; ++n) { const int c = u.pn * 256 + bj * 128 + wc * 32 + n * 16 + fr;
                        const f32x4 a = acc[ai][bj][m][n] * rs;
                        if (!dry) *(u32x2*)(vT + ((size_t)(b * 4 + (c >> 9)) * 512 + (c & 511)) * SEQ + t) = pk4(a); }
            }
    }
};
struct EpiGate {
    static constexpr bool PERM = true;
    const float* ssq; const float* stats; bf16_t* y; bool dry;
    __device__ __forceinline__ void operator()(const f32x4 (&acc)[2][2][4][2], const Unit& u, int wr, int wc, int fr, int fq) const {
        const int row0 = u.pm * 256 + wr * 64 + fr, col0 = u.pn * 256 + wc * 32 + 8 * fq; const int hd = u.pn >> 1;
#pragma unroll
        for (int ai = 0; ai < 2; ++ai)
#pragma unroll
            for (int m = 0; m < 4; ++m) {
                const int row = row0 + ai * 128 + m * 16; const float rs = row_rstd(ssq, row);
                const f32x4* sp = (const f32x4*)(stats + ((size_t)row * 4 + hd) * 32);
                float sum = 0.f, sq = 0.f;
#pragma unroll
                for (int i = 0; i < 8; ++i) { const f32x4 sv = sp[i]; sum += sv.x + sv.z; sq += sv.y + sv.w; }
                const float mu = sum * (1.0f / 512.0f); const float var = fmaxf(sq * (1.0f / 512.0f) - mu * mu, 0.f); const float rh = rsqrtf(var + EPS);
                bf16_t* rowp = y + (size_t)row * 2048 + col0;
#pragma unroll
                for (int bj = 0; bj < 2; ++bj) { const u32x4 yv = *(const u32x4*)(rowp + bj * 128); float yf[8], g[8], o[8];
                    yf[0] = __uint_as_float(yv.x << 16); yf[1] = __uint_as_float(yv.x & 0xffff0000u); yf[2] = __uint_as_float(yv.y << 16); yf[3] = __uint_as_float(yv.y & 0xffff0000u);
                    yf[4] = __uint_as_float(yv.z << 16); yf[5] = __uint_as_float(yv.z & 0xffff0000u); yf[6] = __uint_as_float(yv.w << 16); yf[7] = __uint_as_float(yv.w & 0xffff0000u);
#pragma unroll
                    for (int e = 0; e < 4; ++e) { g[e] = acc[ai][bj][m][0][e] * rs; g[4 + e] = acc[ai][bj][m][1][e] * rs; }
#pragma unroll
                    for (int e = 0; e < 8; ++e) { const float sg = g[e] / (1.0f + __expf(-g[e])); o[e] = sg * (yf[e] - mu) * rh; }
                    u32x4 w; w.x = pk2(o[0], o[1]); w.y = pk2(o[2], o[3]); w.z = pk2(o[4], o[5]); w.w = pk2(o[6], o[7]);
                    *(u32x4*)(rowp + bj * 128) = w; }
            }
    }
};

#ifndef PROBE_MASK
#define PROBE_MASK 0u
#endif
constexpr int NWAVES = 8, NTHREADS = NWAVES * 64;
constexpr int RING_BYTES = 131072, LDS_BYTES = 163840, LDSCTL_OFF = LDS_BYTES - 1024, MISC_OFF = LDSCTL_OFF + 320;

struct Args {
    const float* x; const int* pos; const float* norm_mix_g; const float* norm_mlp_g; const float* w_in_a; const float* w_out_a; const float* w_in_b; const float* ret_norm_g;
    const float* w_out_b; const float* w_mlp_up; const float* w_mlp_down; const float* final_norm_g;
    float* out; unsigned char* ws; int ph_lo, ph_hi, li, pad;
};

#define XB_TMO      128
#define XB_XCNT(j)  (256  + 64 * (j))
#define XB_XSUB(j)  (1280 + 64 * (j))
#define XB_XGEN(j)  (2304 + 64 * (j))
#define XB_TOP      3328
#define XB_TOPGEN   3392
#define XCD_BAR_WORDS 3456
#define XB_SPIN_CAP (1u << 22)
constexpr int CW_BAR = 4096;
__device__ __forceinline__ unsigned xb_ld(unsigned* p)              { return __hip_atomic_load(p, __ATOMIC_RELAXED, __HIP_MEMORY_SCOPE_AGENT); }
__device__ __forceinline__ unsigned xb_add(unsigned* p, unsigned v) { return __hip_atomic_fetch_add(p, v, __ATOMIC_RELAXED, __HIP_MEMORY_SCOPE_AGENT); }
__device__ __forceinline__ unsigned xb_xcc_id() { return (unsigned)__builtin_amdgcn_s_getreg((3 << 11) | 20) & 0xFu; }
#define XB_SPIN(cond, bar) do { unsigned _sp = 0; while (cond) { __builtin_amdgcn_s_sleep(1); \
    if ((++_sp & 255u) == 0u) { if (xb_ld(&(bar)[XB_TMO])) break; if (_sp > XB_SPIN_CAP) { atomicAdd(&(bar)[XB_TMO], 1u); break; } } } } while (0)
struct XcdBarrier { unsigned* bar; unsigned x; volatile LAS unsigned* st; };
__device__ __forceinline__ XcdBarrier xcd_barrier_post(unsigned* bar, volatile LAS unsigned* st) {
    XcdBarrier b; b.bar = bar; b.x = xb_xcc_id(); b.st = st;
    if (threadIdx.x == 0) (void)xb_add(&bar[XB_XCNT(b.x)], 1u);
    return b;
}
__device__ __forceinline__ void xcd_barrier_complete(unsigned* bar, unsigned x, unsigned& nloc, unsigned& nx) {
    const unsigned G = gridDim.x * gridDim.y * gridDim.z;
    unsigned sum, cnt, mine, sp = 0u;
    for (;;) {
        sum = 0u; cnt = 0u; mine = 0u;
#pragma unroll
        for (unsigned j = 0; j < 16; ++j) { const unsigned c = xb_ld(&bar[XB_XCNT(j)]); sum += c; cnt += (c > 0u) ? 1u : 0u; mine = (j == x) ? c : mine; }
        if (sum == G) break;
        __builtin_amdgcn_s_sleep(1);
        if ((++sp & 255u) == 0u) { if (xb_ld(&bar[XB_TMO])) break; if (sp > XB_SPIN_CAP) { atomicAdd(&bar[XB_TMO], 1u); break; } }
    }
    nloc = mine > 0u ? mine : 1u; nx = cnt > 0u ? cnt : 1u;
}
__device__ __forceinline__ void xcd_barrier(const XcdBarrier& b) {
    asm volatile("s_waitcnt vmcnt(0)" ::: "memory");
    __syncthreads();
    if (threadIdx.x == 0) {
        unsigned* bar = b.bar;
        __builtin_amdgcn_s_waitcnt(0);
        unsigned nloc = b.st[0], nx = b.st[1];
        if (nloc == 0u) { xcd_barrier_complete(bar, b.x, nloc, nx); b.st[0] = nloc; b.st[1] = nx; }
        const unsigned old = xb_add(&bar[XB_XSUB(b.x)], 1u);
        const unsigned gen = old / nloc;
        if (old + 1u == (gen + 1u) * nloc) {
            __builtin_amdgcn_fence(__ATOMIC_RELEASE, "agent");
            asm volatile("s_waitcnt vmcnt(0)" ::: "memory");
            const unsigned og = xb_add(&bar[XB_TOP], 1u);
            const unsigned tg = og / nx;
            if (og + 1u == (tg + 1u) * nx) xb_add(&bar[XB_TOPGEN], 1u);
            else XB_SPIN(xb_ld(&bar[XB_TOPGEN]) == tg, bar);
            __builtin_amdgcn_fence(__ATOMIC_ACQUIRE, "agent");
            xb_add(&bar[XB_XGEN(b.x)], 1u);
            asm volatile("s_waitcnt vmcnt(0)" ::: "memory");
        } else {
            XB_SPIN(xb_ld(&bar[XB_XGEN(b.x)]) == gen, bar);
            __builtin_amdgcn_fence(__ATOMIC_ACQUIRE, "agent");
            asm volatile("s_waitcnt vmcnt(0)" ::: "memory");
        }
    }
    __syncthreads();
}

typedef float f32x16 __attribute__((ext_vector_type(16)));
#define MFMA32(a, b, c) __builtin_amdgcn_mfma_f32_32x32x16_bf16((a), (b), (c), 0, 0, 0)
constexpr int ST_STRIDE = 528, ST_BUF = 64 * ST_STRIDE;
constexpr int RET_X = 0, RET_YV = 65536, RET_YI = 65536 + 16384, RET_ST = 114688;

enum Phase { PH_PROLOGUE = 0, PH_GEMM_A, PH_DSA, PH_OUT_A, PH_UP0, PH_DOWN0, PH_GEMM_B, PH_R1, PH_RET, PH_XB2, PH_GATE, PH_OUT_B, PH_UP1, PH_DOWN1, PH_FINAL, PH_COUNT };

__device__ __forceinline__ void transpose_item(const float* W, const float* gain, int K, int N, int Npad, bf16_t* WT, LAS float* scr, int item, int lane) {
    const int nblk = Npad / 32, kb = item / nblk, nb = item % nblk, k0 = 64 * kb, n0 = 32 * nb;
    const int nn = n0 + (lane & 31);
    float tv[32];
#pragma unroll
    for (int i = 0; i < 32; ++i) { const int kk = 2 * i + (lane >> 5); tv[i] = (nn < N) ? W[(size_t)(k0 + kk) * N + nn] : 0.f; }
#pragma unroll
    for (int i = 0; i < 32; ++i) { const int kk = 2 * i + (lane >> 5); float v = tv[i]; if (gain) v *= gain[k0 + kk]; scr[kk * 33 + (lane & 31)] = v; }
    asm volatile("s_waitcnt lgkmcnt(0)" ::: "memory");
    const int c = lane & 7;
#pragma unroll
    for (int j = 0; j < 4; ++j) { const int n = (lane >> 3) + 8 * j; const LAS float* s = scr + (8 * c) * 33 + n;
        u32x4 o; o.x = pk2(s[0 * 33], s[1 * 33]); o.y = pk2(s[2 * 33], s[3 * 33]); o.z = pk2(s[4 * 33], s[5 * 33]); o.w = pk2(s[6 * 33], s[7 * 33]);
        *(u32x4*)(WT + (size_t)(n0 + n) * K + k0 + 8 * c) = o; }
    asm volatile("s_waitcnt lgkmcnt(0)" ::: "memory");
}


typedef short v4i16_t __attribute__((ext_vector_type(4)));
constexpr int DSA_SEL_OFF = RING_BYTES + 1024, DSA_RED_OFF = DSA_SEL_OFF + 4096, DSA_TOT_OFF = DSA_RED_OFF + 512, DSA_RES_OFF = DSA_TOT_OFF + 256;
static_assert(DSA_RES_OFF + 128 <= LDS_BYTES, "DSA LDS map");
__device__ __forceinline__ unsigned okey(float f) { unsigned u = __float_as_uint(f); if ((u << 1) == 0u) u = 0u; return (u & 0x80000000u) ? ~u : (u | 0x80000000u); }
#define MFMA16(a, b, c) __builtin_amdgcn_mfma_f32_16x16x32_bf16((a), (b), (c), 0, 0, 0)

template <class Tv> __device__ __forceinline__ Tv ldu(const void* ubase, unsigned voff) { return *(const Tv*)((const char*)ubase + voff); }

__device__ __forceinline__ void dsa_phase(LAS unsigned char* lds, const bf16_t* __restrict__ q, const bf16_t* __restrict__ k, const bf16_t* __restrict__ v, const bf16_t* __restrict__ qi, const bf16_t* __restrict__ ki,
                                          const float* __restrict__ wi, bf16_t* __restrict__ o, int vcu, int G, int tid_, int lane_, int wave) {
    LAS unsigned short* selbuf = (LAS unsigned short*)(lds + DSA_SEL_OFF);
    LAS unsigned* red = (LAS unsigned*)(lds + DSA_RED_OFF);
    LAS unsigned* tot = (LAS unsigned*)(lds + DSA_TOT_OFF);
    const int npu = 2048;
    const bool even = (npu % G) == 0; const int per = even ? npu / G : 0;
    int par = 0;
    for (int it = 0;; ++it) {
        int pu; if (even) { if (it >= per) break; pu = vcu * per + it; } else { pu = it * G + vcu; if (pu >= npu) break; }
        const int b = pu >> 8, pr = pu & 255;
#pragma unroll 1
        for (int which = 0; which < 2; ++which) {
            int lane = lane_; asm volatile("" : "+v"(lane));
            const int tid = wave * 64 + lane;
            const int hf = lane >> 5, l31 = lane & 31, fr = lane & 15, fq = lane >> 4;
            LAS unsigned char* vbuf = lds + wave * 16384;
            const int g = which ? 511 - pr : pr; const int t0 = 8 * g; const size_t tok0 = (size_t)b * SEQ + t0;
            for (int repi_ = 0; repi_ < 1 + (int)((PROBE_MASK >> 7) & 1u); ++repi_) {
            __syncthreads();
            if (t0 + 7 < TOPK) {
                for (int i = tid; i < 2048; i += NTHREADS) { const int ql = i >> 8, p = i & 255; selbuf[i] = (unsigned short)((p <= t0 + ql) ? p : 0xFFFF); }
            } else {
                const int nkt = ((t0 + 7) >> 5) + 1;
                const unsigned kvoff = (unsigned)(l31 * 128 + 16 * hf);
                const bf16_t* qib = qi + tok0 * 512; const float* wib = wi + tok0 * 8;
                bf16x8 af[2][4]; f32x4 wlo[2][2], whi[2][2];
#pragma unroll
                for (int rt = 0; rt < 2; ++rt) {
                    const int qla = 4 * rt + 2 * ((l31 >> 2) & 1) + (l31 >> 4), hd = (l31 & 3) + 4 * ((l31 >> 3) & 1);
                    const unsigned aoff = (unsigned)((qla * 512 + hd * 64 + 8 * hf) * 2);
#pragma unroll
                    for (int sk = 0; sk < 4; ++sk) af[rt][sk] = ldu<bf16x8>(qib, aoff + 32 * sk);
#pragma unroll
                    for (int j = 0; j < 2; ++j) { const unsigned woff = (unsigned)((4 * rt + 2 * hf + j) * 32); wlo[rt][j] = ldu<f32x4>(wib, woff); whi[rt][j] = ldu<f32x4>(wib, woff + 16); }
                }
                unsigned key[16][4];
                unsigned kvoff_ = kvoff;
#pragma unroll
                for (int i = 0; i < 16; ++i) {
                    const int kt = wave + 8 * i;
                    if (kt < nkt) {
                        const bf16_t* bpu = ki + ((size_t)b * SEQ + 32 * kt) * 64;
                        bf16x8 bfr[4];
#pragma unroll
                        for (int sk = 0; sk < 4; ++sk) bfr[sk] = ldu<bf16x8>(bpu, kvoff_ + 32 * sk);
                        const int kidx = 32 * kt + l31;
#pragma unroll
                        for (int rt = 0; rt < 2; ++rt) {
                            f32x16 acc;
#pragma unroll
                            for (int r = 0; r < 16; ++r) acc[r] = 0.f;
#pragma unroll
                            for (int sk = 0; sk < 4; ++sk) acc = MFMA32(af[rt][sk], bfr[sk], acc);
#pragma unroll
                            for (int j = 0; j < 2; ++j) {
                                float sc = 0.f;
#pragma unroll
                                for (int h = 0; h < 4; ++h) sc += fmaxf(acc[8 * j + h], 0.f) * wlo[rt][j][h];
#pragma unroll
                                for (int h = 0; h < 4; ++h) sc += fmaxf(acc[8 * j + 4 + h], 0.f) * whi[rt][j][h];
                                const int tq = t0 + 4 * rt + 2 * hf + j;
                                key[i][rt * 2 + j] = (kidx <= tq) ? okey(sc) : 0u;
                            }
                        }
                    } else {
#pragma unroll
                        for (int q4 = 0; q4 < 4; ++q4) key[i][q4] = 0u;
                    }
                }
#if (PROBE_MASK >> 10) & 1
                { unsigned ks_ = 0u;
#pragma unroll
                  for (int i = 0; i < 16; ++i) ks_ ^= key[i][0] ^ key[i][1] ^ key[i][2] ^ key[i][3];
                  asm volatile("" :: "v"(ks_)); }
                asm volatile("" : "+v"(kvoff_) :: "memory");
#pragma unroll
                for (int i = 0; i < 16; ++i) {
                    const int kt = wave + 8 * i;
                    if (kt < nkt) {
                        const bf16_t* bpu = ki + ((size_t)b * SEQ + 32 * kt) * 64;
                        bf16x8 bfr[4];
#pragma unroll
                        for (int sk = 0; sk < 4; ++sk) bfr[sk] = ldu<bf16x8>(bpu, kvoff_ + 32 * sk);
                        const int kidx = 32 * kt + l31;
#pragma unroll
                        for (int rt = 0; rt < 2; ++rt) {
                            f32x16 acc;
#pragma unroll
                            for (int r = 0; r < 16; ++r) acc[r] = 0.f;
#pragma unroll
                            for (int sk = 0; sk < 4; ++sk) acc = MFMA32(af[rt][sk], bfr[sk], acc);
#pragma unroll
                            for (int j = 0; j < 2; ++j) {
                                float sc = 0.f;
#pragma unroll
                                for (int h = 0; h < 4; ++h) sc += fmaxf(acc[8 * j + h], 0.f) * wlo[rt][j][h];
#pragma unroll
                                for (int h = 0; h < 4; ++h) sc += fmaxf(acc[8 * j + 4 + h], 0.f) * whi[rt][j][h];
                                const int tq = t0 + 4 * rt + 2 * hf + j;
                                key[i][rt * 2 + j] = (kidx <= tq) ? okey(sc) : 0u;
                            }
                        }
                    } else {
#pragma unroll
                        for (int q4 = 0; q4 < 4; ++q4) key[i][q4] = 0u;
                    }
                }
#endif
#define DSA_REDUCE(PRED, TOT) do { unsigned c01 = 0u, c23 = 0u; \
        _Pragma("unroll") for (int i = 0; i < 16; ++i) { c01 += (PRED(i, 0) ? 1u : 0u) + (PRED(i, 1) ? 0x10000u : 0u); c23 += (PRED(i, 2) ? 1u : 0u) + (PRED(i, 3) ? 0x10000u : 0u); } \
        _Pragma("unroll") for (int o_ = 1; o_ < 32; o_ <<= 1) { c01 += __shfl_xor(c01, o_); c23 += __shfl_xor(c23, o_); } \
        if (l31 == 0) { LAS unsigned* rp = red + (par * 8 + wave) * 8 + 2 * hf; rp[0] = c01 & 0xffffu; rp[1] = c01 >> 16; rp[4] = c23 & 0xffffu; rp[5] = c23 >> 16; } \
        __syncthreads(); \
        TOT[0] = 0u; TOT[1] = 0u; TOT[2] = 0u; TOT[3] = 0u; \
        _Pragma("unroll") for (int w_ = 0; w_ < 8; ++w_) { const LAS unsigned* rp = red + (par * 8 + w_) * 8 + 2 * hf; const u32x2 x_ = *(const LAS u32x2*)rp, y_ = *(const LAS u32x2*)(rp + 4); TOT[0] += x_.x; TOT[1] += x_.y; TOT[2] += y_.x; TOT[3] += y_.y; } \
        par ^= 1; } while (0)
                LAS unsigned* hist = (LAS unsigned*)lds;
                LAS unsigned* res = (LAS unsigned*)(lds + DSA_RES_OFF);
                unsigned thr[4], need[4], ceq[4], icut[4], mid[4]; bool tie[4];
#pragma unroll
                for (int q4 = 0; q4 < 4; ++q4) { thr[q4] = 0u; need[q4] = (unsigned)TOPK; ceq[q4] = 0u; }
                const int hb0 = (2 * hf) * 2048, hb1 = (2 * hf + 1) * 2048, hb2 = (4 + 2 * hf) * 2048, hb3 = (5 + 2 * hf) * 2048;
#define RADIX_PASS(SHIFT, BITS, FIRST) do { \
        for (int i_ = tid; i_ < 4096; i_ += NTHREADS) ((LAS u32x4*)hist)[i_] = (u32x4){0u, 0u, 0u, 0u}; \
        __syncthreads(); \
        _Pragma("unroll") for (int i = 0; i < 16; ++i) if (wave + 8 * i < nkt) { \
            { const unsigned k_ = key[i][0]; const unsigned m_ = (FIRST) ? 1u : ((((k_ >> ((SHIFT) + (BITS) - 1)) >> 1) == thr[0]) ? 1u : 0u); __hip_atomic_fetch_add(hist + hb0 + ((k_ >> (SHIFT)) & ((1u << (BITS)) - 1u)), m_, __ATOMIC_RELAXED, __HIP_MEMORY_SCOPE_WORKGROUP); } \
            { const unsigned k_ = key[i][1]; const unsigned m_ = (FIRST) ? 1u : ((((k_ >> ((SHIFT) + (BITS) - 1)) >> 1) == thr[1]) ? 1u : 0u); __hip_atomic_fetch_add(hist + hb1 + ((k_ >> (SHIFT)) & ((1u << (BITS)) - 1u)), m_, __ATOMIC_RELAXED, __HIP_MEMORY_SCOPE_WORKGROUP); } \
            { const unsigned k_ = key[i][2]; const unsigned m_ = (FIRST) ? 1u : ((((k_ >> ((SHIFT) + (BITS) - 1)) >> 1) == thr[2]) ? 1u : 0u); __hip_atomic_fetch_add(hist + hb2 + ((k_ >> (SHIFT)) & ((1u << (BITS)) - 1u)), m_, __ATOMIC_RELAXED, __HIP_MEMORY_SCOPE_WORKGROUP); } \
            { const unsigned k_ = key[i][3]; const unsigned m_ = (FIRST) ? 1u : ((((k_ >> ((SHIFT) + (BITS) - 1)) >> 1) == thr[3]) ? 1u : 0u); __hip_atomic_fetch_add(hist + hb3 + ((k_ >> (SHIFT)) & ((1u << (BITS)) - 1u)), m_, __ATOMIC_RELAXED, __HIP_MEMORY_SCOPE_WORKGROUP); } } \
        __syncthreads(); \
        {   \
          const LAS unsigned* hq = hist + wave * 2048; const unsigned K_ = (FIRST) ? (unsigned)TOPK : res[wave * 4 + 1]; \
          unsigned s_ = 0u; \
          _Pragma("unroll") for (int j_ = 0; j_ < 8; ++j_) { const u32x4 h4 = *(const LAS u32x4*)(hq + 32 * lane + 4 * j_); s_ += (h4.x + h4.y) + (h4.z + h4.w); } \
          unsigned x_ = s_; \
          _Pragma("unroll") for (int o_ = 1; o_ < 64; o_ <<= 1) { const unsigned t_ = __shfl_down(x_, o_); if (lane + o_ < 64) x_ += t_; } \
          const unsigned T_ = x_ - s_; \
          const unsigned long long bm_ = __ballot(T_ < K_ && x_ >= K_); \
          const int Ls_ = (int)__builtin_ctzll(bm_ | 0x8000000000000000ull); \
          const unsigned Ts_ = __shfl(T_, Ls_); \
          const unsigned hv_ = (lane < 32) ? hq[32 * Ls_ + lane] : 0u; \
          unsigned x2_ = hv_; \
          _Pragma("unroll") for (int o_ = 1; o_ < 32; o_ <<= 1) { const unsigned t_ = __shfl_down(x2_, o_); if (lane + o_ < 64) x2_ += t_; } \
          const unsigned T2_ = Ts_ + x2_ - hv_; \
          if (lane < 32 && T2_ < K_ && T2_ + hv_ >= K_) { LAS unsigned* rp = res + wave * 4; rp[0] = (unsigned)(32 * Ls_ + lane); rp[1] = K_ - T2_; rp[2] = hv_; } } \
        __syncthreads(); \
        _Pragma("unroll") for (int q4 = 0; q4 < 4; ++q4) { const int ql_ = 4 * (q4 >> 1) + 2 * hf + (q4 & 1); const u32x4 r4 = *(const LAS u32x4*)(res + ql_ * 4); thr[q4] = (thr[q4] << (BITS)) | r4.x; need[q4] = r4.y; ceq[q4] = r4.z; } \
    } while (0)
                RADIX_PASS(21, 11, true);
                RADIX_PASS(10, 11, false);
                RADIX_PASS(0, 10, false);
#if (PROBE_MASK >> 9) & 1
#pragma unroll
                for (int q4 = 0; q4 < 4; ++q4) thr[q4] = 0u;
                RADIX_PASS(21, 11, true);
                RADIX_PASS(10, 11, false);
                RADIX_PASS(0, 10, false);
#endif
#if (PROBE_MASK >> 12) & 1
#pragma unroll
                for (int q4 = 0; q4 < 4; ++q4) thr[q4] = 0u;
                RADIX_PASS(21, 11, true);
                thr[0] = 0u; thr[1] = 0u; thr[2] = 0u; thr[3] = 0u;
                RADIX_PASS(21, 11, true);
                RADIX_PASS(10, 11, false);
                RADIX_PASS(0, 10, false);
#endif
#undef RADIX_PASS
                bool anyt = false;
#pragma unroll
                for (int q4 = 0; q4 < 4; ++q4) { tie[q4] = need[q4] < ceq[q4]; icut[q4] = (unsigned)(SEQ - 1); anyt = anyt || tie[q4]; }
                const bool anytie = __any(anyt);
                if (anytie) {
                    unsigned ilo[4], ihi[4];
#pragma unroll
                    for (int q4 = 0; q4 < 4; ++q4) { ilo[q4] = 0u; ihi[q4] = (unsigned)(SEQ - 1); }
#pragma unroll 1
                    for (int iter = 0; iter < 12; ++iter) {
#pragma unroll
                        for (int q4 = 0; q4 < 4; ++q4) mid[q4] = (ilo[q4] + ihi[q4]) >> 1;
                        unsigned ce[4];
#define P_EQ(i, q4) (key[i][q4] == thr[q4] && (unsigned)(32 * (wave + 8 * i) + l31) <= mid[q4])
                        DSA_REDUCE(P_EQ, ce);
#undef P_EQ
#pragma unroll
                        for (int q4 = 0; q4 < 4; ++q4) { if (ce[q4] >= need[q4]) ihi[q4] = mid[q4]; else ilo[q4] = mid[q4] + 1u; }
                    }
#pragma unroll
                    for (int q4 = 0; q4 < 4; ++q4) if (tie[q4]) icut[q4] = ihi[q4];
                }
#define P_SEL(i, q4) (key[i][q4] > thr[q4] || (key[i][q4] == thr[q4] && (unsigned)(32 * (wave + 8 * i) + l31) <= icut[q4]))
                for (int repe_ = 0; repe_ < 1 + (int)((PROBE_MASK >> 11) & 1u); ++repe_) {
                    __syncthreads();
                    unsigned n01 = 0u, n23 = 0u;
#pragma unroll
                    for (int i = 0; i < 16; ++i) { n01 += (P_SEL(i, 0) ? 1u : 0u) + (P_SEL(i, 1) ? 0x10000u : 0u); n23 += (P_SEL(i, 2) ? 1u : 0u) + (P_SEL(i, 3) ? 0x10000u : 0u); }
                    unsigned x01 = n01, x23 = n23;
#pragma unroll
                    for (int o_ = 1; o_ < 32; o_ <<= 1) { const unsigned t01 = __shfl_up(x01, o_, 32), t23 = __shfl_up(x23, o_, 32); if (l31 >= o_) { x01 += t01; x23 += t23; } }
                    if (l31 == 31) { LAS unsigned* tp = tot + wave * 8 + 2 * hf; tp[0] = x01 & 0xffffu; tp[1] = x01 >> 16; tp[4] = x23 & 0xffffu; tp[5] = x23 >> 16; }
                    __syncthreads();
                    unsigned pos[4]; pos[0] = (x01 - n01) & 0xffffu; pos[1] = (x01 - n01) >> 16; pos[2] = (x23 - n23) & 0xffffu; pos[3] = (x23 - n23) >> 16;
#pragma unroll
                    for (int w_ = 0; w_ < 8; ++w_) if (w_ < wave) { const LAS unsigned* tp = tot + w_ * 8 + 2 * hf; pos[0] += tp[0]; pos[1] += tp[1]; pos[2] += tp[4]; pos[3] += tp[5]; }
#pragma unroll
                    for (int i = 0; i < 16; ++i)
#pragma unroll
                        for (int q4 = 0; q4 < 4; ++q4) if (P_SEL(i, q4)) { const int ql = 4 * (q4 >> 1) + 2 * hf + (q4 & 1); selbuf[ql * 256 + (pos[q4] & 255u)] = (unsigned short)(32 * (wave + 8 * i) + l31); pos[q4]++; }
                }
#undef P_SEL
#undef DSA_REDUCE
            }
            }
            __syncthreads();
            for (int repa_ = 0; repa_ < 1 + (int)((PROBE_MASK >> 8) & 1u); ++repa_) {
                const size_t tok = tok0 + wave; const int t = t0 + wave;
                const LAS unsigned short* sel = selbuf + wave * 256;
                const bf16_t* qb = q + tok * 1024; const bf16_t* kb = k + (size_t)b * SEQ * 128; const bf16_t* vb = v + (size_t)b * SEQ * 128;
                bf16x8 qf[4];
                { const unsigned qoff = (unsigned)(((fr & 7) * 128 + 8 * fq) * 2);
#pragma unroll
                  for (int sk = 0; sk < 4; ++sk) qf[sk] = ldu<bf16x8>(qb, qoff + 64 * sk); }
                f32x4 lg[16];
#pragma unroll
                for (int kt = 0; kt < 16; ++kt) {
                    unsigned ix = sel[16 * kt + fr]; ix = (ix == 0xFFFFu) ? 0u : ix;
                    const unsigned koff = ix * 256u + 16u * fq;
                    f32x4 acc = (f32x4){0.f, 0.f, 0.f, 0.f};
#pragma unroll
                    for (int sk = 0; sk < 4; ++sk) { const bf16x8 ka = ldu<bf16x8>(kb, koff + 64 * sk); acc = MFMA16(ka, qf[sk], acc); }
#pragma unroll
                    for (int r = 0; r < 4; ++r) { const int p = 16 * kt + 4 * fq + r; lg[kt][r] = (t >= TOPK - 1 || p <= t) ? acc[r] : -INFINITY; }
                }
                float mx = -INFINITY;
#pragma unroll
                for (int kt = 0; kt < 16; ++kt) mx = fmaxf(fmaxf(mx, fmaxf(lg[kt][0], lg[kt][1])), fmaxf(lg[kt][2], lg[kt][3]));
                mx = fmaxf(mx, __shfl_xor(mx, 16)); mx = fmaxf(mx, __shfl_xor(mx, 32));
                float sm = 0.f;
#pragma unroll
                for (int kt = 0; kt < 16; ++kt)
#pragma unroll
                    for (int r = 0; r < 4; ++r) { const float e = exp2f(lg[kt][r] - mx); lg[kt][r] = e; sm += e; }
                sm += __shfl_xor(sm, 16); sm += __shfl_xor(sm, 32);
                bf16x8 pb[8];
#pragma unroll
                for (int u = 0; u < 8; ++u) { u32x4 w; w.x = pk2(lg[2 * u][0], lg[2 * u][1]); w.y = pk2(lg[2 * u][2], lg[2 * u][3]); w.z = pk2(lg[2 * u + 1][0], lg[2 * u + 1][1]); w.w = pk2(lg[2 * u + 1][2], lg[2 * u + 1][3]);
                    pb[u] = __builtin_bit_cast(bf16x8, w); }
                f32x4 oacc[8];
#pragma unroll
                for (int dt = 0; dt < 8; ++dt) oacc[dt] = (f32x4){0.f, 0.f, 0.f, 0.f};
                u32x4 vr[8];
#define V_LOAD(u) do { _Pragma("unroll") for (int i = 0; i < 8; ++i) { const int rr = fq + 4 * i; unsigned ix = sel[32 * (u) + rr]; ix = (ix == 0xFFFFu) ? 0u : ix; vr[i] = ldu<u32x4>(vb, ix * 256u + 16u * fr); } } while (0)
#define V_WRITE(buf) do { _Pragma("unroll") for (int i = 0; i < 8; ++i) { const int rr = fq + 4 * i; *(LAS u32x4*)(vbuf + (buf) * 8192 + rr * 256 + 16 * (fr ^ ((rr & 7) << 1))) = vr[i]; } } while (0)
                V_LOAD(0); V_WRITE(0);
                const int qq = fr >> 2, pp = fr & 3;
#pragma unroll
                for (int u = 0; u < 8; ++u) {
                    if (u + 1 < 8) V_LOAD(u + 1);
                    const LAS unsigned char* vbase = vbuf + (u & 1) * 8192;
                    const int rA = 4 * fq + qq, rB = 16 + 4 * fq + qq;
#pragma unroll
                    for (int dt = 0; dt < 8; ++dt) {
                        const int ch = 2 * dt + (pp >> 1);
                        const v4i16_t alo = __builtin_amdgcn_ds_read_tr16_b64_v4i16((LAS v4i16_t*)(vbase + rA * 256 + 16 * (ch ^ ((rA & 7) << 1)) + 8 * (pp & 1)));
                        const v4i16_t ahi = __builtin_amdgcn_ds_read_tr16_b64_v4i16((LAS v4i16_t*)(vbase + rB * 256 + 16 * (ch ^ ((rB & 7) << 1)) + 8 * (pp & 1)));
                        bf16x8 va; va[0] = alo[0]; va[1] = alo[1]; va[2] = alo[2]; va[3] = alo[3]; va[4] = ahi[0]; va[5] = ahi[1]; va[6] = ahi[2]; va[7] = ahi[3];
                        oacc[dt] = MFMA16(va, pb[u], oacc[dt]);
                    }
                    if (u + 1 < 8) V_WRITE((u + 1) & 1);
                }
#undef V_LOAD
#undef V_WRITE
                const float inv = 1.0f / sm;
                if (fr < 8) { bf16_t* op = o + tok * 1024 + fr * 128 + 4 * fq;
#pragma unroll
                    for (int dt = 0; dt < 8; ++dt) *(u32x2*)(op + 16 * dt) = pk4(oacc[dt] * inv); }
            }
        }
    }
}

__global__ void __launch_bounds__(NTHREADS, 2) mk_fwd(Args a) {
    extern __shared__ __attribute__((aligned(16))) unsigned char lds_raw[];
    LAS unsigned char* lds = (LAS unsigned char*)lds_raw;
    const int tid = threadIdx.x, lane = tid & 63, wave = __builtin_amdgcn_readfirstlane(tid >> 6);
    const int G = gridDim.x, bx = blockIdx.x;
    const int vcu = (G % 8 == 0) ? (bx % 8) * (G / 8) + bx / 8 : bx;
    unsigned char* ws = a.ws;
    float* ssq = (float*)(ws + WS_SSQ);
    const int lo = a.ph_lo, hi = a.ph_hi;
#define IN(k) (lo <= (k) && (k) < hi)
#define SEAM(k) do { if (IN(k) && IN((k) + 1)) xcd_barrier(bar); } while (0)
    for (int u = tid; u < (LDS_BYTES - LDSCTL_OFF) / 4; u += NTHREADS) ((LAS unsigned*)(lds + LDSCTL_OFF))[u] = 0u;
    __syncthreads();
    XcdBarrier bar; bar.bar = (unsigned*)(ws + WS_CTL) + CW_BAR + a.li * XCD_BAR_WORDS; bar.x = 0; bar.st = nullptr;
    if (hi - lo > 1) { cg::this_grid().sync(); bar = xcd_barrier_post(bar.bar, (volatile LAS unsigned*)(lds + MISC_OFF) + 8); }

    if (IN(PH_PROLOGUE)) for (int rep_ = 0; rep_ < 1 + (int)((PROBE_MASK >> 3) & 1u); ++rep_) {
        LAS float* scr = (LAS float*)(lds + wave * 16384);
        const int gw = vcu * NWAVES + wave, NGW = G * NWAVES;
        int base = 0;
#define CONV(Wp, gp, K_, N_, Np_, dst) do { const int n_ = ((K_) / 64) * ((Np_) / 32); int first = gw - (base % NGW); if (first < 0) first += NGW; \
            for (int it = first; it < n_; it += NGW) transpose_item(Wp, gp, K_, N_, Np_, (bf16_t*)(ws + (dst)), scr, it, lane); base += n_; } while (0)
        CONV(a.w_in_a, a.norm_mix_g, D, A_IN, A_PAD, WS_WA);
        CONV(a.w_out_a, (const float*)nullptr, D, D, D, WS_WOA);
        CONV(a.w_mlp_up, a.norm_mlp_g, D, FF, FF, WS_WUP0);
        CONV(a.w_mlp_down, (const float*)nullptr, FF, D, D, WS_WDN0);
        CONV(a.w_in_b, a.norm_mix_g + D, D, B_IN, B_IN, WS_WB);
        CONV(a.w_out_b, a.ret_norm_g, 2048, D, D, WS_WOB);
        CONV(a.w_mlp_up + (size_t)D * FF, a.norm_mlp_g + D, D, FF, FF, WS_WUP1);
        CONV(a.w_mlp_down + (size_t)FF * D, (const float*)nullptr, FF, D, D, WS_WDN1);
#undef CONV
        bf16_t* xb = (bf16_t*)(ws + WS_XBHI);
        for (int row = gw; row < T; row += NGW) {
            const f32x4* xr = (const f32x4*)(a.x + (size_t)row * D) + lane; u32x2* xo = (u32x2*)(xb + (size_t)row * D) + lane;
            float s = 0.f;
#pragma unroll
            for (int j = 0; j < 4; ++j) { const f32x4 v = xr[64 * j]; xo[64 * j] = pk4(v); s += (v.x * v.x + v.y * v.y) + (v.z * v.z + v.w * v.w); }
            s = wave_sum(s);
            if (lane < 16) ssq[(size_t)row * 16 + lane] = (lane == 0) ? s : 0.f;
        }
        __syncthreads();
        LAS double* invf = (LAS double*)(lds + 8 * 16384);
        if (tid < 152) { double inv; if (tid < 16) inv = pow(500000.0, -(double)tid / 16.0); else if (tid < 24) inv = pow(500000.0, -(double)(tid - 16) / 8.0); else inv = pow(10000.0, -(double)(tid - 24) / 128.0); invf[tid] = inv; }
        __syncthreads();
        const int gt = vcu * NTHREADS + tid, NGT = G * NTHREADS;
        f32x2* tabA = (f32x2*)(ws + WS_TABA); f32x2* tabI = (f32x2*)(ws + WS_TABI); f32x2* tabR = (f32x2*)(ws + WS_TABR);
        for (int i = gt; i < SEQ * 152; i += NGT) {
            const int p = i / 152, r = i % 152; f32x2* dst;
            if (r < 16) dst = tabA + p * 16 + r; else if (r < 24) dst = tabI + p * 8 + (r - 16); else dst = tabR + p * 128 + (r - 24);
            const double ang = (double)p * invf[r]; f32x2 cs; cs.x = (float)cos(ang); cs.y = (float)sin(ang); *dst = cs;
        }
    }
    SEAM(PH_PROLOGUE);
#ifdef GEMM_NAIVE
#define RUN_GEMM_REP(BIT, EPI, SWAPV, g, E) RUN_GEMM(EPI, SWAPV, g, E)
#define RUN_GEMM(EPI, SWAPV, g, E) do { pg8::StaticOrder S_; S_.init((g).M, (g).N, G, bx); pg8::gemm_naive<EPI, pg8::StaticOrder, SWAPV>(g, S_, E); } while (0)
#else
#define RUN_GEMM(EPI, SWAPV, g, E) do { pg8::StaticOrder S_; S_.init((g).M, (g).N, G, bx); pg8::gemm_phase<EPI, pg8::StaticOrder, true, true, SWAPV>(lds, g, S_, E); } while (0)
#define RUN_GEMM_REP(BIT, EPI, SWAPV, g, E) do { for (int rep_ = 0; rep_ < 1 + (int)((PROBE_MASK >> (BIT)) & 1u); ++rep_) RUN_GEMM(EPI, SWAPV, g, E); } while (0)
#endif

    if (IN(PH_GEMM_A)) {
        pg8::Gemm g{(const bf16_t*)(ws + WS_XBHI), (const bf16_t*)(ws + WS_WA), T, A_PAD, D};
        EpiA E{ssq, a.pos, (const f32x2*)(ws + WS_TABA), (const f32x2*)(ws + WS_TABI), (bf16_t*)(ws + WS_Q), (bf16_t*)(ws + WS_K), (bf16_t*)(ws + WS_V), (bf16_t*)(ws + WS_QI), (bf16_t*)(ws + WS_KI), (float*)(ws + WS_WI), false};
        RUN_GEMM_REP(5, EpiA, false, g, E);
    }
    SEAM(PH_GEMM_A);
    if (IN(PH_DSA)) for (int rep_ = 0; rep_ < 1 + (int)((PROBE_MASK >> 1) & 1u); ++rep_) dsa_phase(lds, (const bf16_t*)(ws + WS_Q), (const bf16_t*)(ws + WS_K), (const bf16_t*)(ws + WS_V), (const bf16_t*)(ws + WS_QI), (const bf16_t*)(ws + WS_KI), (const float*)(ws + WS_WI), (bf16_t*)(ws + WS_O), vcu, G, tid, lane, wave);
    SEAM(PH_DSA);
    if (IN(PH_OUT_A)) {
        pg8::Gemm g{(const bf16_t*)(ws + WS_O), (const bf16_t*)(ws + WS_WOA), T, D, D};
        EpiResid E{a.x, a.out, (bf16_t*)(ws + WS_XBHI), ssq, false};
        RUN_GEMM(EpiResid, false, g, E);
    }
    SEAM(PH_OUT_A);
    if (IN(PH_UP0)) {
        pg8::Gemm g{(const bf16_t*)(ws + WS_XBHI), (const bf16_t*)(ws + WS_WUP0), T, FF, D};
        EpiUp E{ssq, (bf16_t*)(ws + WS_HID0), false};
        RUN_GEMM_REP(0, EpiUp, false, g, E);
    }
    SEAM(PH_UP0);
    if (IN(PH_DOWN0)) {
        pg8::Gemm g{(const bf16_t*)(ws + WS_HID0), (const bf16_t*)(ws + WS_WDN0), T, D, FF};
        EpiResid E{a.out, a.out, (bf16_t*)(ws + WS_XBHI), ssq, false};
        RUN_GEMM(EpiResid, false, g, E);
    }
    SEAM(PH_DOWN0);
    if (IN(PH_GEMM_B)) {
        { pg8::Gemm g{(const bf16_t*)(ws + WS_XBHI), (const bf16_t*)(ws + WS_WB), T, 2048, D};
          EpiBqk E{ssq, a.pos, (const f32x2*)(ws + WS_TABR), (bf16_t*)(ws + WS_Q1), (bf16_t*)(ws + WS_K1), false};
          RUN_GEMM_REP(6, EpiBqk, false, g, E); }
        { pg8::Gemm g{(const bf16_t*)(ws + WS_XBHI), (const bf16_t*)(ws + WS_WB) + (size_t)2048 * D, T, 2048, D};
          EpiBv E{ssq, (bf16_t*)(ws + WS_VT), false};
          RUN_GEMM_REP(6, EpiBv, true, g, E); }
    }
    SEAM(PH_GEMM_B);
    if (IN(PH_R1)) {
        const bf16_t* q1 = (const bf16_t*)(ws + WS_Q1); bf16_t* k1 = (bf16_t*)(ws + WS_K1); bf16_t* inner = (bf16_t*)(ws + WS_INNER);
        const int hf = lane >> 5, l31 = lane & 31;
        for (int u = vcu; u < 1024; u += G) {
            const int c = u & 31, bh = u >> 5, h = bh & 3, b = bh >> 2;
            const size_t row0 = (size_t)b * SEQ + (size_t)c * 128;
            const float l2g = log2f(1.0f - exp2f(-5.0f - (float)h));
            for (int ti = wave; ti < 10; ti += 8) {
                int mt, nt; if (ti < 4) { mt = 0; nt = ti; } else if (ti < 7) { mt = 1; nt = ti - 3; } else if (ti < 9) { mt = 2; nt = ti - 5; } else { mt = 3; nt = 3; }
                f32x16 acc;
#pragma unroll
                for (int r = 0; r < 16; ++r) acc[r] = 0.f;
                const bf16_t* ap = k1 + (row0 + 32 * mt + l31) * 1024 + h * 256 + 8 * hf;
                const bf16_t* bp = q1 + (row0 + 32 * nt + l31) * 1024 + h * 256 + 8 * hf;
#pragma unroll
                for (int sk = 0; sk < 16; ++sk) { const bf16x8 av = *(const bf16x8*)(ap + 16 * sk), bv = *(const bf16x8*)(bp + 16 * sk); acc = MFMA32(av, bv, acc); }
                const int n = 32 * nt + l31;
                bf16_t* orow = inner + ((size_t)u * 128 + n) * 128;
#pragma unroll
                for (int rg = 0; rg < 4; ++rg) { const int m0 = 32 * mt + 8 * rg + 4 * hf; f32x4 vv;
#pragma unroll
                    for (int j = 0; j < 4; ++j) { const int m = m0 + j; vv[j] = (m <= n) ? acc[4 * rg + j] * exp2f(-(float)(m + 1) * l2g) : 0.f; }
                    *(u32x2*)(orow + m0) = pk4(vv); }
            }
            const int d = tid & 255, mh = tid >> 8;
            u32x4 pk[8];
#pragma unroll
            for (int i = 0; i < 8; ++i) { const int m0 = 8 * (8 * mh + i); float f[8];
#pragma unroll
                for (int j = 0; j < 8; ++j) f[j] = bf2f(k1[(row0 + m0 + j) * 1024 + h * 256 + d]) * exp2f((float)(127 - (m0 + j)) * l2g);
                pk[i].x = pk2(f[0], f[1]); pk[i].y = pk2(f[2], f[3]); pk[i].z = pk2(f[4], f[5]); pk[i].w = pk2(f[6], f[7]); }
            asm volatile("s_waitcnt vmcnt(0)" ::: "memory");
            __syncthreads();
#pragma unroll
            for (int i = 0; i < 8; ++i) { const int m0 = 8 * (8 * mh + i); *(u32x4*)(k1 + (row0 + (d >> 1)) * 1024 + h * 256 + (d & 1) * 128 + m0) = pk[i]; }
        }
    }
    SEAM(PH_R1);
    if (IN(PH_RET)) {
        const bf16_t* q1 = (const bf16_t*)(ws + WS_Q1); const bf16_t* kz = (const bf16_t*)(ws + WS_K1); const bf16_t* inner = (const bf16_t*)(ws + WS_INNER); const bf16_t* vT = (const bf16_t*)(ws + WS_VT);
        bf16_t* y = (bf16_t*)(ws + WS_Y); float* stats = (float*)(ws + WS_STATS);
        const int hf = lane >> 5, l31 = lane & 31, wn = wave >> 1, we = wave & 1;
        for (int rep_ = 0; rep_ < 1 + (int)((PROBE_MASK >> 2) & 1u); ++rep_)
        for (int u = vcu; u < 256; u += G) {
            const int bh = u >> 3, sl = u & 7, b = bh >> 2, h = bh & 3;
            const float l2g = log2f(1.0f - exp2f(-5.0f - (float)h)); const float gC = exp2f(128.0f * l2g);
            const float xi = exp2f((float)(32 * wn + l31 + 1) * l2g);
            f32x16 S0, S1;
#pragma unroll
            for (int r = 0; r < 16; ++r) { S0[r] = 0.f; S1[r] = 0.f; }
            __syncthreads();
            for (int i = tid; i < ST_BUF / 4; i += NTHREADS) ((LAS unsigned*)(lds + RET_ST))[i] = 0u;
            const int t5 = tid >> 5, s5 = tid & 31, t4 = tid >> 4, s4 = tid & 15;
            const unsigned gq = (unsigned)((t5 * 1024 + s5 * 8) * 2);
            const unsigned lq = (unsigned)(t5 * 512 + (((s5 & 16) | ((s5 & 15) ^ t5))) * 16);
            const unsigned lk = (unsigned)(t5 * 512 + (((s5 & 16) | ((s5 & 15) ^ ((2 * t5 + (s5 >> 4)) & 15)))) * 16);
            const unsigned gi = (unsigned)((t4 * 128 + s4 * 8) * 2);
            const unsigned li = (unsigned)(t4 * 256 + ((s4 ^ (t4 & 15))) * 16);
            const unsigned gv = (unsigned)((t4 * SEQ + s4 * 8) * 2);
            const bf16_t* qbase = q1 + (size_t)b * SEQ * 1024 + h * 256; const bf16_t* kbase = kz + (size_t)b * SEQ * 1024 + h * 256;
            const bf16_t* ibase = inner + (size_t)bh * 32 * 128 * 128; const bf16_t* vbase = vT + ((size_t)bh * 512 + 64 * sl) * SEQ;
            u32x4 rq[8], rk[8], ri[4], rv[2];
#define RET_LOAD_Y(c_) do { _Pragma("unroll") for (int i = 0; i < 4; ++i) ri[i] = ldu<u32x4>(ibase + ((size_t)(c_) * 128 + 32 * i) * 128, gi); \
                            _Pragma("unroll") for (int i = 0; i < 2; ++i) rv[i] = ldu<u32x4>(vbase + (size_t)(32 * i) * SEQ + (c_) * 128, gv); } while (0)
#define RET_LOAD_Q(c_) do { _Pragma("unroll") for (int i = 0; i < 8; ++i) rq[i] = ldu<u32x4>(qbase + ((size_t)(c_) * 128 + 16 * i) * 1024, gq); } while (0)
#define RET_LOAD_K(c_) do { _Pragma("unroll") for (int i = 0; i < 8; ++i) rk[i] = ldu<u32x4>(kbase + ((size_t)(c_) * 128 + 16 * i) * 1024, gq); } while (0)
            RET_LOAD_Y(0); RET_LOAD_Q(0);
            const int n = 32 * wn + l31, e = 32 * we + l31, dA = 64 * wn + l31;
            for (int c = 0; c < 32; ++c) {
                const size_t row0 = (size_t)b * SEQ + (size_t)c * 128;
#pragma unroll
                for (int i = 0; i < 4; ++i) *(LAS u32x4*)(lds + RET_YI + i * 8192 + li) = ri[i];
#pragma unroll
                for (int i = 0; i < 2; ++i) *(LAS u32x4*)(lds + RET_YV + i * 8192 + li) = rv[i];
#pragma unroll
                for (int i = 0; i < 8; ++i) *(LAS u32x4*)(lds + RET_X + i * 8192 + lq) = rq[i];
                __syncthreads();
                RET_LOAD_K(c);
                if (c + 1 < 32) { RET_LOAD_Y(c + 1); RET_LOAD_Q(c + 1); }
                bf16x8 vf[8];
#pragma unroll
                for (int ks = 0; ks < 8; ++ks) vf[ks] = *(const LAS bf16x8*)(lds + RET_YV + e * 256 + (((2 * ks + hf) ^ (e & 15))) * 16);
                f32x16 o;
#pragma unroll
                for (int r = 0; r < 16; ++r) o[r] = 0.f;
#pragma unroll
                for (int mt = 0; mt < 4; ++mt) if (mt <= wn) {
#pragma unroll
                    for (int s2 = 0; s2 < 2; ++s2) { const int ks = 2 * mt + s2; const bf16x8 bv = *(const LAS bf16x8*)(lds + RET_YI + n * 256 + (((2 * ks + hf) ^ (n & 15))) * 16); o = MFMA32(vf[ks], bv, o); } }
                const LAS unsigned char* stp = lds + RET_ST + e * ST_STRIDE + 16 * hf;
#pragma unroll
                for (int sk = 0; sk < 16; ++sk) { const int slot = 2 * sk + hf; const bf16x8 av = *(const LAS bf16x8*)(stp + 32 * sk);
                    const bf16x8 bv = *(const LAS bf16x8*)(lds + RET_X + n * 512 + (((slot & 16) | ((slot & 15) ^ (n & 15)))) * 16); o = MFMA32(av, bv, o); }
                float s1 = 0.f, s2q = 0.f;
#pragma unroll
                for (int r = 0; r < 16; ++r) { o[r] *= xi; s1 += o[r]; s2q += o[r] * o[r]; }
                s1 += __shfl_xor(s1, 32); s2q += __shfl_xor(s2q, 32);
                if (hf == 0) { f32x2 sv; sv.x = s1; sv.y = s2q; *(f32x2*)(stats + (((row0 + n) * 4 + h) * 16 + 2 * sl + we) * 2) = sv; }
                bf16_t* yp = y + (row0 + n) * 2048 + h * 512 + 64 * sl + 32 * we + 4 * hf;
#pragma unroll
                for (int rg = 0; rg < 4; ++rg) { f32x4 vv; vv.x = o[4 * rg]; vv.y = o[4 * rg + 1]; vv.z = o[4 * rg + 2]; vv.w = o[4 * rg + 3]; *(u32x2*)(yp + 8 * rg) = pk4(vv); }
                __syncthreads();
#pragma unroll
                for (int i = 0; i < 8; ++i) *(LAS u32x4*)(lds + RET_X + i * 8192 + lk) = rk[i];
                __syncthreads();
#pragma unroll
                for (int r = 0; r < 16; ++r) { S0[r] *= gC; S1[r] *= gC; }
#pragma unroll
                for (int sk = 0; sk < 8; ++sk) {
                    const int d0 = dA, d1 = dA + 32; const int sl0 = 16 * (d0 & 1) + 2 * sk + hf;
                    const bf16x8 a0 = *(const LAS bf16x8*)(lds + RET_X + (d0 >> 1) * 512 + (((sl0 & 16) | ((sl0 & 15) ^ (d0 & 15)))) * 16);
                    const bf16x8 a1 = *(const LAS bf16x8*)(lds + RET_X + (d1 >> 1) * 512 + (((sl0 & 16) | ((sl0 & 15) ^ (d1 & 15)))) * 16);
                    S0 = MFMA32(a0, vf[sk], S0); S1 = MFMA32(a1, vf[sk], S1); }
                LAS unsigned char* stw = lds + RET_ST + e * ST_STRIDE + (64 * wn + 4 * hf) * 2;
#pragma unroll
                for (int rg = 0; rg < 4; ++rg) { f32x4 v0, v1; v0.x = S0[4 * rg]; v0.y = S0[4 * rg + 1]; v0.z = S0[4 * rg + 2]; v0.w = S0[4 * rg + 3]; v1.x = S1[4 * rg]; v1.y = S1[4 * rg + 1]; v1.z = S1[4 * rg + 2]; v1.w = S1[4 * rg + 3];
                    *(LAS u32x2*)(stw + 16 * rg) = pk4(v0); *(LAS u32x2*)(stw + 64 + 16 * rg) = pk4(v1); }
                __syncthreads();
            }
#undef RET_LOAD_Y
#undef RET_LOAD_Q
#undef RET_LOAD_K
        }
    }
    SEAM(PH_RET);
    if (IN(PH_XB2)) for (int rep_ = 0; rep_ < 1 + 2 * (int)((PROBE_MASK >> 4) & 1u); ++rep_) {
        const int gw = vcu * NWAVES + wave, NGW = G * NWAVES; bf16_t* xb = (bf16_t*)(ws + WS_XBLO);
        for (int row = gw; row < T; row += NGW) {
            const f32x4* hr = (const f32x4*)(a.out + (size_t)row * D) + lane; u32x2* xo = (u32x2*)(xb + (size_t)row * D) + lane;
#pragma unroll
            for (int j = 0; j < 4; ++j) xo[64 * j] = pk4(hr[64 * j]);
        }
    }
    SEAM(PH_XB2);
    if (IN(PH_GATE)) {
        pg8::Gemm g{(const bf16_t*)(ws + WS_XBLO), (const bf16_t*)(ws + WS_WB) + (size_t)4096 * D, T, 2048, D};
        EpiGate E{ssq, (const float*)(ws + WS_STATS), (bf16_t*)(ws + WS_Y), false};
        RUN_GEMM(EpiGate, false, g, E);
    }
    SEAM(PH_GATE);
    if (IN(PH_OUT_B)) {
        pg8::Gemm g{(const bf16_t*)(ws + WS_Y), (const bf16_t*)(ws + WS_WOB), T, D, 2048};
        EpiResid E{a.out, a.out, (bf16_t*)(ws + WS_XBLO), ssq, false};
        RUN_GEMM(EpiResid, false, g, E);
    }
    SEAM(PH_OUT_B);
    if (IN(PH_UP1)) {
        pg8::Gemm g{(const bf16_t*)(ws + WS_XBLO), (const bf16_t*)(ws + WS_WUP1), T, FF, D};
        EpiUp E{ssq, (bf16_t*)(ws + WS_HID1), false};
        RUN_GEMM_REP(0, EpiUp, false, g, E);
    }
    SEAM(PH_UP1);
    if (IN(PH_DOWN1)) {
        pg8::Gemm g{(const bf16_t*)(ws + WS_HID1), (const bf16_t*)(ws + WS_WDN1), T, D, FF};
        EpiResid E{a.out, a.out, (bf16_t*)(ws + WS_XBLO), ssq, false};
        RUN_GEMM(EpiResid, false, g, E);
    }
    SEAM(PH_DOWN1);
    if (IN(PH_FINAL)) {
        const int gw = vcu * NWAVES + wave, NGW = G * NWAVES;
        for (int row = gw; row < T; row += NGW) {
            const float rs = row_rstd(ssq, row);
            f32x4* hr = (f32x4*)(a.out + (size_t)row * D) + lane; const f32x4* gr = (const f32x4*)a.final_norm_g + lane;
#pragma unroll
            for (int j = 0; j < 4; ++j) hr[64 * j] = hr[64 * j] * rs * gr[64 * j];
        }
    }
#undef IN
#undef SEAM
}


__device__ __forceinline__ int block_sum_256(int v, int* red) {
    for (int o = 1; o < 64; o <<= 1) v += __shfl_xor(v, o);
    __syncthreads();
    if ((threadIdx.x & 63) == 0) red[threadIdx.x >> 6] = v;
    __syncthreads();
    return red[0] + red[1] + red[2] + red[3];
}

__global__ void __launch_bounds__(256) k_dsa_simple(const bf16_t* __restrict__ q, const bf16_t* __restrict__ k, const bf16_t* __restrict__ v, const bf16_t* __restrict__ qi, const bf16_t* __restrict__ ki,
                                                    const float* __restrict__ wi, bf16_t* __restrict__ o) {
    __shared__ float s_qi[512]; __shared__ float s_w[8]; __shared__ unsigned s_key[SEQ]; __shared__ int s_sel[TOPK]; __shared__ float s_q[1024]; __shared__ float s_p[8][TOPK];
    __shared__ int s_red[4]; __shared__ int s_cnt; __shared__ float s_mx[8], s_sm[8];
    const int tid = threadIdx.x;
    for (int tok = blockIdx.x; tok < T; tok += gridDim.x) {
        const int b = tok / SEQ, t = tok % SEQ; const int n = t + 1;
        __syncthreads();
        for (int i = tid; i < 512; i += 256) s_qi[i] = bf2f(qi[(size_t)tok * 512 + i]);
        for (int i = tid; i < 1024; i += 256) s_q[i] = bf2f(q[(size_t)tok * 1024 + i]);
        if (tid < 8) s_w[tid] = wi[(size_t)tok * 8 + tid];
        if (tid == 0) s_cnt = 0;
        __syncthreads();
        if (n <= TOPK) {
            s_sel[tid] = (tid < n) ? tid : -1;
        } else {
            for (int j = tid; j < n; j += 256) {
                const bf16_t* kr = ki + ((size_t)b * SEQ + j) * 64; float kv[64];
#pragma unroll
                for (int d = 0; d < 64; ++d) kv[d] = bf2f(kr[d]);
                float sc = 0.f;
#pragma unroll
                for (int h = 0; h < 8; ++h) { float dsum = 0.f;
#pragma unroll
                    for (int d = 0; d < 64; ++d) dsum += s_qi[h * 64 + d] * kv[d];
                    sc += fmaxf(dsum, 0.f) * s_w[h]; }
                s_key[j] = okey(sc);
            }
            __syncthreads();
            unsigned lo_ = 0u, hi_ = 0xFFFFFFFFu, thr = 0u; bool exact = false;
            for (;;) {
                const unsigned mid = lo_ + ((hi_ - lo_) >> 1);
                int c = 0; for (int j = tid; j < n; j += 256) c += (s_key[j] > mid) ? 1 : 0;
                c = block_sum_256(c, s_red);
                if (c == TOPK) { thr = mid; exact = true; break; }
                if (c < TOPK) hi_ = mid; else lo_ = mid + 1u;
                if (lo_ == hi_) { thr = lo_; break; }
            }
            for (int j = tid; j < n; j += 256) if (s_key[j] > thr) { const int p = atomicAdd(&s_cnt, 1); s_sel[p] = j; }
            __syncthreads();
            if (!exact && tid == 0) { int c = s_cnt; for (int j = 0; j < n && c < TOPK; ++j) if (s_key[j] == thr) s_sel[c++] = j; s_cnt = c; }
            __syncthreads();
        }
        __syncthreads();
        { const int j = s_sel[tid];
          if (j >= 0) { const bf16_t* kr = k + ((size_t)b * SEQ + j) * 128; float acc8[8];
#pragma unroll
              for (int h = 0; h < 8; ++h) acc8[h] = 0.f;
              for (int d = 0; d < 128; ++d) { const float kd = bf2f(kr[d]);
#pragma unroll
                  for (int h = 0; h < 8; ++h) acc8[h] += s_q[h * 128 + d] * kd; }
#pragma unroll
              for (int h = 0; h < 8; ++h) s_p[h][tid] = acc8[h];
          } else {
#pragma unroll
              for (int h = 0; h < 8; ++h) s_p[h][tid] = -INFINITY; } }
        __syncthreads();
        { const int w = tid >> 6, l = tid & 63;
          for (int h = w * 2; h < w * 2 + 2; ++h) { float m = -INFINITY; for (int j = l; j < TOPK; j += 64) m = fmaxf(m, s_p[h][j]);
              for (int off = 1; off < 64; off <<= 1) m = fmaxf(m, __shfl_xor(m, off));
              float s = 0.f; for (int j = l; j < TOPK; j += 64) { const float e = exp2f(s_p[h][j] - m); s_p[h][j] = e; s += e; }
              s = wave_sum(s); if (l == 0) { s_mx[h] = m; s_sm[h] = s; } } }
        __syncthreads();
        { const int d = tid & 127, hh = (tid >> 7) * 4; float a0 = 0.f, a1 = 0.f, a2 = 0.f, a3 = 0.f;
          for (int jj = 0; jj < TOPK; ++jj) { const int j = s_sel[jj]; if (j < 0) continue; const float vv = bf2f(v[((size_t)b * SEQ + j) * 128 + d]);
              a0 += s_p[hh][jj] * vv; a1 += s_p[hh + 1][jj] * vv; a2 += s_p[hh + 2][jj] * vv; a3 += s_p[hh + 3][jj] * vv; }
          bf16_t* orow = o + (size_t)tok * 1024;
          orow[(hh + 0) * 128 + d] = (bf16_t)f2bf(a0 / s_sm[hh]); orow[(hh + 1) * 128 + d] = (bf16_t)f2bf(a1 / s_sm[hh + 1]);
          orow[(hh + 2) * 128 + d] = (bf16_t)f2bf(a2 / s_sm[hh + 2]); orow[(hh + 3) * 128 + d] = (bf16_t)f2bf(a3 / s_sm[hh + 3]); }
    }
}

constexpr int DSPLIT = 4;
__global__ void __launch_bounds__(256) k_ret_simple(const bf16_t* __restrict__ q1, const bf16_t* __restrict__ k1, const bf16_t* __restrict__ vT, bf16_t* __restrict__ y) {
    const int bh = blockIdx.x >> 3, eb = blockIdx.x & 7, b = bh >> 2, h = bh & 3;
    const int e = eb * 64 + (threadIdx.x & 63), dq = __builtin_amdgcn_readfirstlane(threadIdx.x >> 6);
    const float gamma = 1.0f - exp2f(-5.0f - (float)h);
    float Sst[64];
#pragma unroll
    for (int d = 0; d < 64; ++d) Sst[d] = 0.f;
    __shared__ float s_part[4][64];
    const bf16_t* vrow = vT + ((size_t)(b * 4 + h) * 512 + e) * SEQ;
    for (int t0 = 0; t0 < SEQ; t0 += 8) {
        const bf16x8 v8 = *(const bf16x8*)(vrow + t0);
#pragma unroll
        for (int tt = 0; tt < 8; ++tt) {
            const size_t row = (size_t)b * SEQ + t0 + tt;
            const bf16_t* qr = q1 + row * 1024 + h * 256 + dq * 64; const bf16_t* kr = k1 + row * 1024 + h * 256 + dq * 64;
            const float vv = bf2f((bf16_t)v8[tt]); float o = 0.f;
#pragma unroll
            for (int d = 0; d < 64; ++d) { Sst[d] = gamma * Sst[d] + bf2f(kr[d]) * vv; o += bf2f(qr[d]) * Sst[d]; }
            s_part[dq][threadIdx.x & 63] = o;
            __syncthreads();
            if (dq == 0) { const int l = threadIdx.x; const float tot = (s_part[0][l] + s_part[1][l]) + (s_part[2][l] + s_part[3][l]); y[row * 2048 + h * 512 + e] = (bf16_t)f2bf(tot); }
            __syncthreads();
        }
    }
}
__global__ void __launch_bounds__(256) k_stats_simple(const bf16_t* __restrict__ y, float* __restrict__ stats) {
    const int i = blockIdx.x * 256 + threadIdx.x; if (i >= T * 64) return;
    const bf16_t* p = y + (size_t)i * 32; float s = 0.f, q = 0.f;
    for (int e = 0; e < 32; ++e) { const float v = bf2f(p[e]); s += v; q += v * v; }
    stats[(size_t)i * 2] = s; stats[(size_t)i * 2 + 1] = q;
}

extern "C" void kernel_launch(void* const* d_in, const int* in_sizes, int n_in, void* d_out, int out_size, void* d_ws, size_t ws_size, hipStream_t stream) {
    static int grid = 0;
    if (grid == 0) {
        if (n_in != 12 || out_size != T * D || ws_size < WS_END) { fprintf(stderr, "kernel_launch: unexpected shapes (n_in %d out %d ws %zu)\n", n_in, out_size, ws_size); grid = -1; return; }
        int dev = 0, cus = 0;
        if (hipGetDevice(&dev) != hipSuccess || hipDeviceGetAttribute(&cus, hipDeviceAttributeMultiprocessorCount, dev) != hipSuccess) { grid = -1; return; }
        if (hipFuncSetAttribute((const void*)mk_fwd, hipFuncAttributeMaxDynamicSharedMemorySize, LDS_BYTES) != hipSuccess) { fprintf(stderr, "kernel_launch: hipFuncSetAttribute failed\n"); grid = -1; return; }
        (void)hipGetLastError();
        grid = cus;
    }
    if (grid < 0) return;
    unsigned char* ws = (unsigned char*)d_ws;
    Args a{};
    a.x = (const float*)d_in[0]; a.pos = (const int*)d_in[1]; a.norm_mix_g = (const float*)d_in[2]; a.norm_mlp_g = (const float*)d_in[3]; a.w_in_a = (const float*)d_in[4]; a.w_out_a = (const float*)d_in[5];
    a.w_in_b = (const float*)d_in[6]; a.ret_norm_g = (const float*)d_in[7]; a.w_out_b = (const float*)d_in[8]; a.w_mlp_up = (const float*)d_in[9]; a.w_mlp_down = (const float*)d_in[10]; a.final_norm_g = (const float*)d_in[11];
    a.out = (float*)d_out; a.ws = ws;
    if (hipMemsetAsync(ws + WS_CTL, 0, CTL_ZERO_BYTES, stream) != hipSuccess) { fprintf(stderr, "kernel_launch: memset failed\n"); return; }
    int li = 0;
    auto seg = [&](int lo, int hi) {
        a.ph_lo = lo; a.ph_hi = hi; a.li = li++;
        if (hi - lo > 1) { void* args[] = {&a}; hipError_t e = hipLaunchCooperativeKernel((const void*)mk_fwd, dim3(grid), dim3(NTHREADS), args, LDS_BYTES, stream);
            if (e != hipSuccess) fprintf(stderr, "cooperative launch failed: %s\n", hipGetErrorString(e)); }
        else hipLaunchKernelGGL(mk_fwd, dim3(grid), dim3(NTHREADS), LDS_BYTES, stream, a);
    };
#ifdef SIMPLE_DSA
    seg(PH_PROLOGUE, PH_DSA);
    k_dsa_simple<<<2048, 256, 0, stream>>>((const bf16_t*)(ws + WS_Q), (const bf16_t*)(ws + WS_K), (const bf16_t*)(ws + WS_V), (const bf16_t*)(ws + WS_QI), (const bf16_t*)(ws + WS_KI), (const float*)(ws + WS_WI), (bf16_t*)(ws + WS_O));
    seg(PH_OUT_A, PH_COUNT);
#else
#ifdef PROBE_PRE_PHASE
    seg(PROBE_PRE_PHASE, PROBE_PRE_PHASE + 1);
#endif
    seg(PH_PROLOGUE, PH_COUNT);
#ifdef PROBE_EXTRA_PHASE
    seg(PROBE_EXTRA_PHASE, PROBE_EXTRA_PHASE + 1);
#endif
#endif
}
#if 0
#ifdef SIMPLE_RET
    seg(PH_OUT_A, PH_R1);
    k_ret_simple<<<256, 256, 0, stream>>>((const bf16_t*)(ws + WS_Q1), (const bf16_t*)(ws + WS_K1), (const bf16_t*)(ws + WS_VT), (bf16_t*)(ws + WS_Y));
    k_stats_simple<<<(T * 64) / 256, 256, 0, stream>>>((const bf16_t*)(ws + WS_Y), (float*)(ws + WS_STATS));
    seg(PH_XB2, PH_COUNT);
#else
    seg(PH_OUT_A, PH_COUNT);
#endif
}
#endif
```

```cpp
#include <hip/hip_runtime.h>
#include <hip/hip_cooperative_groups.h>
#include <cstdio>
#include <cstdint>
namespace cg = cooperative_groups;

#define LAS __attribute__((address_space(3)))
#define GAS __attribute__((address_space(1)))
typedef unsigned short bf16_t;
typedef short bf16x8 __attribute__((ext_vector_type(8)));
typedef float f32x4 __attribute__((ext_vector_type(4)));
typedef float f32x2 __attribute__((ext_vector_type(2)));
typedef unsigned u32x4 __attribute__((ext_vector_type(4)));
typedef unsigned u32x2 __attribute__((ext_vector_type(2)));

constexpr int NB = 8, SEQ = 4096, T = NB * SEQ, D = 1024, FF = 4096;
constexpr int A_IN = 1864, A_PAD = 2048, B_IN = 6144;
constexpr int TOPK = 256;
constexpr float EPS = 1e-6f;
constexpr float QSCALE = 0.08838834764831845f * 1.4426950408889634f;

constexpr size_t MiB = 1u << 20;
constexpr size_t WS_CTL = 0, CTL_ZERO_BYTES = 1 * MiB;
constexpr size_t WS_SSQ = 1 * MiB;
constexpr size_t WS_WI = 3 * MiB;
constexpr size_t WS_TABA = 4 * MiB;
constexpr size_t WS_TABI = 4 * MiB + 512 * 1024;
constexpr size_t WS_TABR = 5 * MiB;
constexpr size_t WS_STATS = 9 * MiB;
constexpr size_t WS_WA = 26 * MiB, WS_WOA = 30 * MiB, WS_WUP0 = 32 * MiB, WS_WDN0 = 40 * MiB, WS_WB = 48 * MiB, WS_WOB = 60 * MiB, WS_WUP1 = 64 * MiB, WS_WDN1 = 72 * MiB;
constexpr size_t WS_Q = 80 * MiB, WS_K = 144 * MiB, WS_V = 152 * MiB, WS_QI = 160 * MiB, WS_KI = 192 * MiB, WS_SEL = 196 * MiB, WS_O = 212 * MiB;
constexpr size_t WS_HID0 = 80 * MiB, WS_XB = 448 * MiB;
constexpr size_t WS_Q1 = 80 * MiB, WS_K1 = 144 * MiB, WS_VT = 208 * MiB, WS_INNER = 336 * MiB, WS_HID1 = 144 * MiB;
constexpr size_t WS_END = 512 * MiB;

__device__ __forceinline__ float bf2f(bf16_t v) { return __uint_as_float((unsigned)v << 16); }
__device__ __forceinline__ unsigned f2bf(float f) { unsigned u = __float_as_uint(f); return (u + 0x7fffu + ((u >> 16) & 1u)) >> 16; }
typedef __bf16 bf16x2_t __attribute__((ext_vector_type(2)));
__device__ __forceinline__ unsigned pk2(float lo, float hi) { const f32x2 v = {lo, hi}; const bf16x2_t b = __builtin_convertvector(v, bf16x2_t); return __builtin_bit_cast(unsigned, b); }
__device__ __forceinline__ u32x2 pk4(f32x4 v) { u32x2 r; r.x = pk2(v.x, v.y); r.y = pk2(v.z, v.w); return r; }
__device__ __forceinline__ float wave_sum(float v) {
#pragma unroll
    for (int o = 1; o < 64; o <<= 1) v += __shfl_xor(v, o);
    return v;
}
__device__ __forceinline__ float row_rstd(const float* ssq16, int row) {
    const f32x4* p = (const f32x4*)(ssq16 + (size_t)row * 16);
    const f32x4 a = p[0], b = p[1], c = p[2], d = p[3];
    const float s = (((a.x + a.y) + (a.z + a.w)) + ((b.x + b.y) + (b.z + b.w))) + (((c.x + c.y) + (c.z + c.w)) + ((d.x + d.y) + (d.z + d.w)));
    return rsqrtf(s * (1.0f / 1024.0f) + EPS);
}

constexpr size_t WS_TPROBE = 768 * 1024;
constexpr size_t WS_RSN = 25 * 1024 * 1024;
#ifdef TPROBE
#define TS_DECL unsigned long long tacc1 = 0; unsigned long long tlast = __builtin_amdgcn_s_memrealtime()
#define TS(k) do { const unsigned long long n_ = __builtin_amdgcn_s_memrealtime(); if ((k) == TPROBE) tacc1 += n_ - tlast; tlast = n_; } while (0)
#define TS_EXPORT(wsbase, cond) do { if ((cond) && tacc1) { unsigned long long* tw_ = (unsigned long long*)((wsbase) + WS_TPROBE); tw_[TPROBE] = tacc1; } } while (0)
#else
#define TS_DECL do {} while (0)
#define TS(k) do {} while (0)
#define TS_EXPORT(wsbase, cond) do {} while (0)
#endif

namespace pg8 {
#define PG8_LAS __attribute__((address_space(3)))
constexpr int BM = 256, BK = 64, HALF = 128, HTB = HALF * BK * 2, STAGE_BYTES = 8 * HTB, NXCD = 8, WGM = 8;
__host__ __device__ __forceinline__ int lds_byte(int r, int c) { const int st = (r >> 4) * 2 + (c >> 5), rr = r & 15, cc = c & 31, ob = rr * 64 + cc * 2; return st * 1024 + (ob ^ (((ob >> 9) & 1) << 5)); }
__host__ __device__ __forceinline__ void stage_rc(int b, int& R, int& C) { const int st = b / 1024, sb = b % 1024, swz = sb ^ (((sb >> 9) & 1) << 5); R = (st >> 1) * 16 + swz / 64; C = (st & 1) * 32 + (swz % 64) / 2; }
__host__ __device__ __forceinline__ int perm32(int rho) { const int n = rho >> 4, i = rho & 15; return 8 * (i >> 2) + 4 * n + (i & 3); }
struct Unit { int pm, pn, ord; };
struct Gemm { const bf16_t* A; const bf16_t* Bt; int M, N, K; };
struct StaticOrder {
    int nM, nN, nwg, G, c;
    __host__ __device__ __forceinline__ void init(int M, int N, int G_, int c_) { nM = M / BM; nN = N / BM; nwg = nM * nN; G = G_; c = c_; }
    __host__ __device__ __forceinline__ bool next(int i, Unit& u) const {
        const long L = (long)i * G + c; if (L >= nwg) return false;
        int wgid = (int)L; { const int q = nwg / NXCD, r = nwg % NXCD, xcd = wgid % NXCD, off = wgid / NXCD; wgid = (xcd < r ? xcd * (q + 1) : r * (q + 1) + (xcd - r) * q) + off; }
        const int nig = WGM * nN, gid = wgid / nig, fm = gid * WGM, gsz = (nM - fm) < WGM ? (nM - fm) : WGM;
        u.pm = fm + ((wgid % nig) % gsz); u.pn = (wgid % nig) / gsz; return true;
    }
    __device__ __forceinline__ void a_ready(const Unit&) const {}
    __device__ __forceinline__ void done(const Unit&) const {}
};

template <class Epi, class Sched, bool ALIGN_EPI, bool SP2, bool SWAP>
__device__ __forceinline__ void gemm_phase(PG8_LAS unsigned char* lds, const Gemm g, const Sched& S, const Epi& E) {
    const int tid = threadIdx.x, wid = __builtin_amdgcn_readfirstlane(tid >> 6), lane = tid & 63, wr = wid >> 2, wc = wid & 3, fr = lane & 15, fq = lane >> 4;
    const int K = g.K, nt = K / BK;
    unsigned voffA[2], voffB[2];
#pragma unroll
    for (int i = 0; i < 2; ++i) { int R, C; stage_rc(tid * 16 + i * 8192, R, C); const int Rb = Epi::PERM ? ((R & ~31) + perm32(R & 31)) : R;
        voffA[i] = (unsigned)(R * K + C) * 2u; voffB[i] = (unsigned)(Rb * K + C) * 2u; }
    const size_t kstep = (size_t)(BK * 2);
    const size_t hstep = (size_t)HALF * K * 2;
    const size_t tstep = 2 * hstep;
    const unsigned ldsw = (unsigned)wid * 1024u;
    const int aoff = lds_byte(wr * 64 + fr, fq * 8), boff = lds_byte(wc * 32 + fr, fq * 8);
#define PG8_SA(b, h) (((b) * 2 + (h)) * HTB)
#define PG8_SB(b, h) ((4 + (b) * 2 + (h)) * HTB)
#define PG8_STAGE(bufoff, gbase, voff) do { _Pragma("unroll") for (int _i = 0; _i < 2; ++_i) \
        __builtin_amdgcn_global_load_lds((const unsigned*)((const char*)(gbase) + (voff)[_i]), (PG8_LAS unsigned*)(lds + (bufoff) + ldsw + _i * 8192), 16, 0, 0); } while (0)
#define PG8_LDA(dst, b, h) do { _Pragma("unroll") for (int m = 0; m < 4; ++m) _Pragma("unroll") for (int k = 0; k < 2; ++k) dst[m][k] = *(const PG8_LAS bf16x8*)(lds + PG8_SA(b, h) + aoff + m * 2048 + k * 1024); } while (0)
#define PG8_LDB(dst, b, h) do { _Pragma("unroll") for (int n = 0; n < 2; ++n) _Pragma("unroll") for (int k = 0; k < 2; ++k) dst[n][k] = *(const PG8_LAS bf16x8*)(lds + PG8_SB(b, h) + boff + n * 2048 + k * 1024); } while (0)
#define PG8_MMA(ai, bj, At, Bt) do { __builtin_amdgcn_s_setprio(1); _Pragma("unroll") for (int m = 0; m < 4; ++m) _Pragma("unroll") for (int n = 0; n < 2; ++n) _Pragma("unroll") for (int k = 0; k < 2; ++k) { \
        if constexpr (SWAP) acc[ai][bj][m][n] = __builtin_amdgcn_mfma_f32_16x16x32_bf16(At[m][k], Bt[n][k], acc[ai][bj][m][n], 0, 0, 0); \
        else acc[ai][bj][m][n] = __builtin_amdgcn_mfma_f32_16x16x32_bf16(Bt[n][k], At[m][k], acc[ai][bj][m][n], 0, 0, 0); } __builtin_amdgcn_s_setprio(0); } while (0)
#define PG8_WAIT_V(n) asm volatile("s_waitcnt vmcnt(" #n ")" ::: "memory")
#define PG8_WAIT_L(n) asm volatile("s_waitcnt lgkmcnt(" #n ")" ::: "memory")
#define PG8_BAR __builtin_amdgcn_s_barrier()
#define PG8_SCHED __builtin_amdgcn_sched_barrier(0)
    Unit cur, nxt; int ui = 0;
    if (!S.next(0, cur)) return;
    cur.ord = 0;
    TS_DECL;
    f32x4 acc[2][2][4][2];
#pragma unroll
    for (int a = 0; a < 2; ++a)
#pragma unroll
        for (int b = 0; b < 2; ++b)
#pragma unroll
            for (int m = 0; m < 4; ++m)
#pragma unroll
                for (int n = 0; n < 2; ++n) acc[a][b][m][n] = (f32x4){0.f, 0.f, 0.f, 0.f};
    bf16x8 At[4][2], B0[2][2], B1[2][2];
    const char* cA = (const char*)g.A + (size_t)cur.pm * tstep; const char* cB = (const char*)g.Bt + (size_t)cur.pn * tstep;
    S.a_ready(cur);
    if constexpr (SP2) {
        PG8_STAGE(PG8_SB(0, 0), cB, voffB); PG8_STAGE(PG8_SB(0, 1), cB + hstep, voffB); PG8_STAGE(PG8_SA(0, 0), cA, voffA); PG8_STAGE(PG8_SA(0, 1), cA + hstep, voffA);
        if (wr == 1) PG8_BAR;
        PG8_WAIT_V(2); PG8_BAR;
        PG8_STAGE(PG8_SB(1, 0), cB + kstep, voffB); PG8_STAGE(PG8_SA(1, 0), cA + kstep, voffA); PG8_STAGE(PG8_SB(1, 1), cB + hstep + kstep, voffB);
        PG8_WAIT_V(6); PG8_BAR;
    } else {
        PG8_STAGE(PG8_SB(0, 0), cB, voffB); PG8_STAGE(PG8_SA(0, 0), cA, voffA); PG8_STAGE(PG8_SB(0, 1), cB + hstep, voffB); PG8_STAGE(PG8_SA(0, 1), cA + hstep, voffA);
        if (wr == 1) PG8_BAR;
        PG8_WAIT_V(4); PG8_BAR;
        PG8_STAGE(PG8_SB(1, 0), cB + kstep, voffB); PG8_STAGE(PG8_SA(1, 0), cA + kstep, voffA); PG8_STAGE(PG8_SB(1, 1), cB + hstep + kstep, voffB);
        PG8_WAIT_V(6); PG8_BAR;
    }
    for (;;) {
        const bool has_next = S.next(ui + 1, nxt); nxt.ord = ui + 1;
        const char* nA = has_next ? (const char*)g.A + (size_t)nxt.pm * tstep : cA; const char* nB = has_next ? (const char*)g.Bt + (size_t)nxt.pn * tstep : cB;
        for (int t = 0; t < nt; t += 2) {
            const bool last = (t == nt - 2);
            const char* a1 = cA + (size_t)(t + 1) * kstep;
            const char* a2 = last ? nA : cA + (size_t)(t + 2) * kstep; const char* b2 = last ? nB : cB + (size_t)(t + 2) * kstep;
            const char* a3 = a2 + kstep; const char* b3 = b2 + kstep;
            if (last && has_next) S.a_ready(nxt);
            if constexpr (SP2) {
            PG8_LDB(B0, 0, 0); PG8_LDB(B1, 0, 1); PG8_SCHED; PG8_LDA(At, 0, 0); PG8_STAGE(PG8_SA(1, 1), a1 + hstep, voffA);
            PG8_WAIT_V(8); PG8_WAIT_L(0); PG8_BAR; PG8_MMA(0, 0, At, B0); PG8_MMA(0, 1, At, B1); PG8_BAR; PG8_SCHED;
            PG8_LDA(At, 0, 1); PG8_STAGE(PG8_SB(0, 0), b2, voffB); PG8_STAGE(PG8_SB(0, 1), b2 + hstep, voffB); PG8_STAGE(PG8_SA(0, 0), a2, voffA);
            PG8_WAIT_V(8); PG8_WAIT_L(0); PG8_BAR; PG8_MMA(1, 0, At, B0); PG8_MMA(1, 1, At, B1); PG8_BAR; PG8_SCHED;
            PG8_LDB(B0, 1, 0); PG8_LDB(B1, 1, 1); PG8_SCHED; PG8_LDA(At, 1, 0); PG8_STAGE(PG8_SA(0, 1), a2 + hstep, voffA);
            PG8_WAIT_V(8); PG8_WAIT_L(0); PG8_BAR; PG8_MMA(0, 0, At, B0); PG8_MMA(0, 1, At, B1); PG8_BAR; PG8_SCHED;
            PG8_LDA(At, 1, 1); PG8_STAGE(PG8_SB(1, 0), b3, voffB); PG8_STAGE(PG8_SB(1, 1), b3 + hstep, voffB); PG8_STAGE(PG8_SA(1, 0), a3, voffA);
            PG8_WAIT_V(8); PG8_WAIT_L(0); PG8_BAR; PG8_MMA(1, 0, At, B0); PG8_MMA(1, 1, At, B1); PG8_BAR; PG8_SCHED;
            } else {
            PG8_LDB(B0, 0, 0); PG8_SCHED; PG8_LDA(At, 0, 0); PG8_STAGE(PG8_SA(1, 1), a1 + hstep, voffA);
            PG8_WAIT_L(8); PG8_BAR; PG8_WAIT_L(0); PG8_MMA(0, 0, At, B0); PG8_BAR; PG8_SCHED;
            PG8_LDB(B1, 0, 1); PG8_STAGE(PG8_SB(0, 0), b2, voffB);
            PG8_BAR; PG8_WAIT_L(0); PG8_MMA(0, 1, At, B1); PG8_BAR;
            PG8_LDA(At, 0, 1); PG8_STAGE(PG8_SA(0, 0), a2, voffA);
            PG8_BAR; PG8_WAIT_L(0); PG8_MMA(1, 0, At, B0); PG8_BAR; PG8_SCHED;
            PG8_STAGE(PG8_SB(0, 1), b2 + hstep, voffB);
            PG8_WAIT_V(6); PG8_BAR; PG8_MMA(1, 1, At, B1); PG8_BAR;
            PG8_LDB(B0, 1, 0); PG8_SCHED; PG8_LDA(At, 1, 0); PG8_STAGE(PG8_SA(0, 1), a2 + hstep, voffA);
            PG8_WAIT_L(8); PG8_BAR; PG8_WAIT_L(0); PG8_MMA(0, 0, At, B0); PG8_BAR; PG8_SCHED;
            PG8_LDB(B1, 1, 1); PG8_STAGE(PG8_SB(1, 0), b3, voffB);
            PG8_BAR; PG8_WAIT_L(0); PG8_MMA(0, 1, At, B1); PG8_BAR;
            PG8_LDA(At, 1, 1); PG8_STAGE(PG8_SA(1, 0), a3, voffA);
            PG8_BAR; PG8_WAIT_L(0); PG8_MMA(1, 0, At, B0); PG8_BAR; PG8_SCHED;
            PG8_STAGE(PG8_SB(1, 1), b3 + hstep, voffB);
            PG8_WAIT_V(6); PG8_BAR; PG8_MMA(1, 1, At, B1); PG8_BAR;
            }
        }
        if constexpr (ALIGN_EPI) { if (wr == 0) PG8_BAR; }
        if constexpr (Epi::TIMED) { TS(10); }
        E(acc, cur, wr, wc, fr, fq); S.done(cur);
        if constexpr (Epi::TIMED) { TS(11); }
        if (!has_next) break;
#pragma unroll
        for (int a = 0; a < 2; ++a)
#pragma unroll
            for (int b = 0; b < 2; ++b)
#pragma unroll
                for (int m = 0; m < 4; ++m)
#pragma unroll
                    for (int n = 0; n < 2; ++n) acc[a][b][m][n] = (f32x4){0.f, 0.f, 0.f, 0.f};
        cur = nxt; cA = nA; cB = nB; ++ui;
        if constexpr (ALIGN_EPI) { if (wr == 1) PG8_BAR; }
    }
    PG8_WAIT_V(0);
    if constexpr (!ALIGN_EPI) { if (wr == 0) PG8_BAR; }
    PG8_BAR;
    if constexpr (Epi::TIMED) { TS(12); TS_EXPORT(E.wsb, blockIdx.x == 0 && tid == 0); }
#undef PG8_SA
#undef PG8_SB
#undef PG8_STAGE
#undef PG8_LDA
#undef PG8_LDB
#undef PG8_MMA
#undef PG8_WAIT_V
#undef PG8_WAIT_L
#undef PG8_BAR
#undef PG8_SCHED
}

template <class Epi, class Sched, bool SWAP>
__device__ __forceinline__ void gemm_naive(const Gemm g, const Sched& S, const Epi& E) {
    const int tid = threadIdx.x, wid = tid >> 6, lane = tid & 63, wr = wid >> 2, wc = wid & 3, fr = lane & 15, fq = lane >> 4;
    Unit u;
    for (int i = 0; S.next(i, u); ++i) {
        f32x4 acc[2][2][4][2];
#pragma unroll 1
        for (int ai = 0; ai < 2; ++ai)
#pragma unroll 1
            for (int bj = 0; bj < 2; ++bj)
#pragma unroll 1
                for (int m = 0; m < 4; ++m)
#pragma unroll 1
                    for (int n = 0; n < 2; ++n) {
                        f32x4 r;
#pragma unroll 1
                        for (int e = 0; e < 4; ++e) {
                            int row, col;
                            if (SWAP) { row = u.pm * 256 + ai * 128 + wr * 64 + m * 16 + 4 * fq + e; col = u.pn * 256 + bj * 128 + wc * 32 + n * 16 + fr; }
                            else { row = u.pm * 256 + ai * 128 + wr * 64 + m * 16 + fr; col = u.pn * 256 + bj * 128 + wc * 32 + n * 16 + 4 * fq + e; }
                            const bf16x8* a = (const bf16x8*)(g.A + (size_t)row * g.K); const bf16x8* b = (const bf16x8*)(g.Bt + (size_t)col * g.K);
                            float s = 0.f;
                            for (int k = 0; k < g.K / 8; ++k) { const bf16x8 av = a[k], bv = b[k];
#pragma unroll
                                for (int j = 0; j < 8; ++j) s += bf2f((bf16_t)av[j]) * bf2f((bf16_t)bv[j]); }
                            r[e] = s;
                        }
#pragma unroll
                        for (int a2 = 0; a2 < 2; ++a2)
#pragma unroll
                            for (int b2 = 0; b2 < 2; ++b2)
#pragma unroll
                                for (int m2 = 0; m2 < 4; ++m2)
#pragma unroll
                                    for (int n2 = 0; n2 < 2; ++n2) if (a2 == ai && b2 == bj && m2 == m && n2 == n) acc[a2][b2][m2][n2] = r;
                    }
        E(acc, u, wr, wc, fr, fq);
    }
}
}
using pg8::Unit;

struct EpiA {
    static constexpr bool PERM = false, TIMED = false;
    const float* ssq; const int* pos; const f32x2* tabA; const f32x2* tabI;
    bf16_t *q, *k, *v, *qi, *ki; float* wi; bool dry;
    __device__ __forceinline__ void operator()(const f32x4 (&acc)[2][2][4][2], const Unit& u, int wr, int wc, int fr, int fq) const {
        const int row0 = u.pm * 256 + wr * 64 + fr; const int pn = u.pn;
#pragma unroll
        for (int ai = 0; ai < 2; ++ai)
#pragma unroll
            for (int m = 0; m < 4; ++m) {
                const int row = row0 + ai * 128 + m * 16;
                const float rs = row_rstd(ssq, row);
                int p = pos[row]; p = p < 0 ? 0 : (p > SEQ - 1 ? SEQ - 1 : p);
                if (pn < 4) {
#pragma unroll
                    for (int bj = 0; bj < 2; ++bj) {
                        f32x4 a0 = acc[ai][bj][m][0] * rs, a1 = acc[ai][bj][m][1] * rs;
                        if (wc == 0) { const f32x2* tb = tabA + p * 16 + 4 * fq;
#pragma unroll
                            for (int e = 0; e < 4; ++e) { const f32x2 cs = tb[e]; const float x1 = a0[e], x2 = a1[e]; a0[e] = x1 * cs.x - x2 * cs.y; a1[e] = x2 * cs.x + x1 * cs.y; } }
                        a0 = a0 * QSCALE; a1 = a1 * QSCALE;
                        bf16_t* dst = q + (size_t)row * 1024 + pn * 256 + bj * 128 + wc * 32 + 4 * fq;
                        if (!dry) *(u32x2*)dst = pk4(a0); if (!dry) *(u32x2*)(dst + 16) = pk4(a1);
                    }
                } else if (pn == 4) {
                    { f32x4 a0 = acc[ai][0][m][0] * rs, a1 = acc[ai][0][m][1] * rs;
                      if (wc == 0) { const f32x2* tb = tabA + p * 16 + 4 * fq;
#pragma unroll
                          for (int e = 0; e < 4; ++e) { const f32x2 cs = tb[e]; const float x1 = a0[e], x2 = a1[e]; a0[e] = x1 * cs.x - x2 * cs.y; a1[e] = x2 * cs.x + x1 * cs.y; } }
                      bf16_t* dst = k + (size_t)row * 128 + wc * 32 + 4 * fq; if (!dry) *(u32x2*)dst = pk4(a0); if (!dry) *(u32x2*)(dst + 16) = pk4(a1); }
                    { const f32x4 a0 = acc[ai][1][m][0] * rs, a1 = acc[ai][1][m][1] * rs;
                      bf16_t* dst = v + (size_t)row * 128 + wc * 32 + 4 * fq; if (!dry) *(u32x2*)dst = pk4(a0); if (!dry) *(u32x2*)(dst + 16) = pk4(a1); }
                } else if (pn < 7) {
#pragma unroll
                    for (int bj = 0; bj < 2; ++bj) {
                        f32x4 a0 = acc[ai][bj][m][0] * rs; const f32x4 a1 = acc[ai][bj][m][1] * rs;
                        if ((wc & 1) == 0) { const f32x2* tb = tabI + p * 8 + 4 * (fq & 1);
#pragma unroll
                            for (int e = 0; e < 4; ++e) { const float other = __shfl_xor(a0[e], 32); const f32x2 cs = tb[e]; a0[e] = (fq < 2) ? (a0[e] * cs.x - other * cs.y) : (a0[e] * cs.x + other * cs.y); } }
                        bf16_t* dst = qi + (size_t)row * 512 + (pn - 5) * 256 + bj * 128 + wc * 32 + 4 * fq;
                        if (!dry) *(u32x2*)dst = pk4(a0); if (!dry) *(u32x2*)(dst + 16) = pk4(a1);
                    }
                } else {
                    if (wc < 2) {
                        f32x4 a0 = acc[ai][0][m][0] * rs; const f32x4 a1 = acc[ai][0][m][1] * rs;
                        if (wc == 0) { const f32x2* tb = tabI + p * 8 + 4 * (fq & 1);
#pragma unroll
                            for (int e = 0; e < 4; ++e) { const float other = __shfl_xor(a0[e], 32); const f32x2 cs = tb[e]; a0[e] = (fq < 2) ? (a0[e] * cs.x - other * cs.y) : (a0[e] * cs.x + other * cs.y); } }
                        bf16_t* dst = ki + (size_t)row * 64 + wc * 32 + 4 * fq; if (!dry) *(u32x2*)dst = pk4(a0); if (!dry) *(u32x2*)(dst + 16) = pk4(a1);
                    } else if (wc == 2) {
                        if (fq < 2) { const f32x4 a0 = acc[ai][0][m][0] * (rs * 0.04419417382415922f); if (!dry) *(f32x4*)(wi + (size_t)row * 8 + 4 * fq) = a0; }
                    }
                }
            }
    }
};

struct EpiUp {
#ifdef TPROBE
    static constexpr bool PERM = true, TIMED = true;
#else
    static constexpr bool PERM = true, TIMED = false;
#endif
    const float* ssq; bf16_t* hid; bool dry; unsigned char* wsb;
    __device__ __forceinline__ void operator()(const f32x4 (&acc)[2][2][4][2], const Unit& u, int wr, int wc, int fr, int fq) const {
        const int row0 = u.pm * 256 + wr * 64 + fr, col0 = u.pn * 256 + wc * 32 + 8 * fq;
#pragma unroll
        for (int ai = 0; ai < 2; ++ai)
#pragma unroll
            for (int m = 0; m < 4; ++m) {
                const int row = row0 + ai * 128 + m * 16;
                bf16_t* rowp = hid + (size_t)row * FF + col0;
#pragma unroll
                for (int bj = 0; bj < 2; ++bj) { f32x4 a0 = acc[ai][bj][m][0], a1 = acc[ai][bj][m][1];
#pragma unroll
                    for (int e = 0; e < 4; ++e) { const float r0 = fmaxf(a0[e], 0.f), r1 = fmaxf(a1[e], 0.f); a0[e] = r0 * r0; a1[e] = r1 * r1; }
                    u32x4 w; w.x = pk2(a0[0], a0[1]); w.y = pk2(a0[2], a0[3]); w.z = pk2(a1[0], a1[1]); w.w = pk2(a1[2], a1[3]);
                    *(u32x4*)(rowp + bj * 128) = w; }
            }
    }
};

struct EpiResid {
    static constexpr bool PERM = true, TIMED = false;
    bf16_t* xb; float* ssq; bool dry; const LAS float* rs2tab;
    __device__ __forceinline__ void operator()(const f32x4 (&acc)[2][2][4][2], const Unit& u, int wr, int wc, int fr, int fq) const {
        const int rl0 = wr * 64 + fr, row0 = u.pm * 256 + rl0, col0 = u.pn * 256 + wc * 32 + 8 * fq;
#pragma unroll
        for (int ai = 0; ai < 2; ++ai) {
            u32x4 xv[4][2];
#pragma unroll
            for (int m = 0; m < 4; ++m)
#pragma unroll
                for (int bj = 0; bj < 2; ++bj) xv[m][bj] = *(const u32x4*)(xb + (size_t)(row0 + ai * 128 + m * 16) * D + col0 + bj * 128);
#pragma unroll
            for (int m = 0; m < 4; ++m) {
                const int row = row0 + ai * 128 + m * 16; float s = 0.f; const float sc2 = rs2tab ? rs2tab[u.ord * 256 + rl0 + ai * 128 + m * 16] : 1.f;
#pragma unroll
                for (int bj = 0; bj < 2; ++bj) { const size_t off = (size_t)row * D + col0 + bj * 128;
                    const u32x4 xq = xv[m][bj]; f32x4 h0, h1;
                    h0.x = __uint_as_float(xq.x << 16); h0.y = __uint_as_float(xq.x & 0xffff0000u); h0.z = __uint_as_float(xq.y << 16); h0.w = __uint_as_float(xq.y & 0xffff0000u);
                    h1.x = __uint_as_float(xq.z << 16); h1.y = __uint_as_float(xq.z & 0xffff0000u); h1.z = __uint_as_float(xq.w << 16); h1.w = __uint_as_float(xq.w & 0xffff0000u);
                    h0 = h0 + acc[ai][bj][m][0] * sc2; h1 = h1 + acc[ai][bj][m][1] * sc2;
                    u32x4 w; w.x = pk2(h0[0], h0[1]); w.y = pk2(h0[2], h0[3]); w.z = pk2(h1[0], h1[1]); w.w = pk2(h1[2], h1[3]);
                    *(u32x4*)(xb + off) = w;
                    s += ((h0.x * h0.x + h0.y * h0.y) + (h0.z * h0.z + h0.w * h0.w)) + ((h1.x * h1.x + h1.y * h1.y) + (h1.z * h1.z + h1.w * h1.w)); }
                s += __shfl_xor(s, 16); s += __shfl_xor(s, 32);
                if (fq == 0) ssq[(size_t)row * 16 + u.pn * 4 + wc] = s;
            }
        }
    }
};

struct EpiBqk {
    static constexpr bool PERM = true, TIMED = false;
    const float* ssq; const int* pos; const f32x2* tabR; bf16_t *q1, *k1; bool dry;
    __device__ __forceinline__ void operator()(const f32x4 (&acc)[2][2][4][2], const Unit& u, int wr, int wc, int fr, int fq) const {
        const int row0 = u.pm * 256 + wr * 64 + fr; const bool isk = u.pn >= 4; bf16_t* dstb = isk ? k1 : q1; const float sc = isk ? 0.0625f : 1.0f; const int hd = u.pn & 3;
#pragma unroll
        for (int ai = 0; ai < 2; ++ai)
#pragma unroll
            for (int m = 0; m < 4; ++m) {
                const int row = row0 + ai * 128 + m * 16; const float rs = sc;
                int p = pos[row]; p = p < 0 ? 0 : (p > SEQ - 1 ? SEQ - 1 : p);
                const f32x2* tb = tabR + p * 128 + wc * 32 + 8 * fq; float x1[8], x2[8];
#pragma unroll
                for (int e = 0; e < 4; ++e) { x1[e] = acc[ai][0][m][0][e] * rs; x1[4 + e] = acc[ai][0][m][1][e] * rs; x2[e] = acc[ai][1][m][0][e] * rs; x2[4 + e] = acc[ai][1][m][1][e] * rs; }
#pragma unroll
                for (int e = 0; e < 8; ++e) { const f32x2 cs = tb[e]; const float a = x1[e], b = x2[e]; x1[e] = a * cs.x - b * cs.y; x2[e] = b * cs.x + a * cs.y; }
                bf16_t* dst = dstb + (size_t)row * 1024 + hd * 256 + wc * 32 + 8 * fq;
                u32x4 w1, w2; w1.x = pk2(x1[0], x1[1]); w1.y = pk2(x1[2], x1[3]); w1.z = pk2(x1[4], x1[5]); w1.w = pk2(x1[6], x1[7]); w2.x = pk2(x2[0], x2[1]); w2.y = pk2(x2[2], x2[3]); w2.z = pk2(x2[4], x2[5]); w2.w = pk2(x2[6], x2[7]);
                *(u32x4*)dst = w1; *(u32x4*)(dst + 128) = w2;
            }
    }
};
struct EpiBv {
    static constexpr bool PERM = false, TIMED = false;
    const float* ssq; bf16_t* vT; bool dry;
    __device__ __forceinline__ void operator()(const f32x4 (&acc)[2][2][4][2], const Unit& u, int wr, int wc, int fr, int fq) const {
        const int rowb = u.pm * 256 + wr * 64 + 4 * fq; const int b = u.pm >> 4;
#pragma unroll
        for (int ai = 0; ai < 2; ++ai)
#pragma unroll
            for (int m = 0; m < 4; ++m) {
                const int row = rowb + ai * 128 + m * 16;
                const int t = row & (SEQ - 1);
#pragma unroll
                for (int bj = 0; bj < 2; ++bj)
#pragma unroll
                    for (int n = 0; n < 2; ++n) { const int c = u.pn * 256 + bj * 128 + wc * 32 + n * 16 + fr;
                        const f32x4 a = acc[ai][bj][m][n];
                        if (!dry) *(u32x2*)(vT + ((size_t)(b * 4 + (c >> 9)) * 512 + (c & 511)) * SEQ + t) = pk4(a); }
            }
    }
};
struct EpiGate {
    static constexpr bool PERM = true, TIMED = false;
    const LAS f32x4* tab; bf16_t* y; bool dry;
    __device__ __forceinline__ void operator()(const f32x4 (&acc)[2][2][4][2], const Unit& u, int wr, int wc, int fr, int fq) const {
        const int rl0 = wr * 64 + fr, row0 = u.pm * 256 + rl0, col0 = u.pn * 256 + wc * 32 + 8 * fq;
#pragma unroll
        for (int ai = 0; ai < 2; ++ai) {
            u32x4 yv[1][4][2];
#pragma unroll
            for (int m = 0; m < 4; ++m)
#pragma unroll
                for (int bj = 0; bj < 2; ++bj) yv[0][m][bj] = *(const u32x4*)(y + (size_t)(row0 + ai * 128 + m * 16) * 2048 + col0 + bj * 128);
#pragma unroll
            for (int m = 0; m < 4; ++m) {
                const f32x4 tv = tab[u.ord * 256 + rl0 + ai * 128 + m * 16]; const float rs = tv.x, mu = tv.y, rh = tv.z;
                bf16_t* rowp = y + (size_t)(row0 + ai * 128 + m * 16) * 2048 + col0;
#pragma unroll
                for (int bj = 0; bj < 2; ++bj) { const u32x4 yq = yv[0][m][bj]; float yf[8], g[8], o[8];
                    yf[0] = __uint_as_float(yq.x << 16); yf[1] = __uint_as_float(yq.x & 0xffff0000u); yf[2] = __uint_as_float(yq.y << 16); yf[3] = __uint_as_float(yq.y & 0xffff0000u);
                    yf[4] = __uint_as_float(yq.z << 16); yf[5] = __uint_as_float(yq.z & 0xffff0000u); yf[6] = __uint_as_float(yq.w << 16); yf[7] = __uint_as_float(yq.w & 0xffff0000u);
#pragma unroll
                    for (int e = 0; e < 4; ++e) { g[e] = acc[ai][bj][m][0][e] * rs; g[4 + e] = acc[ai][bj][m][1][e] * rs; }
#pragma unroll
                    for (int e = 0; e < 8; ++e) { const float sg = g[e] * __builtin_amdgcn_rcpf(1.0f + __builtin_amdgcn_exp2f(-1.4426950408889634f * g[e])); o[e] = sg * ((yf[e] - mu) * rh); }
                    u32x4 w; w.x = pk2(o[0], o[1]); w.y = pk2(o[2], o[3]); w.z = pk2(o[4], o[5]); w.w = pk2(o[6], o[7]);
                    *(u32x4*)(rowp + bj * 128) = w; }
            }
        }
    }
};

#ifndef PROBE_MASK
#define PROBE_MASK 0u
#endif
constexpr int NWAVES = 8, NTHREADS = NWAVES * 64;
constexpr int RING_BYTES = 131072, LDS_BYTES = 163840, LDSCTL_OFF = LDS_BYTES - 1024, MISC_OFF = LDSCTL_OFF + 320;

struct Args {
    const float* x; const int* pos; const float* norm_mix_g; const float* norm_mlp_g; const float* w_in_a; const float* w_out_a; const float* w_in_b; const float* ret_norm_g;
    const float* w_out_b; const float* w_mlp_up; const float* w_mlp_down; const float* final_norm_g;
    float* out; unsigned char* ws; int ph_lo, ph_hi, li, pad;
};

#define XB_TMO      128
#define XB_XCNT(j)  (256  + 64 * (j))
#define XB_XSUB(j)  (1280 + 64 * (j))
#define XB_XGEN(j)  (2304 + 64 * (j))
#define XB_TOP      3328
#define XB_TOPGEN   3392
#define XCD_BAR_WORDS 3456
#define XB_SPIN_CAP (1u << 22)
constexpr int CW_BAR = 4096;
__device__ __forceinline__ unsigned xb_ld(unsigned* p)              { return __hip_atomic_load(p, __ATOMIC_RELAXED, __HIP_MEMORY_SCOPE_AGENT); }
__device__ __forceinline__ unsigned xb_add(unsigned* p, unsigned v) { return __hip_atomic_fetch_add(p, v, __ATOMIC_RELAXED, __HIP_MEMORY_SCOPE_AGENT); }
__device__ __forceinline__ unsigned xb_xcc_id() { return (unsigned)__builtin_amdgcn_s_getreg((3 << 11) | 20) & 0xFu; }
#define XB_SPIN(cond, bar) do { unsigned _sp = 0; while (cond) { __builtin_amdgcn_s_sleep(1); \
    if ((++_sp & 255u) == 0u) { if (xb_ld(&(bar)[XB_TMO])) break; if (_sp > XB_SPIN_CAP) { atomicAdd(&(bar)[XB_TMO], 1u); break; } } } } while (0)
struct XcdBarrier { unsigned* bar; unsigned x; volatile LAS unsigned* st; };
__device__ __forceinline__ XcdBarrier xcd_barrier_post(unsigned* bar, volatile LAS unsigned* st) {
    XcdBarrier b; b.bar = bar; b.x = xb_xcc_id(); b.st = st;
    if (threadIdx.x == 0) (void)xb_add(&bar[XB_XCNT(b.x)], 1u);
    return b;
}
__device__ __forceinline__ void xcd_barrier_complete(unsigned* bar, unsigned x, unsigned& nloc, unsigned& nx) {
    const unsigned G = gridDim.x * gridDim.y * gridDim.z;
    unsigned sum, cnt, mine, sp = 0u;
    for (;;) {
        sum = 0u; cnt = 0u; mine = 0u;
#pragma unroll
        for (unsigned j = 0; j < 16; ++j) { const unsigned c = xb_ld(&bar[XB_XCNT(j)]); sum += c; cnt += (c > 0u) ? 1u : 0u; mine = (j == x) ? c : mine; }
        if (sum == G) break;
        __builtin_amdgcn_s_sleep(1);
        if ((++sp & 255u) == 0u) { if (xb_ld(&bar[XB_TMO])) break; if (sp > XB_SPIN_CAP) { atomicAdd(&bar[XB_TMO], 1u); break; } }
    }
    nloc = mine > 0u ? mine : 1u; nx = cnt > 0u ? cnt : 1u;
}
__device__ __forceinline__ void xcd_barrier(const XcdBarrier& b) {
    asm volatile("s_waitcnt vmcnt(0)" ::: "memory");
    __syncthreads();
    if (threadIdx.x == 0) {
        unsigned* bar = b.bar;
        __builtin_amdgcn_s_waitcnt(0);
        unsigned nloc = b.st[0], nx = b.st[1];
        if (nloc == 0u) { xcd_barrier_complete(bar, b.x, nloc, nx); b.st[0] = nloc; b.st[1] = nx; }
        const unsigned old = xb_add(&bar[XB_XSUB(b.x)], 1u);
        const unsigned gen = old / nloc;
        if (old + 1u == (gen + 1u) * nloc) {
            __builtin_amdgcn_fence(__ATOMIC_RELEASE, "agent");
            asm volatile("s_waitcnt vmcnt(0)" ::: "memory");
            const unsigned og = xb_add(&bar[XB_TOP], 1u);
            const unsigned tg = og / nx;
            if (og + 1u == (tg + 1u) * nx) xb_add(&bar[XB_TOPGEN], 1u);
            else XB_SPIN(xb_ld(&bar[XB_TOPGEN]) == tg, bar);
            __builtin_amdgcn_fence(__ATOMIC_ACQUIRE, "agent");
            xb_add(&bar[XB_XGEN(b.x)], 1u);
            asm volatile("s_waitcnt vmcnt(0)" ::: "memory");
        } else {
            XB_SPIN(xb_ld(&bar[XB_XGEN(b.x)]) == gen, bar);
            __builtin_amdgcn_fence(__ATOMIC_ACQUIRE, "agent");
            asm volatile("s_waitcnt vmcnt(0)" ::: "memory");
        }
    }
    __syncthreads();
}

typedef float f32x16 __attribute__((ext_vector_type(16)));
#define MFMA32(a, b, c) __builtin_amdgcn_mfma_f32_32x32x16_bf16((a), (b), (c), 0, 0, 0)
constexpr int ST_STRIDE = 528, ST_BUF = 64 * ST_STRIDE;
constexpr int RET_X = 0, RET_YV = 65536, RET_YI = 65536 + 16384, RET_ST = 114688;

enum Phase { PH_PROLOGUE = 0, PH_GEMM_A, PH_DSA, PH_OUT_A, PH_UP0, PH_DOWN0, PH_GEMM_B, PH_R1, PH_RET, PH_GATE, PH_OUT_B, PH_UP1, PH_DOWN1, PH_FINAL, PH_COUNT };

__device__ __forceinline__ void transpose_item(const float* W, const float* gain, int K, int N, int Npad, bf16_t* WT, LAS float* scr, int item, int lane) {
    const int nblk = Npad / 32, kb = item / nblk, nb = item % nblk, k0 = 64 * kb, n0 = 32 * nb;
    const int nn = n0 + (lane & 31);
    float tv[32];
#pragma unroll
    for (int i = 0; i < 32; ++i) { const int kk = 2 * i + (lane >> 5); tv[i] = (nn < N) ? W[(size_t)(k0 + kk) * N + nn] : 0.f; }
#pragma unroll
    for (int i = 0; i < 32; ++i) { const int kk = 2 * i + (lane >> 5); float v = tv[i]; if (gain) v *= gain[k0 + kk]; scr[kk * 33 + (lane & 31)] = v; }
    asm volatile("s_waitcnt lgkmcnt(0)" ::: "memory");
    const int c = lane & 7;
#pragma unroll
    for (int j = 0; j < 4; ++j) { const int n = (lane >> 3) + 8 * j; const LAS float* s = scr + (8 * c) * 33 + n;
        u32x4 o; o.x = pk2(s[0 * 33], s[1 * 33]); o.y = pk2(s[2 * 33], s[3 * 33]); o.z = pk2(s[4 * 33], s[5 * 33]); o.w = pk2(s[6 * 33], s[7 * 33]);
        *(u32x4*)(WT + (size_t)(n0 + n) * K + k0 + 8 * c) = o; }
    asm volatile("s_waitcnt lgkmcnt(0)" ::: "memory");
}


typedef short v4i16_t __attribute__((ext_vector_type(4)));
constexpr int DSA_SEL_OFF = RING_BYTES + 1024, DSA_RED_OFF = DSA_SEL_OFF + 4096, DSA_TOT_OFF = DSA_RED_OFF + 512, DSA_RES_OFF = DSA_TOT_OFF + 256;
static_assert(DSA_RES_OFF + 128 <= LDS_BYTES, "DSA LDS map");
__device__ __forceinline__ unsigned okey(float f) { const unsigned u = __float_as_uint(f); return u ^ ((unsigned)((int)u >> 31) | 0x80000000u); }
#define MFMA16(a, b, c) __builtin_amdgcn_mfma_f32_16x16x32_bf16((a), (b), (c), 0, 0, 0)

__device__ __forceinline__ unsigned wave_incl_scan(unsigned v) {
    v += (unsigned)__builtin_amdgcn_update_dpp(0, (int)v, 0x111, 0xf, 0xf, false);
    v += (unsigned)__builtin_amdgcn_update_dpp(0, (int)v, 0x112, 0xf, 0xf, false);
    v += (unsigned)__builtin_amdgcn_update_dpp(0, (int)v, 0x114, 0xf, 0xf, false);
    v += (unsigned)__builtin_amdgcn_update_dpp(0, (int)v, 0x118, 0xf, 0xf, false);
    v += (unsigned)__builtin_amdgcn_update_dpp(0, (int)v, 0x142, 0xa, 0xf, false);
    v += (unsigned)__builtin_amdgcn_update_dpp(0, (int)v, 0x143, 0xc, 0xf, false);
    return v;
}
__device__ __forceinline__ unsigned wave_min_u32(unsigned v) {
    v = min(v, (unsigned)__builtin_amdgcn_update_dpp(-1, (int)v, 0x111, 0xf, 0xf, false));
    v = min(v, (unsigned)__builtin_amdgcn_update_dpp(-1, (int)v, 0x112, 0xf, 0xf, false));
    v = min(v, (unsigned)__builtin_amdgcn_update_dpp(-1, (int)v, 0x114, 0xf, 0xf, false));
    v = min(v, (unsigned)__builtin_amdgcn_update_dpp(-1, (int)v, 0x118, 0xf, 0xf, false));
    v = min(v, (unsigned)__builtin_amdgcn_update_dpp(-1, (int)v, 0x142, 0xa, 0xf, false));
    v = min(v, (unsigned)__builtin_amdgcn_update_dpp(-1, (int)v, 0x143, 0xc, 0xf, false));
    return (unsigned)__builtin_amdgcn_readlane((int)v, 63);
}
template <class Tv> __device__ __forceinline__ Tv ldu(const void* ubase, unsigned voff) { return *(const Tv*)((const char*)ubase + voff); }

__device__ __forceinline__ void dsa_phase(LAS unsigned char* lds, const bf16_t* __restrict__ q, const bf16_t* __restrict__ k, const bf16_t* __restrict__ v, const bf16_t* __restrict__ qi, const bf16_t* __restrict__ ki,
                                          const float* __restrict__ wi, bf16_t* __restrict__ o, int vcu, int G, int tid_, int lane_, int wave, unsigned char* wsb) {
    TS_DECL;
    LAS unsigned short* selbuf = (LAS unsigned short*)(lds + DSA_SEL_OFF);
    LAS unsigned* keysL = (LAS unsigned*)lds;
    const int npu = 2048;
    const bool even = (npu % G) == 0; const int per = even ? npu / G : 0;
    for (int it = 0;; ++it) {
        int pu; if (even) { if (it >= per) break; pu = vcu * per + it; } else { pu = it * G + vcu; if (pu >= npu) break; }
        const int b = pu >> 8, pr = pu & 255;
#pragma unroll 1
        for (int which = 0; which < 2; ++which) {
            int lane = lane_; asm volatile("" : "+v"(lane));
            const int hf = lane >> 5, l31 = lane & 31, fr = lane & 15, fq = lane >> 4;
            LAS unsigned char* wbuf = lds + wave * 16384;
            LAS unsigned short* sel = selbuf + wave * 320;
            const int g = which ? 511 - pr : pr; const int t0 = 8 * g; const size_t tok0 = (size_t)b * SEQ + t0;
            const int t = t0 + wave;
            TS(7);
            __syncthreads();
            TS(8);
            if (t0 + 7 < TOPK) {
#pragma unroll
                for (int i = 0; i < 4; ++i) { const int p = lane + 64 * i; sel[p] = (unsigned short)((p <= t) ? p : 0xFFFF); }
            } else {
                const int nkt = ((t0 + 7) >> 5) + 1;
                const unsigned kvoff = (unsigned)(l31 * 128 + 16 * hf);
                const bf16_t* qib = qi + tok0 * 512; const float* wib = wi + tok0 * 8;
                bf16x8 af[2][4]; f32x4 wlo[2][2], whi[2][2];
#pragma unroll
                for (int rt = 0; rt < 2; ++rt) {
                    const int qla = 4 * rt + 2 * ((l31 >> 2) & 1) + (l31 >> 4), hd = (l31 & 3) + 4 * ((l31 >> 3) & 1);
                    const unsigned aoff = (unsigned)((qla * 512 + hd * 64 + 8 * hf) * 2);
#pragma unroll
                    for (int sk = 0; sk < 4; ++sk) af[rt][sk] = ldu<bf16x8>(qib, aoff + 32 * sk);
#pragma unroll
                    for (int j = 0; j < 2; ++j) { const unsigned woff = (unsigned)((4 * rt + 2 * hf + j) * 32); wlo[rt][j] = ldu<f32x4>(wib, woff) * 0.5f; whi[rt][j] = ldu<f32x4>(wib, woff + 16) * 0.5f; }
                }
                LAS unsigned* kq0 = keysL + (2 * hf) * 4096 + l31; LAS unsigned* kq2 = keysL + (4 + 2 * hf) * 4096 + l31;
                bf16x8 bfr[3][4];
#define B_LOAD(i_) do { const int kt_ = wave + 8 * (i_); if (kt_ < nkt) { const bf16_t* bpu = ki + ((size_t)b * SEQ + 32 * kt_) * 64; \
        _Pragma("unroll") for (int sk = 0; sk < 4; ++sk) bfr[(i_) % 3][sk] = ldu<bf16x8>(bpu, kvoff + 32 * sk); } } while (0)
#define SC_MMA(ACC, RT, I) do { _Pragma("unroll") for (int r = 0; r < 16; ++r) ACC[r] = 0.f; _Pragma("unroll") for (int sk = 0; sk < 4; ++sk) ACC = MFMA32(af[RT][sk], bfr[(I) % 3][sk], ACC); } while (0)
#define SC_EPI(ACC, RT, I) do { const int kt_ = wave + 8 * (I); const int kidx = 32 * kt_ + l31; \
        _Pragma("unroll") for (int j = 0; j < 2; ++j) { float sa = 0.f, sb = 0.f;     \
            _Pragma("unroll") for (int h = 0; h < 4; ++h) { sa = fmaf(ACC[8 * j + h], wlo[RT][j][h], sa); sb = fmaf(__builtin_fabsf(ACC[8 * j + h]), wlo[RT][j][h], sb); } \
            _Pragma("unroll") for (int h = 0; h < 4; ++h) { sa = fmaf(ACC[8 * j + 4 + h], whi[RT][j][h], sa); sb = fmaf(__builtin_fabsf(ACC[8 * j + 4 + h]), whi[RT][j][h], sb); } \
            const float sc = (sa + sb) + 0.0f;                                   \
            const int tq = t0 + 4 * (RT) + 2 * hf + j; const unsigned kv = (kidx <= tq) ? okey(sc) : 0u; \
            ((RT) ? kq2 : kq0)[j * 4096 + 32 * kt_] = kv; } } while (0)
                f32x16 accA, accB;
                B_LOAD(0); B_LOAD(1);
                SC_MMA(accA, 0, 0);
#pragma unroll
                for (int i = 0; i < 16; ++i) {
                    const int kt = wave + 8 * i;
                    if (kt < nkt) {
                        if (i + 2 < 16) B_LOAD(i + 2);
                        SC_MMA(accB, 1, i);
                        SC_EPI(accA, 0, i);
                        if (i + 1 < 16) { if (kt + 8 < nkt) SC_MMA(accA, 0, i + 1); }
                        SC_EPI(accB, 1, i);
                    }
                }
#undef SC_MMA
#undef SC_EPI
#undef B_LOAD
                TS(0);
                __syncthreads();
                TS(9);
                const int nj = (nkt + 1) >> 1;
                unsigned key[64];
#pragma unroll
                for (int j = 0; j < 64; ++j) key[j] = 0u;
#pragma unroll
                for (int c = 0; c < 16; ++c) if (4 * c < nj) {
#pragma unroll
                    for (int j = 4 * c; j < 4 * c + 4; ++j) { const int kidx = lane + 64 * j; if (kidx < 32 * nkt) key[j] = keysL[wave * 4096 + kidx]; } }
                TS(1);
                LAS unsigned* hist = (LAS unsigned*)wbuf;
                unsigned thr = 0u, need = (unsigned)TOPK, bincnt = 0u;
#define RADIX_PASS(SHIFT, BITS, FIRST) do { \
        _Pragma("unroll") for (int i_ = 0; i_ < 8; ++i_) ((LAS u32x4*)hist)[lane + 64 * i_] = (u32x4){0u, 0u, 0u, 0u}; \
        _Pragma("unroll") for (int c_ = 0; c_ < 16; ++c_) if (4 * c_ < nj) _Pragma("unroll") for (int j = 4 * c_; j < 4 * c_ + 4; ++j) { const unsigned k_ = key[j]; \
            const unsigned m_ = (FIRST) ? ((k_ != 0u) ? 1u : 0u) : ((((k_ >> ((SHIFT) + (BITS) - 1)) >> 1) == thr) ? 1u : 0u); \
            if (m_) __hip_atomic_fetch_add(hist + ((k_ >> (SHIFT)) & ((1u << (BITS)) - 1u)), 1u, __ATOMIC_RELAXED, __HIP_MEMORY_SCOPE_WORKGROUP); } \
        {   \
          const int lb_ = 2016 - 32 * lane; unsigned s_ = 0u; \
          _Pragma("unroll") for (int j_ = 0; j_ < 8; ++j_) { const u32x4 h4 = *(const LAS u32x4*)(hist + lb_ + 4 * j_); s_ += (h4.x + h4.y) + (h4.z + h4.w); } \
          const unsigned x_ = wave_incl_scan(s_); const unsigned T_ = x_ - s_; \
          const unsigned long long bm_ = __ballot(T_ < need && x_ >= need); \
          const int Ls_ = (int)__builtin_ctzll(bm_ | 0x8000000000000000ull); \
          const unsigned Ts_ = (unsigned)__builtin_amdgcn_readlane((int)T_, Ls_); \
          const int bb_ = 2016 - 32 * Ls_;                           \
          const unsigned hv_ = (lane < 32) ? hist[bb_ + 31 - lane] : 0u; \
          const unsigned x2_ = wave_incl_scan(hv_); const unsigned T2_ = Ts_ + x2_ - hv_; \
          const unsigned long long bm2_ = __ballot(lane < 32 && T2_ < need && T2_ + hv_ >= need); \
          const int js_ = (int)__builtin_ctzll(bm2_ | 0x8000000000000000ull); \
          thr = (thr << (BITS)) | (unsigned)(bb_ + 31 - js_); need = need - (unsigned)__builtin_amdgcn_readlane((int)T2_, js_); bincnt = (unsigned)__builtin_amdgcn_readlane((int)hv_, js_); } \
    } while (0)
                RADIX_PASS(21, 11, true);
                RADIX_PASS(10, 11, false);
                if (bincnt == need) {
                    const unsigned lo_ = thr << 10; unsigned mn_ = 0xFFFFFFFFu;
#pragma unroll
                    for (int c = 0; c < 16; ++c) if (4 * c < nj) {
#pragma unroll
                        for (int j = 4 * c; j < 4 * c + 4; ++j) mn_ = min(mn_, key[j] - lo_); }
                    thr = lo_ + wave_min_u32(mn_);
                } else {
                    RADIX_PASS(0, 10, false);
                }
#undef RADIX_PASS
                TS(2);
                if (bincnt == need) {
                    unsigned mlo = 0u, mhi = 0u;
#define GE_BIT(m_, k_) asm("v_cmp_le_u32 vcc, %2, %1\n\tv_addc_co_u32 %0, vcc, %0, %0, vcc" : "+v"(m_) : "v"(k_), "s"(thr) : "vcc")
#pragma unroll
                    for (int c = 0; c < 8; ++c) if (4 * c < nj) { GE_BIT(mlo, key[4 * c]); GE_BIT(mlo, key[4 * c + 1]); GE_BIT(mlo, key[4 * c + 2]); GE_BIT(mlo, key[4 * c + 3]); }
#pragma unroll
                    for (int c = 8; c < 16; ++c) if (4 * c < nj) { GE_BIT(mhi, key[4 * c]); GE_BIT(mhi, key[4 * c + 1]); GE_BIT(mhi, key[4 * c + 2]); GE_BIT(mhi, key[4 * c + 3]); }
#undef GE_BIT
                    const unsigned cge = (unsigned)(__builtin_popcount(mlo) + __builtin_popcount(mhi));
                    const int nj4 = (nj + 3) & ~3, nlo = nj4 < 32 ? nj4 : 32, nhi = nj4 - nlo;
                    LAS unsigned short* sp = sel + ((wave_incl_scan(cge) - cge) & 255u);
                    unsigned ib = (unsigned)(lane + 64 * (nlo - 1));
                    while (mlo) { const unsigned b_ = (unsigned)__builtin_ctz(mlo); mlo &= mlo - 1u; *sp++ = (unsigned short)(ib - 64u * b_); }
                    ib = (unsigned)(lane + 64 * (31 + nhi));
                    while (mhi) { const unsigned b_ = (unsigned)__builtin_ctz(mhi); mhi &= mhi - 1u; *sp++ = (unsigned short)(ib - 64u * b_); }
                } else {
                    unsigned base = 0u, eqbase = 0u;
#pragma unroll
                    for (int j = 0; j < 64; ++j) if (j < nj) {
                        const unsigned k_ = key[j]; const bool gt = k_ > thr, eq = k_ == thr;
                        const unsigned long long beq = __ballot(eq);
                        const unsigned eqr = eqbase + __builtin_amdgcn_mbcnt_hi((unsigned)(beq >> 32), __builtin_amdgcn_mbcnt_lo((unsigned)beq, 0u));
                        const bool take = gt || (eq && eqr < need);
                        const unsigned long long bt = __ballot(take);
                        const unsigned pos = base + __builtin_amdgcn_mbcnt_hi((unsigned)(bt >> 32), __builtin_amdgcn_mbcnt_lo((unsigned)bt, 0u));
                        if (take) sel[pos & 255u] = (unsigned short)(lane + 64 * j);
                        base += (unsigned)__builtin_popcountll(bt); eqbase += (unsigned)__builtin_popcountll(beq);
                    }
                }
            }
            TS(3);
            {
                const size_t tok = tok0 + wave;
                const bf16_t* qb = q + tok * 1024; const bf16_t* kb = k + (size_t)b * SEQ * 128; const bf16_t* vb = v + (size_t)b * SEQ * 128;
                bf16x8 qf[4];
                { const unsigned qoff = (unsigned)(((fr & 7) * 128 + 8 * fq) * 2);
#pragma unroll
                  for (int sk = 0; sk < 4; ++sk) qf[sk] = ldu<bf16x8>(qb, qoff + 64 * sk); }
                u32x4 kr[3][4];
#define K_LOAD(kt_) do { _Pragma("unroll") for (int i = 0; i < 4; ++i) { const int rr = fq + 4 * i; unsigned ix = sel[16 * (kt_) + rr]; ix = (ix == 0xFFFFu) ? 0u : ix; kr[(kt_) % 3][i] = ldu<u32x4>(kb, ix * 256u + 16u * fr); } } while (0)
#define K_WRITE(kt_) do { _Pragma("unroll") for (int i = 0; i < 4; ++i) { const int rr = fq + 4 * i; *(LAS u32x4*)(wbuf + ((kt_) & 1) * 4096 + rr * 256 + 16 * (fr ^ rr)) = kr[(kt_) % 3][i]; } } while (0)
                f32x4 lg[16];
                K_LOAD(0); K_LOAD(1); K_LOAD(2); K_WRITE(0);
#pragma unroll
                for (int kt = 0; kt < 16; ++kt) {
                    if (kt + 3 < 16) K_LOAD(kt + 3);
                    const LAS unsigned char* kbase = wbuf + (kt & 1) * 4096 + fr * 256;
                    f32x4 acc = (f32x4){0.f, 0.f, 0.f, 0.f};
#pragma unroll
                    for (int sk = 0; sk < 4; ++sk) { const bf16x8 ka = *(const LAS bf16x8*)(kbase + 16 * ((4 * sk + fq) ^ fr)); acc = MFMA16(ka, qf[sk], acc); }
#pragma unroll
                    for (int r = 0; r < 4; ++r) { const int p = 16 * kt + 4 * fq + r; lg[kt][r] = (t >= TOPK - 1 || p <= t) ? acc[r] : -INFINITY; }
                    if (kt + 1 < 16) K_WRITE(kt + 1);
                }
#undef K_LOAD
#undef K_WRITE
                TS(4);
                u32x4 vr[2][8];
#define V_LOAD(u) do { _Pragma("unroll") for (int i = 0; i < 8; ++i) { const int rr = fq + 4 * i; unsigned ix = sel[32 * (u) + rr]; ix = (ix == 0xFFFFu) ? 0u : ix; vr[(u) & 1][i] = ldu<u32x4>(vb, ix * 256u + 16u * fr); } } while (0)
#define V_WRITE(u) do { _Pragma("unroll") for (int i = 0; i < 8; ++i) { const int rr = fq + 4 * i; *(LAS u32x4*)(wbuf + ((u) & 1) * 8192 + rr * 256 + 16 * (fr ^ ((rr & 7) << 1))) = vr[(u) & 1][i]; } } while (0)
                V_LOAD(0); V_LOAD(1);
                float mx = -INFINITY;
#pragma unroll
                for (int kt = 0; kt < 16; ++kt) mx = fmaxf(fmaxf(mx, fmaxf(lg[kt][0], lg[kt][1])), fmaxf(lg[kt][2], lg[kt][3]));
                mx = fmaxf(mx, __shfl_xor(mx, 16)); mx = fmaxf(mx, __shfl_xor(mx, 32));
                float sm = 0.f;
#pragma unroll
                for (int kt = 0; kt < 16; ++kt)
#pragma unroll
                    for (int r = 0; r < 4; ++r) { const float e = exp2f(lg[kt][r] - mx); lg[kt][r] = e; sm += e; }
                sm += __shfl_xor(sm, 16); sm += __shfl_xor(sm, 32);
                bf16x8 pb[8];
#pragma unroll
                for (int u = 0; u < 8; ++u) { u32x4 w; w.x = pk2(lg[2 * u][0], lg[2 * u][1]); w.y = pk2(lg[2 * u][2], lg[2 * u][3]); w.z = pk2(lg[2 * u + 1][0], lg[2 * u + 1][1]); w.w = pk2(lg[2 * u + 1][2], lg[2 * u + 1][3]);
                    pb[u] = __builtin_bit_cast(bf16x8, w); }
                f32x4 oacc[8];
#pragma unroll
                for (int dt = 0; dt < 8; ++dt) oacc[dt] = (f32x4){0.f, 0.f, 0.f, 0.f};
                TS(5);
                V_WRITE(0);
                const int qq = fr >> 2, pp = fr & 3;
#pragma unroll
                for (int u = 0; u < 8; ++u) {
                    const LAS unsigned char* vbase = wbuf + (u & 1) * 8192;
                    const int rA = 4 * fq + qq, rB = 16 + 4 * fq + qq;
                    bf16x8 va[8];
#pragma unroll
                    for (int dt = 0; dt < 8; ++dt) {
                        const int ch = 2 * dt + (pp >> 1);
                        const v4i16_t alo = __builtin_amdgcn_ds_read_tr16_b64_v4i16((LAS v4i16_t*)(vbase + rA * 256 + 16 * (ch ^ ((rA & 7) << 1)) + 8 * (pp & 1)));
                        const v4i16_t ahi = __builtin_amdgcn_ds_read_tr16_b64_v4i16((LAS v4i16_t*)(vbase + rB * 256 + 16 * (ch ^ ((rB & 7) << 1)) + 8 * (pp & 1)));
                        va[dt][0] = alo[0]; va[dt][1] = alo[1]; va[dt][2] = alo[2]; va[dt][3] = alo[3]; va[dt][4] = ahi[0]; va[dt][5] = ahi[1]; va[dt][6] = ahi[2]; va[dt][7] = ahi[3];
                    }
                    if (u + 1 < 8) V_WRITE(u + 1);
                    if (u + 2 < 8) V_LOAD(u + 2);
#pragma unroll
                    for (int dt = 0; dt < 8; ++dt) oacc[dt] = MFMA16(va[dt], pb[u], oacc[dt]);
                }
#undef V_LOAD
#undef V_WRITE
                TS(6);
                const float inv = 1.0f / sm;
                if (fr < 8) { bf16_t* op = o + tok * 1024 + fr * 128 + 4 * fq;
#pragma unroll
                    for (int dt = 0; dt < 8; ++dt) *(u32x2*)(op + 16 * dt) = pk4(oacc[dt] * inv); }
            }
        }
    }
    TS_EXPORT(wsb, blockIdx.x == 0 && wave == 0 && lane_ == 0);
}

__global__ void __launch_bounds__(NTHREADS, 2) mk_fwd(Args a) {
    extern __shared__ __attribute__((aligned(16))) unsigned char lds_raw[];
    LAS unsigned char* lds = (LAS unsigned char*)lds_raw;
    const int tid = threadIdx.x, lane = tid & 63, wave = __builtin_amdgcn_readfirstlane(tid >> 6);
    const int G = gridDim.x, bx = blockIdx.x;
    const int vcu = (G % 8 == 0) ? (bx % 8) * (G / 8) + bx / 8 : bx;
    unsigned char* ws = a.ws;
    float* ssq = (float*)(ws + WS_SSQ); float* ssq1 = (float*)(ws + WS_STATS);
    const int lo = a.ph_lo, hi = a.ph_hi;
#define IN(k) (lo <= (k) && (k) < hi)
#define SEAM(k) do { if (IN(k) && IN((k) + 1)) xcd_barrier(bar); } while (0)
    for (int u = tid; u < (LDS_BYTES - LDSCTL_OFF) / 4; u += NTHREADS) ((LAS unsigned*)(lds + LDSCTL_OFF))[u] = 0u;
    __syncthreads();
    TS_DECL;
    XcdBarrier bar; bar.bar = (unsigned*)(ws + WS_CTL) + CW_BAR + a.li * XCD_BAR_WORDS; bar.x = 0; bar.st = nullptr;
    if (hi - lo > 1) bar = xcd_barrier_post(bar.bar, (volatile LAS unsigned*)(lds + MISC_OFF) + 8);

    if (IN(PH_PROLOGUE)) for (int rep_ = 0; rep_ < 1 + (int)((PROBE_MASK >> 3) & 1u); ++rep_) {
        LAS float* scr = (LAS float*)(lds + wave * 16384);
        const int gw = vcu * NWAVES + wave, NGW = G * NWAVES;
        int base = 0;
#define CONV(Wp, gp, K_, N_, Np_, dst) do { const int n_ = ((K_) / 64) * ((Np_) / 32); int first = gw - (base % NGW); if (first < 0) first += NGW; \
            for (int it = first; it < n_; it += NGW) transpose_item(Wp, gp, K_, N_, Np_, (bf16_t*)(ws + (dst)), scr, it, lane); base += n_; } while (0)
        CONV(a.w_in_a, a.norm_mix_g, D, A_IN, A_PAD, WS_WA);
        CONV(a.w_out_a, (const float*)nullptr, D, D, D, WS_WOA);
        CONV(a.w_mlp_up, a.norm_mlp_g, D, FF, FF, WS_WUP0);
        CONV(a.w_mlp_down, (const float*)nullptr, FF, D, D, WS_WDN0);
        CONV(a.w_in_b, a.norm_mix_g + D, D, B_IN, B_IN, WS_WB);
        CONV(a.w_out_b, a.ret_norm_g, 2048, D, D, WS_WOB);
        CONV(a.w_mlp_up + (size_t)D * FF, a.norm_mlp_g + D, D, FF, FF, WS_WUP1);
        CONV(a.w_mlp_down + (size_t)FF * D, (const float*)nullptr, FF, D, D, WS_WDN1);
#undef CONV
        bf16_t* xb = (bf16_t*)(ws + WS_XB);
        for (int row = gw; row < T; row += NGW) {
            const f32x4* xr = (const f32x4*)(a.x + (size_t)row * D) + lane; u32x2* xo = (u32x2*)(xb + (size_t)row * D) + lane;
            float s = 0.f;
#pragma unroll
            for (int j = 0; j < 4; ++j) { const f32x4 v = xr[64 * j]; xo[64 * j] = pk4(v); s += (v.x * v.x + v.y * v.y) + (v.z * v.z + v.w * v.w); }
            s = wave_sum(s);
            if (lane < 16) ssq[(size_t)row * 16 + lane] = (lane == 0) ? s : 0.f;
        }
        __syncthreads();
        LAS double* invf = (LAS double*)(lds + 8 * 16384);
        if (tid < 152) { double inv; if (tid < 16) inv = pow(500000.0, -(double)tid / 16.0); else if (tid < 24) inv = pow(500000.0, -(double)(tid - 16) / 8.0); else inv = pow(10000.0, -(double)(tid - 24) / 128.0); invf[tid] = inv; }
        __syncthreads();
        const int gt = vcu * NTHREADS + tid, NGT = G * NTHREADS;
        f32x2* tabA = (f32x2*)(ws + WS_TABA); f32x2* tabI = (f32x2*)(ws + WS_TABI); f32x2* tabR = (f32x2*)(ws + WS_TABR);
        for (int i = gt; i < SEQ * 152; i += NGT) {
            const int p = i / 152, r = i % 152; f32x2* dst;
            if (r < 16) dst = tabA + p * 16 + r; else if (r < 24) dst = tabI + p * 8 + (r - 16); else dst = tabR + p * 128 + (r - 24);
            const double ang = (double)p * invf[r]; f32x2 cs; cs.x = (float)cos(ang); cs.y = (float)sin(ang); *dst = cs;
        }
    }
    SEAM(PH_PROLOGUE);
#ifdef GEMM_NAIVE
#define RUN_GEMM_REP(BIT, EPI, SWAPV, g, E) RUN_GEMM(EPI, SWAPV, g, E)
#define RUN_GEMM(EPI, SWAPV, g, E) do { pg8::StaticOrder S_; S_.init((g).M, (g).N, G, bx); pg8::gemm_naive<EPI, pg8::StaticOrder, SWAPV>(g, S_, E); } while (0)
#else
#define RUN_GEMM(EPI, SWAPV, g, E) do { pg8::StaticOrder S_; S_.init((g).M, (g).N, G, bx); pg8::gemm_phase<EPI, pg8::StaticOrder, true, true, SWAPV>(lds, g, S_, E); } while (0)
#define RUN_GEMM_REP(BIT, EPI, SWAPV, g, E) do { for (int rep_ = 0; rep_ < 1 + (int)((PROBE_MASK >> (BIT)) & 1u); ++rep_) RUN_GEMM(EPI, SWAPV, g, E); } while (0)
#endif

    TS(12);
    if (IN(PH_GEMM_A)) {
        pg8::Gemm g{(const bf16_t*)(ws + WS_XB), (const bf16_t*)(ws + WS_WA), T, A_PAD, D};
        EpiA E{ssq, a.pos, (const f32x2*)(ws + WS_TABA), (const f32x2*)(ws + WS_TABI), (bf16_t*)(ws + WS_Q), (bf16_t*)(ws + WS_K), (bf16_t*)(ws + WS_V), (bf16_t*)(ws + WS_QI), (bf16_t*)(ws + WS_KI), (float*)(ws + WS_WI), false};
        RUN_GEMM_REP(5, EpiA, false, g, E);
    }
    TS(4);
    SEAM(PH_GEMM_A);
    if (IN(PH_DSA)) for (int rep_ = 0; rep_ < 1 + (int)((PROBE_MASK >> 1) & 1u); ++rep_) dsa_phase(lds, (const bf16_t*)(ws + WS_Q), (const bf16_t*)(ws + WS_K), (const bf16_t*)(ws + WS_V), (const bf16_t*)(ws + WS_QI), (const bf16_t*)(ws + WS_KI), (const float*)(ws + WS_WI), (bf16_t*)(ws + WS_O), vcu, G, tid, lane, wave, ws);
    SEAM(PH_DSA);
    TS(12);
    if (IN(PH_OUT_A)) {
        pg8::Gemm g{(const bf16_t*)(ws + WS_O), (const bf16_t*)(ws + WS_WOA), T, D, D};
        EpiResid E{(bf16_t*)(ws + WS_XB), ssq1, false, (const LAS float*)nullptr};
        RUN_GEMM(EpiResid, false, g, E);
    }
    TS(5);
    SEAM(PH_OUT_A);
    if (IN(PH_UP0)) {
        pg8::Gemm g{(const bf16_t*)(ws + WS_XB), (const bf16_t*)(ws + WS_WUP0), T, FF, D};
        EpiUp E{ssq, (bf16_t*)(ws + WS_HID0), false, ws};
        RUN_GEMM_REP(0, EpiUp, false, g, E);
    }
    SEAM(PH_UP0);
    if (IN(PH_DOWN0)) {
        pg8::Gemm g{(const bf16_t*)(ws + WS_HID0), (const bf16_t*)(ws + WS_WDN0), T, D, FF};
        LAS float* rtab = (LAS float*)(lds + RING_BYTES);
        { pg8::StaticOrder S0; S0.init(g.M, g.N, G, bx); Unit u0;
          for (int i = 0; i < 28 && S0.next(i, u0); ++i) if (tid < 256) { const float r_ = row_rstd(ssq1, u0.pm * 256 + tid); rtab[i * 256 + tid] = r_ * r_; }
          __syncthreads(); }
        EpiResid E{(bf16_t*)(ws + WS_XB), ssq, false, (const LAS float*)rtab};
        RUN_GEMM(EpiResid, false, g, E);
    }
    SEAM(PH_DOWN0);
    TS(12);
    if (IN(PH_GEMM_B)) {
        { pg8::Gemm g{(const bf16_t*)(ws + WS_XB), (const bf16_t*)(ws + WS_WB), T, 2048, D};
          EpiBqk E{ssq, a.pos, (const f32x2*)(ws + WS_TABR), (bf16_t*)(ws + WS_Q1), (bf16_t*)(ws + WS_K1), false};
          RUN_GEMM_REP(6, EpiBqk, false, g, E); }
        { pg8::Gemm g{(const bf16_t*)(ws + WS_XB), (const bf16_t*)(ws + WS_WB) + (size_t)2048 * D, T, 2048, D};
          EpiBv E{ssq, (bf16_t*)(ws + WS_VT), false};
          RUN_GEMM_REP(6, EpiBv, true, g, E); }
    }
    TS(6);
    SEAM(PH_GEMM_B);
    TS(12);
    if (IN(PH_R1)) {
        const bf16_t* q1 = (const bf16_t*)(ws + WS_Q1); bf16_t* k1 = (bf16_t*)(ws + WS_K1); bf16_t* inner = (bf16_t*)(ws + WS_INNER);
        const int hf = lane >> 5, l31 = lane & 31;
        constexpr int R1S = 528, R1K = 128 * R1S, R1RS = 2 * R1K;
        LAS float* rs2 = (LAS float*)(lds + R1RS);
        const int t5 = tid >> 5, s5 = tid & 31;
        const unsigned gq = (unsigned)((t5 * 1024 + s5 * 8) * 2);
        const unsigned lq = (unsigned)(t5 * R1S + s5 * 16);
        for (int u = vcu; u < 1024; u += G) {
            const int c = u & 31, bh = u >> 5, h = bh & 3, b = bh >> 2;
            const size_t row0 = (size_t)b * SEQ + (size_t)c * 128;
            const float l2g = log2f(1.0f - exp2f(-5.0f - (float)h));
            __syncthreads();
            { const bf16_t* qb = q1 + row0 * 1024 + h * 256; const bf16_t* kb = k1 + row0 * 1024 + h * 256; u32x4 rq[8], rk[8];
#pragma unroll
              for (int i = 0; i < 8; ++i) { rq[i] = ldu<u32x4>(qb + (size_t)(16 * i) * 1024, gq); rk[i] = ldu<u32x4>(kb + (size_t)(16 * i) * 1024, gq); }
              if (tid < 128) { const float r_ = row_rstd(ssq, (int)row0 + tid); rs2[tid] = r_ * r_; if (h == 0) ((float*)(ws + WS_RSN))[row0 + tid] = r_; }
#pragma unroll
              for (int i = 0; i < 8; ++i) { *(LAS u32x4*)(lds + i * 16 * R1S + lq) = rq[i]; *(LAS u32x4*)(lds + R1K + i * 16 * R1S + lq) = rk[i]; } }
            __syncthreads();
            for (int ti = wave; ti < 10; ti += 8) {
                int mt, nt; if (ti < 4) { mt = 0; nt = ti; } else if (ti < 7) { mt = 1; nt = ti - 3; } else if (ti < 9) { mt = 2; nt = ti - 5; } else { mt = 3; nt = 3; }
                f32x16 acc;
#pragma unroll
                for (int r = 0; r < 16; ++r) acc[r] = 0.f;
                const int n = 32 * nt + l31;
                const LAS unsigned char* ap = lds + R1K + (32 * mt + l31) * R1S + 16 * hf; const LAS unsigned char* bp = lds + n * R1S + 16 * hf;
#pragma unroll
                for (int sk = 0; sk < 16; ++sk) { const bf16x8 av = *(const LAS bf16x8*)(ap + 32 * sk); const bf16x8 bv = *(const LAS bf16x8*)(bp + 32 * sk); acc = MFMA32(av, bv, acc); }
                bf16_t* orow = inner + ((size_t)u * 128 + n) * 128;
#pragma unroll
                for (int rg = 0; rg < 4; ++rg) { const int m0 = 32 * mt + 8 * rg + 4 * hf; f32x4 vv;
#pragma unroll
                    for (int j = 0; j < 4; ++j) { const int m = m0 + j; vv[j] = (m <= n) ? acc[4 * rg + j] * exp2f(-(float)(m + 1) * l2g) * rs2[m] : 0.f; }
                    *(u32x2*)(orow + m0) = pk4(vv); }
            }
            { const int d = tid & 255, mh = tid >> 8; const LAS unsigned char* kcol = lds + R1K + (64 * mh) * R1S + d * 2; const LAS float* rsp = rs2 + 64 * mh;
              bf16_t* dst = k1 + (row0 + (d >> 1)) * 1024 + h * 256 + (d & 1) * 128 + 64 * mh;
#pragma unroll 2
              for (int i = 0; i < 8; ++i) { float f[8];
#pragma unroll
                  for (int j = 0; j < 8; ++j) { const int ml = 8 * i + j; f[j] = bf2f(*(const LAS bf16_t*)(kcol + ml * R1S)) * exp2f((float)(127 - (64 * mh + ml)) * l2g) * rsp[ml]; }
                  u32x4 pk; pk.x = pk2(f[0], f[1]); pk.y = pk2(f[2], f[3]); pk.z = pk2(f[4], f[5]); pk.w = pk2(f[6], f[7]);
                  *(u32x4*)(dst + 8 * i) = pk; } }
        }
    }
    TS(13);
    SEAM(PH_R1);
    TS(12);
    if (IN(PH_RET)) {
        const bf16_t* q1 = (const bf16_t*)(ws + WS_Q1); const bf16_t* kz = (const bf16_t*)(ws + WS_K1); const bf16_t* inner = (const bf16_t*)(ws + WS_INNER); const bf16_t* vT = (const bf16_t*)(ws + WS_VT);
        bf16_t* y = (bf16_t*)a.out; float* stats = (float*)(ws + WS_STATS);
        const int hf = lane >> 5, l31 = lane & 31, wn = wave >> 1, we = wave & 1;
        for (int rep_ = 0; rep_ < 1 + (int)((PROBE_MASK >> 2) & 1u); ++rep_)
        for (int u = vcu; u < 256; u += G) {
            const int bh = u >> 3, sl = u & 7, b = bh >> 2, h = bh & 3;
            const float l2g = log2f(1.0f - exp2f(-5.0f - (float)h)); const float gC = exp2f(128.0f * l2g);
            const float xi = exp2f((float)(32 * wn + l31 + 1) * l2g);
            f32x16 S0, S1;
#pragma unroll
            for (int r = 0; r < 16; ++r) { S0[r] = 0.f; S1[r] = 0.f; }
            __syncthreads();
            for (int i = tid; i < ST_BUF / 4; i += NTHREADS) ((LAS unsigned*)(lds + RET_ST))[i] = 0u;
            const int t5 = tid >> 5, s5 = tid & 31, t4 = tid >> 4, s4 = tid & 15;
            const unsigned gq = (unsigned)((t5 * 1024 + s5 * 8) * 2);
            const unsigned lq = (unsigned)(t5 * 512 + (((s5 & 16) | ((s5 & 15) ^ t5))) * 16);
            const unsigned lk = (unsigned)(t5 * 512 + (((s5 & 16) | ((s5 & 15) ^ ((2 * t5 + (s5 >> 4)) & 15)))) * 16);
            const unsigned gi = (unsigned)((t4 * 128 + s4 * 8) * 2);
            const unsigned li = (unsigned)(t4 * 256 + ((s4 ^ (t4 & 15))) * 16);
            const unsigned gv = (unsigned)((t4 * SEQ + s4 * 8) * 2);
            const bf16_t* qbase = q1 + (size_t)b * SEQ * 1024 + h * 256; const bf16_t* kbase = kz + (size_t)b * SEQ * 1024 + h * 256;
            const bf16_t* ibase = inner + (size_t)bh * 32 * 128 * 128; const bf16_t* vbase = vT + ((size_t)bh * 512 + 64 * sl) * SEQ;
            u32x4 rq[8], rk[8], ri[4], rv[2];
#define RET_LOAD_Y(c_) do { _Pragma("unroll") for (int i = 0; i < 4; ++i) ri[i] = ldu<u32x4>(ibase + ((size_t)(c_) * 128 + 32 * i) * 128, gi); \
                            _Pragma("unroll") for (int i = 0; i < 2; ++i) rv[i] = ldu<u32x4>(vbase + (size_t)(32 * i) * SEQ + (c_) * 128, gv); } while (0)
#define RET_LOAD_Q(c_) do { _Pragma("unroll") for (int i = 0; i < 8; ++i) rq[i] = ldu<u32x4>(qbase + ((size_t)(c_) * 128 + 16 * i) * 1024, gq); } while (0)
#define RET_LOAD_K(c_) do { _Pragma("unroll") for (int i = 0; i < 8; ++i) rk[i] = ldu<u32x4>(kbase + ((size_t)(c_) * 128 + 16 * i) * 1024, gq); } while (0)
            RET_LOAD_Y(0); RET_LOAD_Q(0);
            const int n = 32 * wn + l31, e = 32 * we + l31, dA = 64 * wn + l31;
            for (int c = 0; c < 32; ++c) {
                const size_t row0 = (size_t)b * SEQ + (size_t)c * 128;
#pragma unroll
                for (int i = 0; i < 4; ++i) *(LAS u32x4*)(lds + RET_YI + i * 8192 + li) = ri[i];
#pragma unroll
                for (int i = 0; i < 2; ++i) *(LAS u32x4*)(lds + RET_YV + i * 8192 + li) = rv[i];
#pragma unroll
                for (int i = 0; i < 8; ++i) *(LAS u32x4*)(lds + RET_X + i * 8192 + lq) = rq[i];
                __syncthreads();
                RET_LOAD_K(c);
                if (c + 1 < 32) RET_LOAD_Q(c + 1);
                bf16x8 vf[8];
#pragma unroll
                for (int ks = 0; ks < 8; ++ks) vf[ks] = *(const LAS bf16x8*)(lds + RET_YV + e * 256 + (((2 * ks + hf) ^ (e & 15))) * 16);
                f32x16 o;
#pragma unroll
                for (int r = 0; r < 16; ++r) o[r] = 0.f;
#pragma unroll
                for (int mt = 0; mt < 4; ++mt) if (mt <= wn) {
#pragma unroll
                    for (int s2 = 0; s2 < 2; ++s2) { const int ks = 2 * mt + s2; const bf16x8 bv = *(const LAS bf16x8*)(lds + RET_YI + n * 256 + (((2 * ks + hf) ^ (n & 15))) * 16); o = MFMA32(vf[ks], bv, o); } }
                const LAS unsigned char* stp = lds + RET_ST + e * ST_STRIDE + 16 * hf;
#pragma unroll
                for (int sk = 0; sk < 16; ++sk) { const int slot = 2 * sk + hf; const bf16x8 av = *(const LAS bf16x8*)(stp + 32 * sk);
                    const bf16x8 bv = *(const LAS bf16x8*)(lds + RET_X + n * 512 + (((slot & 16) | ((slot & 15) ^ (n & 15)))) * 16); o = MFMA32(av, bv, o); }
                const float xs = xi * ((const float*)(ws + WS_RSN))[row0 + n];
                float s1 = 0.f, s2q = 0.f;
#pragma unroll
                for (int r = 0; r < 16; ++r) { o[r] *= xs; s1 += o[r]; s2q += o[r] * o[r]; }
                s1 += __shfl_xor(s1, 32); s2q += __shfl_xor(s2q, 32);
                if (hf == 0) { f32x2 sv; sv.x = s1; sv.y = s2q; *(f32x2*)(stats + (((row0 + n) * 4 + h) * 16 + 2 * sl + we) * 2) = sv; }
                bf16_t* yp = y + (row0 + n) * 2048 + h * 512 + 64 * sl + 32 * we + 4 * hf;
#pragma unroll
                for (int rg = 0; rg < 4; ++rg) { f32x4 vv; vv.x = o[4 * rg]; vv.y = o[4 * rg + 1]; vv.z = o[4 * rg + 2]; vv.w = o[4 * rg + 3]; *(u32x2*)(yp + 8 * rg) = pk4(vv); }
                __syncthreads();
#pragma unroll
                for (int i = 0; i < 8; ++i) *(LAS u32x4*)(lds + RET_X + i * 8192 + lk) = rk[i];
                if (c + 1 < 32) RET_LOAD_Y(c + 1);
                __syncthreads();
#pragma unroll
                for (int ks = 0; ks < 8; ++ks) vf[ks] = *(const LAS bf16x8*)(lds + RET_YV + e * 256 + (((2 * ks + hf) ^ (e & 15))) * 16);
#pragma unroll
                for (int r = 0; r < 16; ++r) { S0[r] *= gC; S1[r] *= gC; }
#pragma unroll
                for (int sk = 0; sk < 8; ++sk) {
                    const int d0 = dA, d1 = dA + 32; const int sl0 = 16 * (d0 & 1) + 2 * sk + hf;
                    const bf16x8 a0 = *(const LAS bf16x8*)(lds + RET_X + (d0 >> 1) * 512 + (((sl0 & 16) | ((sl0 & 15) ^ (d0 & 15)))) * 16);
                    const bf16x8 a1 = *(const LAS bf16x8*)(lds + RET_X + (d1 >> 1) * 512 + (((sl0 & 16) | ((sl0 & 15) ^ (d1 & 15)))) * 16);
                    S0 = MFMA32(a0, vf[sk], S0); S1 = MFMA32(a1, vf[sk], S1); }
                LAS unsigned char* stw = lds + RET_ST + e * ST_STRIDE + (64 * wn + 4 * hf) * 2;
#pragma unroll
                for (int rg = 0; rg < 4; ++rg) { f32x4 v0, v1; v0.x = S0[4 * rg]; v0.y = S0[4 * rg + 1]; v0.z = S0[4 * rg + 2]; v0.w = S0[4 * rg + 3]; v1.x = S1[4 * rg]; v1.y = S1[4 * rg + 1]; v1.z = S1[4 * rg + 2]; v1.w = S1[4 * rg + 3];
                    *(LAS u32x2*)(stw + 16 * rg) = pk4(v0); *(LAS u32x2*)(stw + 64 + 16 * rg) = pk4(v1); }
                __syncthreads();
            }
#undef RET_LOAD_Y
#undef RET_LOAD_Q
#undef RET_LOAD_K
        }
    }
    TS(14);
    SEAM(PH_RET);
    TS(12);
    if (IN(PH_GATE)) {
        pg8::Gemm g{(const bf16_t*)(ws + WS_XB), (const bf16_t*)(ws + WS_WB) + (size_t)4096 * D, T, 2048, D};
        LAS f32x4* gtab = (LAS f32x4*)(lds + RING_BYTES);
        { pg8::StaticOrder S0; S0.init(g.M, g.N, G, bx); Unit u0; const float* stats = (const float*)(ws + WS_STATS);
          for (int i = 0; i < 7 && S0.next(i, u0); ++i) {
              if (tid < 256) { const int row = u0.pm * 256 + tid, hd = u0.pn >> 1;
                  const f32x4* sp = (const f32x4*)(stats + ((size_t)row * 4 + hd) * 32); float sum = 0.f, sq = 0.f;
#pragma unroll
                  for (int j = 0; j < 8; ++j) { const f32x4 sv = sp[j]; sum += sv.x + sv.z; sq += sv.y + sv.w; }
                  const float mu = sum * (1.0f / 512.0f); const float var = fmaxf(sq * (1.0f / 512.0f) - mu * mu, 0.f);
                  f32x4 tv; tv.x = row_rstd(ssq, row); tv.y = mu; tv.z = rsqrtf(var + EPS); tv.w = 0.f; gtab[i * 256 + tid] = tv; } }
          __syncthreads(); }
        EpiGate E{(const LAS f32x4*)gtab, (bf16_t*)a.out, false};
        RUN_GEMM(EpiGate, false, g, E);
    }
    TS(1);
    SEAM(PH_GATE);
    TS(12);
    if (IN(PH_OUT_B)) {
        pg8::Gemm g{(const bf16_t*)a.out, (const bf16_t*)(ws + WS_WOB), T, D, 2048};
        EpiResid E{(bf16_t*)(ws + WS_XB), ssq1, false, (const LAS float*)nullptr};
        RUN_GEMM(EpiResid, false, g, E);
    }
    TS(7);
    SEAM(PH_OUT_B);
    if (IN(PH_UP1)) {
        pg8::Gemm g{(const bf16_t*)(ws + WS_XB), (const bf16_t*)(ws + WS_WUP1), T, FF, D};
        EpiUp E{ssq, (bf16_t*)(ws + WS_HID1), false, ws};
        RUN_GEMM_REP(0, EpiUp, false, g, E);
    }
    SEAM(PH_UP1);
    TS(12);
    if (IN(PH_DOWN1)) {
        pg8::Gemm g{(const bf16_t*)(ws + WS_HID1), (const bf16_t*)(ws + WS_WDN1), T, D, FF};
        LAS float* rtab = (LAS float*)(lds + RING_BYTES);
        { pg8::StaticOrder S0; S0.init(g.M, g.N, G, bx); Unit u0;
          for (int i = 0; i < 28 && S0.next(i, u0); ++i) if (tid < 256) { const float r_ = row_rstd(ssq1, u0.pm * 256 + tid); rtab[i * 256 + tid] = r_ * r_; }
          __syncthreads(); }
        EpiResid E{(bf16_t*)(ws + WS_XB), ssq, false, (const LAS float*)rtab};
        RUN_GEMM(EpiResid, false, g, E);
    }
    TS(8);
    SEAM(PH_DOWN1);
    TS_EXPORT(ws, blockIdx.x == 0 && tid == 0);
    if (IN(PH_FINAL)) {
        int lane_f = lane; asm volatile("" : "+v"(lane_f));
        const int gw = vcu * NWAVES + wave, NGW = G * NWAVES; const bf16_t* xb = (const bf16_t*)(ws + WS_XB);
        for (int row = gw; row < T; row += NGW) {
            const float rs = row_rstd(ssq, row);
            const u32x2* xr = (const u32x2*)(xb + (size_t)row * D) + lane_f; f32x4* orow = (f32x4*)(a.out + (size_t)row * D) + lane_f; const f32x4* gr = (const f32x4*)a.final_norm_g + lane_f;
#pragma unroll
            for (int j = 0; j < 4; ++j) { const u32x2 xv = xr[64 * j]; f32x4 hv; hv.x = __uint_as_float(xv.x << 16); hv.y = __uint_as_float(xv.x & 0xffff0000u); hv.z = __uint_as_float(xv.y << 16); hv.w = __uint_as_float(xv.y & 0xffff0000u);
                orow[64 * j] = hv * rs * gr[64 * j]; }
        }
#ifdef TPROBE
        if (bx == 0 && tid == 0) { const unsigned long long tv_ = ((const unsigned long long*)(ws + WS_TPROBE))[TPROBE]; a.out[0] += (float)tv_ * (0.01f / 5.0f); }
#endif
    }
#undef IN
#undef SEAM
}

extern "C" void kernel_launch(void* const* d_in, const int* in_sizes, int n_in, void* d_out, int out_size, void* d_ws, size_t ws_size, hipStream_t stream) {
    static int grid = 0;
    if (grid == 0) {
        if (n_in != 12 || out_size != T * D || ws_size < WS_END) { fprintf(stderr, "kernel_launch: unexpected shapes (n_in %d out %d ws %zu)\n", n_in, out_size, ws_size); grid = -1; return; }
        int dev = 0, cus = 0;
        if (hipGetDevice(&dev) != hipSuccess || hipDeviceGetAttribute(&cus, hipDeviceAttributeMultiprocessorCount, dev) != hipSuccess) { grid = -1; return; }
        if (hipFuncSetAttribute((const void*)mk_fwd, hipFuncAttributeMaxDynamicSharedMemorySize, LDS_BYTES) != hipSuccess) { fprintf(stderr, "kernel_launch: hipFuncSetAttribute failed\n"); grid = -1; return; }
        int per_cu = 0;
        if (hipOccupancyMaxActiveBlocksPerMultiprocessor(&per_cu, (const void*)mk_fwd, NTHREADS, LDS_BYTES) != hipSuccess || per_cu < 1) { fprintf(stderr, "kernel_launch: occupancy query says %d workgroups per CU; nothing launched\n", per_cu); grid = -1; return; }
        (void)hipGetLastError();
        grid = cus;
    }
    if (grid < 0) return;
    unsigned char* ws = (unsigned char*)d_ws;
    Args a{};
    a.x = (const float*)d_in[0]; a.pos = (const int*)d_in[1]; a.norm_mix_g = (const float*)d_in[2]; a.norm_mlp_g = (const float*)d_in[3]; a.w_in_a = (const float*)d_in[4]; a.w_out_a = (const float*)d_in[5];
    a.w_in_b = (const float*)d_in[6]; a.ret_norm_g = (const float*)d_in[7]; a.w_out_b = (const float*)d_in[8]; a.w_mlp_up = (const float*)d_in[9]; a.w_mlp_down = (const float*)d_in[10]; a.final_norm_g = (const float*)d_in[11];
    a.out = (float*)d_out; a.ws = ws;
    if (hipMemsetAsync(ws + WS_CTL, 0, CTL_ZERO_BYTES, stream) != hipSuccess) { fprintf(stderr, "kernel_launch: memset failed\n"); return; }
    int li = 0;
    auto seg = [&](int lo, int hi) {
        a.ph_lo = lo; a.ph_hi = hi; a.li = li++;
        if (hi - lo > 1) { void* args[] = {&a}; hipError_t e = hipLaunchCooperativeKernel((const void*)mk_fwd, dim3(grid), dim3(NTHREADS), args, LDS_BYTES, stream);
            if (e != hipSuccess) fprintf(stderr, "cooperative launch failed: %s\n", hipGetErrorString(e)); }
        else hipLaunchKernelGGL(mk_fwd, dim3(grid), dim3(NTHREADS), LDS_BYTES, stream, a);
    };
#ifdef PROBE_PRE_PHASE
    seg(PROBE_PRE_PHASE, PROBE_PRE_PHASE + 1);
#endif
    seg(PH_PROLOGUE, PH_COUNT);
#ifdef PROBE_EXTRA_PHASE
    seg(PROBE_EXTRA_PHASE, PROBE_EXTRA_PHASE + 1);
#endif
}
```

```cpp
#include <hip/hip_runtime.h>
#include <hip/hip_cooperative_groups.h>
#include <cstdio>
#include <cstdint>
namespace cg = cooperative_groups;

#define LAS __attribute__((address_space(3)))
#define GAS __attribute__((address_space(1)))
typedef unsigned short bf16_t;
typedef short bf16x8 __attribute__((ext_vector_type(8)));
typedef float f32x4 __attribute__((ext_vector_type(4)));
typedef float f32x2 __attribute__((ext_vector_type(2)));
typedef unsigned u32x4 __attribute__((ext_vector_type(4)));
typedef unsigned u32x2 __attribute__((ext_vector_type(2)));

constexpr int NB = 8, SEQ = 4096, T = NB * SEQ, D = 1024, FF = 4096;
constexpr int A_IN = 1864, A_PAD = 2048, B_IN = 6144;
constexpr int TOPK = 256;
constexpr float EPS = 1e-6f;
constexpr float QSCALE = 0.08838834764831845f * 1.4426950408889634f;

constexpr size_t MiB = 1u << 20;
constexpr size_t WS_CTL = 0, CTL_ZERO_BYTES = 1 * MiB;
constexpr size_t WS_SSQ = 1 * MiB;
constexpr size_t WS_WI = 3 * MiB;
constexpr size_t WS_TABA = 4 * MiB;
constexpr size_t WS_TABI = 4 * MiB + 512 * 1024;
constexpr size_t WS_TABR = 5 * MiB;
constexpr size_t WS_STATS = 9 * MiB;
constexpr size_t WS_WA = 26 * MiB, WS_WOA = 30 * MiB, WS_WUP0 = 32 * MiB, WS_WDN0 = 40 * MiB, WS_WB = 48 * MiB, WS_WOB = 60 * MiB, WS_WUP1 = 64 * MiB, WS_WDN1 = 72 * MiB;
constexpr size_t WS_Q = 80 * MiB, WS_K = 144 * MiB, WS_V = 152 * MiB, WS_QI = 160 * MiB, WS_KI = 192 * MiB, WS_SEL = 196 * MiB, WS_O = 212 * MiB;
constexpr size_t WS_HID0 = 80 * MiB, WS_XB = 448 * MiB;
constexpr size_t WS_Q1 = 80 * MiB, WS_K1 = 144 * MiB, WS_VT = 208 * MiB, WS_INNER = 336 * MiB, WS_HID1 = 144 * MiB;
constexpr size_t WS_END = 512 * MiB;

__device__ __forceinline__ float bf2f(bf16_t v) { return __uint_as_float((unsigned)v << 16); }
__device__ __forceinline__ unsigned f2bf(float f) { unsigned u = __float_as_uint(f); return (u + 0x7fffu + ((u >> 16) & 1u)) >> 16; }
typedef __bf16 bf16x2_t __attribute__((ext_vector_type(2)));
__device__ __forceinline__ unsigned pk2(float lo, float hi) { const f32x2 v = {lo, hi}; const bf16x2_t b = __builtin_convertvector(v, bf16x2_t); return __builtin_bit_cast(unsigned, b); }
__device__ __forceinline__ u32x2 pk4(f32x4 v) { u32x2 r; r.x = pk2(v.x, v.y); r.y = pk2(v.z, v.w); return r; }
__device__ __forceinline__ float lane_xor16(float v) { const unsigned u = __float_as_uint(v); const auto r = __builtin_amdgcn_permlane16_swap(u, u, false, false);
    const unsigned ln = __builtin_amdgcn_mbcnt_hi(~0u, __builtin_amdgcn_mbcnt_lo(~0u, 0u)); return __uint_as_float((ln & 16u) ? r[0] : r[1]); }
__device__ __forceinline__ float lane_xor32(float v) { const unsigned u = __float_as_uint(v); const auto r = __builtin_amdgcn_permlane32_swap(u, u, false, false);
    const unsigned ln = __builtin_amdgcn_mbcnt_hi(~0u, __builtin_amdgcn_mbcnt_lo(~0u, 0u)); return __uint_as_float((ln & 32u) ? r[0] : r[1]); }
__device__ __forceinline__ float wave_sum(float v) {
#pragma unroll
    for (int o = 1; o < 64; o <<= 1) v += __shfl_xor(v, o);
    return v;
}
__device__ __forceinline__ float row_rstd(const float* ssq16, int row) {
    const f32x4* p = (const f32x4*)(ssq16 + (size_t)row * 16);
    const f32x4 a = p[0], b = p[1], c = p[2], d = p[3];
    const float s = (((a.x + a.y) + (a.z + a.w)) + ((b.x + b.y) + (b.z + b.w))) + (((c.x + c.y) + (c.z + c.w)) + ((d.x + d.y) + (d.z + d.w)));
    return rsqrtf(s * (1.0f / 1024.0f) + EPS);
}

constexpr size_t WS_TPROBE = 768 * 1024;
constexpr size_t WS_RSN = 25 * 1024 * 1024;
#ifdef TPROBE
#define TS_DECL unsigned long long tacc1 = 0; unsigned long long tlast = __builtin_amdgcn_s_memrealtime()
#define TS(k) do { const unsigned long long n_ = __builtin_amdgcn_s_memrealtime(); if ((k) == TPROBE) tacc1 += n_ - tlast; tlast = n_; } while (0)
#define TS_EXPORT(wsbase, cond) do { if ((cond) && tacc1) { unsigned long long* tw_ = (unsigned long long*)((wsbase) + WS_TPROBE); tw_[TPROBE] = tacc1; } } while (0)
#else
#define TS_DECL do {} while (0)
#define TS(k) do {} while (0)
#define TS_EXPORT(wsbase, cond) do {} while (0)
#endif

namespace pg8 {
#define PG8_LAS __attribute__((address_space(3)))
constexpr int BM = 256, BK = 64, HALF = 128, HTB = HALF * BK * 2, STAGE_BYTES = 8 * HTB, NXCD = 8, WGM = 8;
__host__ __device__ __forceinline__ int lds_byte(int r, int c) { const int st = (r >> 4) * 2 + (c >> 5), rr = r & 15, cc = c & 31, ob = rr * 64 + cc * 2; return st * 1024 + (ob ^ (((ob >> 9) & 1) << 5)); }
__host__ __device__ __forceinline__ void stage_rc(int b, int& R, int& C) { const int st = b / 1024, sb = b % 1024, swz = sb ^ (((sb >> 9) & 1) << 5); R = (st >> 1) * 16 + swz / 64; C = (st & 1) * 32 + (swz % 64) / 2; }
__host__ __device__ __forceinline__ int perm32(int rho) { const int n = rho >> 4, i = rho & 15; return 8 * (i >> 2) + 4 * n + (i & 3); }
struct Unit { int pm, pn, ord; };
struct Gemm { const bf16_t* A; const bf16_t* Bt; int M, N, K; };
struct StaticOrder {
    int nM, nN, nwg, G, c;
    __host__ __device__ __forceinline__ void init(int M, int N, int G_, int c_) { nM = M / BM; nN = N / BM; nwg = nM * nN; G = G_; c = c_; }
    __host__ __device__ __forceinline__ bool next(int i, Unit& u) const {
        const long L = (long)i * G + c; if (L >= nwg) return false;
        int wgid = (int)L; { const int q = nwg / NXCD, r = nwg % NXCD, xcd = wgid % NXCD, off = wgid / NXCD; wgid = (xcd < r ? xcd * (q + 1) : r * (q + 1) + (xcd - r) * q) + off; }
        const int nig = WGM * nN, gid = wgid / nig, fm = gid * WGM, gsz = (nM - fm) < WGM ? (nM - fm) : WGM;
        u.pm = fm + ((wgid % nig) % gsz); u.pn = (wgid % nig) / gsz;
        if (nM == 128) { const int x_ = u.pm >> 4, k_ = u.pm & 15; u.pm = 16 * (k_ >> 1) + 2 * x_ + (k_ & 1);
            u.pn = (u.pn + x_ * (nN >= 8 ? nN / 8 : 1)) % nN; }
        return true;
    }
    __device__ __forceinline__ void a_ready(const Unit&) const {}
    __device__ __forceinline__ void done(const Unit&) const {}
};

template <class Epi, class Sched, bool ALIGN_EPI, bool SP2, bool SWAP>
__device__ __forceinline__ void gemm_phase(PG8_LAS unsigned char* lds, const Gemm g, const Sched& S, const Epi& E) {
    const int tid = threadIdx.x, wid = __builtin_amdgcn_readfirstlane(tid >> 6), lane = tid & 63, wr = wid >> 2, wc = wid & 3, fr = lane & 15, fq = lane >> 4;
    const int K = g.K, nt = K / BK;
    const int koff = ((S.c & (NXCD - 1)) * nt) >> 3;
#define PG8_KT(t_) ((size_t)(((t_) + koff) & (nt - 1)) * kstep)
    unsigned voffA[2], voffB[2];
#pragma unroll
    for (int i = 0; i < 2; ++i) { int R, C; stage_rc(tid * 16 + i * 8192, R, C); const int Rb = Epi::PERM ? ((R & ~31) + perm32(R & 31)) : R;
        voffA[i] = (unsigned)(R * K + C) * 2u; voffB[i] = (unsigned)(Rb * K + C) * 2u; }
    const size_t kstep = (size_t)(BK * 2);
    const size_t hstep = (size_t)HALF * K * 2;
    const size_t tstep = 2 * hstep;
    const unsigned ldsw = (unsigned)wid * 1024u;
    const int aoff = lds_byte(wr * 64 + fr, fq * 8), boff = lds_byte(wc * 32 + fr, fq * 8);
#define PG8_SA(b, h) (((b) * 2 + (h)) * HTB)
#define PG8_SB(b, h) ((4 + (b) * 2 + (h)) * HTB)
#define PG8_STAGE(bufoff, gbase, voff) do { _Pragma("unroll") for (int _i = 0; _i < 2; ++_i) \
        __builtin_amdgcn_global_load_lds((const unsigned*)((const char*)(gbase) + (voff)[_i]), (PG8_LAS unsigned*)(lds + (bufoff) + ldsw + _i * 8192), 16, 0, 0); } while (0)
#define PG8_LDA(dst, b, h) do { _Pragma("unroll") for (int m = 0; m < 4; ++m) _Pragma("unroll") for (int k = 0; k < 2; ++k) dst[m][k] = *(const PG8_LAS bf16x8*)(lds + PG8_SA(b, h) + aoff + m * 2048 + k * 1024); } while (0)
#define PG8_LDB(dst, b, h) do { _Pragma("unroll") for (int n = 0; n < 2; ++n) _Pragma("unroll") for (int k = 0; k < 2; ++k) dst[n][k] = *(const PG8_LAS bf16x8*)(lds + PG8_SB(b, h) + boff + n * 2048 + k * 1024); } while (0)
#define PG8_MMA(ai, bj, At, Bt) do { __builtin_amdgcn_s_setprio(1); _Pragma("unroll") for (int m = 0; m < 4; ++m) _Pragma("unroll") for (int n = 0; n < 2; ++n) _Pragma("unroll") for (int k = 0; k < 2; ++k) { \
        if constexpr (SWAP) acc[ai][bj][m][n] = __builtin_amdgcn_mfma_f32_16x16x32_bf16(At[m][k], Bt[n][k], acc[ai][bj][m][n], 0, 0, 0); \
        else acc[ai][bj][m][n] = __builtin_amdgcn_mfma_f32_16x16x32_bf16(Bt[n][k], At[m][k], acc[ai][bj][m][n], 0, 0, 0); } __builtin_amdgcn_s_setprio(0); } while (0)
#define PG8_WAIT_V(n) asm volatile("s_waitcnt vmcnt(" #n ")" ::: "memory")
#define PG8_WAIT_L(n) asm volatile("s_waitcnt lgkmcnt(" #n ")" ::: "memory")
#define PG8_BAR __builtin_amdgcn_s_barrier()
#define PG8_SCHED __builtin_amdgcn_sched_barrier(0)
    Unit cur, nxt; int ui = 0;
    if (!S.next(0, cur)) return;
    cur.ord = 0;
    TS_DECL;
    f32x4 acc[2][2][4][2];
#pragma unroll
    for (int a = 0; a < 2; ++a)
#pragma unroll
        for (int b = 0; b < 2; ++b)
#pragma unroll
            for (int m = 0; m < 4; ++m)
#pragma unroll
                for (int n = 0; n < 2; ++n) acc[a][b][m][n] = (f32x4){0.f, 0.f, 0.f, 0.f};
    bf16x8 At[4][2], B0[2][2], B1[2][2];
    const char* cA = (const char*)g.A + (size_t)cur.pm * tstep; const char* cB = (const char*)g.Bt + (size_t)cur.pn * tstep;
    S.a_ready(cur);
    if constexpr (SP2) {
        PG8_STAGE(PG8_SB(0, 0), cB + PG8_KT(0), voffB); PG8_STAGE(PG8_SB(0, 1), cB + PG8_KT(0) + hstep, voffB); PG8_STAGE(PG8_SA(0, 0), cA + PG8_KT(0), voffA); PG8_STAGE(PG8_SA(0, 1), cA + PG8_KT(0) + hstep, voffA);
        if (wr == 1) PG8_BAR;
        PG8_WAIT_V(2); PG8_BAR;
        PG8_STAGE(PG8_SB(1, 0), cB + PG8_KT(1), voffB); PG8_STAGE(PG8_SA(1, 0), cA + PG8_KT(1), voffA); PG8_STAGE(PG8_SB(1, 1), cB + hstep + PG8_KT(1), voffB);
        PG8_WAIT_V(6); PG8_BAR;
    } else {
        PG8_STAGE(PG8_SB(0, 0), cB, voffB); PG8_STAGE(PG8_SA(0, 0), cA, voffA); PG8_STAGE(PG8_SB(0, 1), cB + hstep, voffB); PG8_STAGE(PG8_SA(0, 1), cA + hstep, voffA);
        if (wr == 1) PG8_BAR;
        PG8_WAIT_V(4); PG8_BAR;
        PG8_STAGE(PG8_SB(1, 0), cB + kstep, voffB); PG8_STAGE(PG8_SA(1, 0), cA + kstep, voffA); PG8_STAGE(PG8_SB(1, 1), cB + hstep + kstep, voffB);
        PG8_WAIT_V(6); PG8_BAR;
    }
    for (;;) {
        const bool has_next = S.next(ui + 1, nxt); nxt.ord = ui + 1;
        const char* nA = has_next ? (const char*)g.A + (size_t)nxt.pm * tstep : cA; const char* nB = has_next ? (const char*)g.Bt + (size_t)nxt.pn * tstep : cB;
        for (int t = 0; t < nt; t += 2) {
            const bool last = (t == nt - 2);
            const char* a1 = cA + PG8_KT(t + 1);
            const char* a2 = last ? nA + PG8_KT(0) : cA + PG8_KT(t + 2); const char* b2 = last ? nB + PG8_KT(0) : cB + PG8_KT(t + 2);
            const char* a3 = last ? nA + PG8_KT(1) : cA + PG8_KT(t + 3); const char* b3 = last ? nB + PG8_KT(1) : cB + PG8_KT(t + 3);
            if (last && has_next) S.a_ready(nxt);
            if constexpr (SP2) {
            PG8_LDB(B0, 0, 0); PG8_LDB(B1, 0, 1); PG8_SCHED; PG8_LDA(At, 0, 0); PG8_STAGE(PG8_SA(1, 1), a1 + hstep, voffA);
            PG8_WAIT_V(8); PG8_WAIT_L(0); PG8_BAR; PG8_MMA(0, 0, At, B0); PG8_MMA(0, 1, At, B1); PG8_BAR; PG8_SCHED;
            PG8_LDA(At, 0, 1); PG8_STAGE(PG8_SB(0, 0), b2, voffB); PG8_STAGE(PG8_SB(0, 1), b2 + hstep, voffB); PG8_STAGE(PG8_SA(0, 0), a2, voffA);
            PG8_WAIT_V(8); PG8_WAIT_L(0); PG8_BAR; PG8_MMA(1, 0, At, B0); PG8_MMA(1, 1, At, B1); PG8_BAR; PG8_SCHED;
            PG8_LDB(B0, 1, 0); PG8_LDB(B1, 1, 1); PG8_SCHED; PG8_LDA(At, 1, 0); PG8_STAGE(PG8_SA(0, 1), a2 + hstep, voffA);
            PG8_WAIT_V(8); PG8_WAIT_L(0); PG8_BAR; PG8_MMA(0, 0, At, B0); PG8_MMA(0, 1, At, B1); PG8_BAR; PG8_SCHED;
            PG8_LDA(At, 1, 1); PG8_STAGE(PG8_SB(1, 0), b3, voffB); PG8_STAGE(PG8_SB(1, 1), b3 + hstep, voffB); PG8_STAGE(PG8_SA(1, 0), a3, voffA);
            PG8_WAIT_V(8); PG8_WAIT_L(0); PG8_BAR; PG8_MMA(1, 0, At, B0); PG8_MMA(1, 1, At, B1); PG8_BAR; PG8_SCHED;
            } else {
            PG8_LDB(B0, 0, 0); PG8_SCHED; PG8_LDA(At, 0, 0); PG8_STAGE(PG8_SA(1, 1), a1 + hstep, voffA);
            PG8_WAIT_L(8); PG8_BAR; PG8_WAIT_L(0); PG8_MMA(0, 0, At, B0); PG8_BAR; PG8_SCHED;
            PG8_LDB(B1, 0, 1); PG8_STAGE(PG8_SB(0, 0), b2, voffB);
            PG8_BAR; PG8_WAIT_L(0); PG8_MMA(0, 1, At, B1); PG8_BAR;
            PG8_LDA(At, 0, 1); PG8_STAGE(PG8_SA(0, 0), a2, voffA);
            PG8_BAR; PG8_WAIT_L(0); PG8_MMA(1, 0, At, B0); PG8_BAR; PG8_SCHED;
            PG8_STAGE(PG8_SB(0, 1), b2 + hstep, voffB);
            PG8_WAIT_V(6); PG8_BAR; PG8_MMA(1, 1, At, B1); PG8_BAR;
            PG8_LDB(B0, 1, 0); PG8_SCHED; PG8_LDA(At, 1, 0); PG8_STAGE(PG8_SA(0, 1), a2 + hstep, voffA);
            PG8_WAIT_L(8); PG8_BAR; PG8_WAIT_L(0); PG8_MMA(0, 0, At, B0); PG8_BAR; PG8_SCHED;
            PG8_LDB(B1, 1, 1); PG8_STAGE(PG8_SB(1, 0), b3, voffB);
            PG8_BAR; PG8_WAIT_L(0); PG8_MMA(0, 1, At, B1); PG8_BAR;
            PG8_LDA(At, 1, 1); PG8_STAGE(PG8_SA(1, 0), a3, voffA);
            PG8_BAR; PG8_WAIT_L(0); PG8_MMA(1, 0, At, B0); PG8_BAR; PG8_SCHED;
            PG8_STAGE(PG8_SB(1, 1), b3 + hstep, voffB);
            PG8_WAIT_V(6); PG8_BAR; PG8_MMA(1, 1, At, B1); PG8_BAR;
            }
        }
        if constexpr (ALIGN_EPI) { if (wr == 0) PG8_BAR; }
        if constexpr (Epi::TIMED) { TS(10); }
        E(acc, cur, wr, wc, fr, fq); S.done(cur);
        if constexpr (Epi::TIMED) { TS(11); }
        if (!has_next) break;
#pragma unroll
        for (int a = 0; a < 2; ++a)
#pragma unroll
            for (int b = 0; b < 2; ++b)
#pragma unroll
                for (int m = 0; m < 4; ++m)
#pragma unroll
                    for (int n = 0; n < 2; ++n) acc[a][b][m][n] = (f32x4){0.f, 0.f, 0.f, 0.f};
        cur = nxt; cA = nA; cB = nB; ++ui;
        if constexpr (ALIGN_EPI) { if (wr == 1) PG8_BAR; }
    }
    PG8_WAIT_V(0);
    if constexpr (!ALIGN_EPI) { if (wr == 0) PG8_BAR; }
    PG8_BAR;
    if constexpr (Epi::TIMED) { TS(12); TS_EXPORT(E.wsb, blockIdx.x == 0 && tid == 0); }
#undef PG8_KT
#undef PG8_SA
#undef PG8_SB
#undef PG8_STAGE
#undef PG8_LDA
#undef PG8_LDB
#undef PG8_MMA
#undef PG8_WAIT_V
#undef PG8_WAIT_L
#undef PG8_BAR
#undef PG8_SCHED
}

template <class Epi, class Sched, bool SWAP>
__device__ __forceinline__ void gemm_naive(const Gemm g, const Sched& S, const Epi& E) {
    const int tid = threadIdx.x, wid = tid >> 6, lane = tid & 63, wr = wid >> 2, wc = wid & 3, fr = lane & 15, fq = lane >> 4;
    Unit u;
    for (int i = 0; S.next(i, u); ++i) {
        f32x4 acc[2][2][4][2];
#pragma unroll 1
        for (int ai = 0; ai < 2; ++ai)
#pragma unroll 1
            for (int bj = 0; bj < 2; ++bj)
#pragma unroll 1
                for (int m = 0; m < 4; ++m)
#pragma unroll 1
                    for (int n = 0; n < 2; ++n) {
                        f32x4 r;
#pragma unroll 1
                        for (int e = 0; e < 4; ++e) {
                            int row, col;
                            if (SWAP) { row = u.pm * 256 + ai * 128 + wr * 64 + m * 16 + 4 * fq + e; col = u.pn * 256 + bj * 128 + wc * 32 + n * 16 + fr; }
                            else { row = u.pm * 256 + ai * 128 + wr * 64 + m * 16 + fr; col = u.pn * 256 + bj * 128 + wc * 32 + n * 16 + 4 * fq + e; }
                            const bf16x8* a = (const bf16x8*)(g.A + (size_t)row * g.K); const bf16x8* b = (const bf16x8*)(g.Bt + (size_t)col * g.K);
                            float s = 0.f;
                            for (int k = 0; k < g.K / 8; ++k) { const bf16x8 av = a[k], bv = b[k];
#pragma unroll
                                for (int j = 0; j < 8; ++j) s += bf2f((bf16_t)av[j]) * bf2f((bf16_t)bv[j]); }
                            r[e] = s;
                        }
#pragma unroll
                        for (int a2 = 0; a2 < 2; ++a2)
#pragma unroll
                            for (int b2 = 0; b2 < 2; ++b2)
#pragma unroll
                                for (int m2 = 0; m2 < 4; ++m2)
#pragma unroll
                                    for (int n2 = 0; n2 < 2; ++n2) if (a2 == ai && b2 == bj && m2 == m && n2 == n) acc[a2][b2][m2][n2] = r;
                    }
        E(acc, u, wr, wc, fr, fq);
    }
}
}
using pg8::Unit;

__device__ __forceinline__ void store_strip16(bf16_t* row32, const f32x4& a0, const f32x4& a1, int fq) {
    u32x2 p0 = pk4(a0), p1 = pk4(a1);
    const auto rx = __builtin_amdgcn_permlane16_swap(p0.x, p1.x, false, false);
    const auto ry = __builtin_amdgcn_permlane16_swap(p0.y, p1.y, false, false);
    u32x4 w; w.x = rx[0]; w.y = ry[0]; w.z = rx[1]; w.w = ry[1];
    *(u32x4*)(row32 + 16 * (fq & 1) + 8 * (fq >> 1)) = w;
}
__device__ __forceinline__ void store_strip16_nt(bf16_t* row32, const f32x4& a0, const f32x4& a1, int fq) {
    u32x2 p0 = pk4(a0), p1 = pk4(a1);
    const auto rx = __builtin_amdgcn_permlane16_swap(p0.x, p1.x, false, false);
    const auto ry = __builtin_amdgcn_permlane16_swap(p0.y, p1.y, false, false);
    u32x4 w; w.x = rx[0]; w.y = ry[0]; w.z = rx[1]; w.w = ry[1];
    __builtin_nontemporal_store(w, (u32x4*)(row32 + 16 * (fq & 1) + 8 * (fq >> 1)));
}
__device__ __forceinline__ void store_pair32(bf16_t* row16, const f32x4& ga, const f32x4& gb, int hf) {
    u32x2 p0 = pk4(ga), p1 = pk4(gb);
    const auto rx = __builtin_amdgcn_permlane32_swap(p0.x, p1.x, false, false);
    const auto ry = __builtin_amdgcn_permlane32_swap(p0.y, p1.y, false, false);
    u32x4 w; w.x = rx[0]; w.y = ry[0]; w.z = rx[1]; w.w = ry[1];
    *(u32x4*)(row16 + 8 * hf) = w;
}
struct EpiA {
    static constexpr bool PERM = false, TIMED = false;
    const LAS f32x2* rptab; const f32x2* tabA; const f32x2* tabI;
    bf16_t *q, *k, *v, *qi, *ki; float* wi; bool dry;
    __device__ __forceinline__ void operator()(const f32x4 (&acc)[2][2][4][2], const Unit& u, int wr, int wc, int fr, int fq) const {
        const int rl0 = wr * 64 + fr, row0 = u.pm * 256 + rl0; const int pn = u.pn;
        const bool rotA = (pn <= 4) && wc == 0, rotI = (pn >= 5) && ((pn < 7) ? ((wc & 1) == 0) : (wc == 0));
#pragma unroll
        for (int ai = 0; ai < 2; ++ai) {
            f32x2 rp[4]; f32x4 cs4[4][2];
#pragma unroll
            for (int m = 0; m < 4; ++m) rp[m] = rptab[u.ord * 256 + rl0 + ai * 128 + m * 16];
            if (rotA) {
#pragma unroll
                for (int m = 0; m < 4; ++m) { const f32x4* tb = (const f32x4*)(tabA + __float_as_int(rp[m].y) * 16 + 4 * fq); cs4[m][0] = tb[0]; cs4[m][1] = tb[1]; }
            } else if (rotI) {
#pragma unroll
                for (int m = 0; m < 4; ++m) { const f32x4* tb = (const f32x4*)(tabI + __float_as_int(rp[m].y) * 8 + 4 * (fq & 1)); cs4[m][0] = tb[0]; cs4[m][1] = tb[1]; }
            } else {
#pragma unroll
                for (int m = 0; m < 4; ++m) { cs4[m][0] = (f32x4){1.f, 0.f, 1.f, 0.f}; cs4[m][1] = (f32x4){1.f, 0.f, 1.f, 0.f}; }
            }
#define CSX(m_, e_) (cs4[m_][(e_) >> 1][2 * ((e_) & 1)])
#define CSY(m_, e_) (cs4[m_][(e_) >> 1][2 * ((e_) & 1) + 1])
#pragma unroll
            for (int m = 0; m < 4; ++m) {
                const int row = row0 + ai * 128 + m * 16;
                const float rs = rp[m].x;
                if (pn < 4) {
#pragma unroll
                    for (int bj = 0; bj < 2; ++bj) {
                        f32x4 a0 = acc[ai][bj][m][0] * rs, a1 = acc[ai][bj][m][1] * rs;
                        if (wc == 0) {
#pragma unroll
                            for (int e = 0; e < 4; ++e) { const float cx = CSX(m, e), cy = CSY(m, e); const float x1 = a0[e], x2 = a1[e]; a0[e] = x1 * cx - x2 * cy; a1[e] = x2 * cx + x1 * cy; } }
                        a0 = a0 * QSCALE; a1 = a1 * QSCALE;
                        if (!dry) store_strip16(q + (size_t)row * 1024 + pn * 256 + bj * 128 + wc * 32, a0, a1, fq);
                    }
                } else if (pn == 4) {
                    { f32x4 a0 = acc[ai][0][m][0] * rs, a1 = acc[ai][0][m][1] * rs;
                      if (wc == 0) {
#pragma unroll
                          for (int e = 0; e < 4; ++e) { const float cx = CSX(m, e), cy = CSY(m, e); const float x1 = a0[e], x2 = a1[e]; a0[e] = x1 * cx - x2 * cy; a1[e] = x2 * cx + x1 * cy; } }
                      if (!dry) store_strip16(k + (size_t)row * 128 + wc * 32, a0, a1, fq); }
                    { const f32x4 a0 = acc[ai][1][m][0] * rs, a1 = acc[ai][1][m][1] * rs;
                      if (!dry) store_strip16(v + (size_t)row * 128 + wc * 32, a0, a1, fq); }
                } else if (pn < 7) {
#pragma unroll
                    for (int bj = 0; bj < 2; ++bj) {
                        f32x4 a0 = acc[ai][bj][m][0] * rs; const f32x4 a1 = acc[ai][bj][m][1] * rs;
                        if ((wc & 1) == 0) {
#pragma unroll
                            for (int e = 0; e < 4; ++e) { const float other = __shfl_xor(a0[e], 32); const float cx = CSX(m, e), cy = CSY(m, e); a0[e] = (fq < 2) ? (a0[e] * cx - other * cy) : (a0[e] * cx + other * cy); } }
                        if (!dry) store_strip16(qi + (size_t)row * 512 + (pn - 5) * 256 + bj * 128 + wc * 32, a0, a1, fq);
                    }
                } else {
                    if (wc < 2) {
                        f32x4 a0 = acc[ai][0][m][0] * rs; const f32x4 a1 = acc[ai][0][m][1] * rs;
                        if (wc == 0) {
#pragma unroll
                            for (int e = 0; e < 4; ++e) { const float other = __shfl_xor(a0[e], 32); const float cx = CSX(m, e), cy = CSY(m, e); a0[e] = (fq < 2) ? (a0[e] * cx - other * cy) : (a0[e] * cx + other * cy); } }
                        if (!dry) store_strip16(ki + (size_t)row * 64 + wc * 32, a0, a1, fq);
                    } else if (wc == 2) {
                        if (fq < 2) { const f32x4 a0 = acc[ai][0][m][0] * (rs * 0.04419417382415922f); if (!dry) *(f32x4*)(wi + (size_t)row * 8 + 4 * fq) = a0; }
                    }
                }
            }
#undef CSX
#undef CSY
        }
    }
};

struct EpiUp {
#ifdef TPROBE
    static constexpr bool PERM = true, TIMED = true;
#else
    static constexpr bool PERM = true, TIMED = false;
#endif
    const float* ssq; bf16_t* hid; bool dry; unsigned char* wsb;
    __device__ __forceinline__ void operator()(const f32x4 (&acc)[2][2][4][2], const Unit& u, int wr, int wc, int fr, int fq) const {
        const int row0 = u.pm * 256 + wr * 64 + fr, col0 = u.pn * 256 + wc * 32 + 8 * fq;
#pragma unroll
        for (int ai = 0; ai < 2; ++ai)
#pragma unroll
            for (int m = 0; m < 4; ++m) {
                const int row = row0 + ai * 128 + m * 16;
                bf16_t* rowp = hid + (size_t)row * FF + col0;
#pragma unroll
                for (int bj = 0; bj < 2; ++bj) { f32x4 a0 = acc[ai][bj][m][0], a1 = acc[ai][bj][m][1];
#pragma unroll
                    for (int e = 0; e < 4; ++e) { const float r0 = fmaxf(a0[e], 0.f), r1 = fmaxf(a1[e], 0.f); a0[e] = r0 * r0; a1[e] = r1 * r1; }
                    u32x4 w; w.x = pk2(a0[0], a0[1]); w.y = pk2(a0[2], a0[3]); w.z = pk2(a1[0], a1[1]); w.w = pk2(a1[2], a1[3]);
                    __builtin_nontemporal_store(w, (u32x4*)(rowp + bj * 128)); }
            }
    }
};

struct EpiResid {
    static constexpr bool PERM = true, TIMED = false;
    bf16_t* xb; float* ssq; bool dry; const LAS float* rs2tab;
    __device__ __forceinline__ void operator()(const f32x4 (&acc)[2][2][4][2], const Unit& u, int wr, int wc, int fr, int fq) const {
        const int rl0 = wr * 64 + fr, row0 = u.pm * 256 + rl0, col0 = u.pn * 256 + wc * 32 + 8 * fq;
#pragma unroll
        for (int ai = 0; ai < 2; ++ai) {
            u32x4 xv[4][2];
#pragma unroll
            for (int m = 0; m < 4; ++m)
#pragma unroll
                for (int bj = 0; bj < 2; ++bj) xv[m][bj] = *(const u32x4*)(xb + (size_t)(row0 + ai * 128 + m * 16) * D + col0 + bj * 128);
#pragma unroll
            for (int m = 0; m < 4; ++m) {
                const int row = row0 + ai * 128 + m * 16; float s = 0.f; const float sc2 = rs2tab ? rs2tab[u.ord * 256 + rl0 + ai * 128 + m * 16] : 1.f;
#pragma unroll
                for (int bj = 0; bj < 2; ++bj) { const size_t off = (size_t)row * D + col0 + bj * 128;
                    const u32x4 xq = xv[m][bj]; f32x4 h0, h1;
                    h0.x = __uint_as_float(xq.x << 16); h0.y = __uint_as_float(xq.x & 0xffff0000u); h0.z = __uint_as_float(xq.y << 16); h0.w = __uint_as_float(xq.y & 0xffff0000u);
                    h1.x = __uint_as_float(xq.z << 16); h1.y = __uint_as_float(xq.z & 0xffff0000u); h1.z = __uint_as_float(xq.w << 16); h1.w = __uint_as_float(xq.w & 0xffff0000u);
                    h0 = h0 + acc[ai][bj][m][0] * sc2; h1 = h1 + acc[ai][bj][m][1] * sc2;
                    u32x4 w; w.x = pk2(h0[0], h0[1]); w.y = pk2(h0[2], h0[3]); w.z = pk2(h1[0], h1[1]); w.w = pk2(h1[2], h1[3]);
                    *(u32x4*)(xb + off) = w;
                    s += ((h0.x * h0.x + h0.y * h0.y) + (h0.z * h0.z + h0.w * h0.w)) + ((h1.x * h1.x + h1.y * h1.y) + (h1.z * h1.z + h1.w * h1.w)); }
                s += lane_xor16(s); s += lane_xor32(s);
                if (fq == 0) ssq[(size_t)row * 16 + u.pn * 4 + wc] = s;
            }
        }
    }
};

struct EpiBqk {
    static constexpr bool PERM = true, TIMED = false;
    const LAS f32x2* rptab; const f32x2* tabR; bf16_t *q1, *k1; bool dry;
    __device__ __forceinline__ void operator()(const f32x4 (&acc)[2][2][4][2], const Unit& u, int wr, int wc, int fr, int fq) const {
        const int rl0 = wr * 64 + fr, row0 = u.pm * 256 + rl0; const bool isk = u.pn >= 4; bf16_t* dstb = isk ? k1 : q1; const float sc = isk ? 0.0625f : 1.0f; const int hd = u.pn & 3;
#pragma unroll
        for (int ai = 0; ai < 2; ++ai) {
            f32x4 cs4[4][4];
#pragma unroll
            for (int m = 0; m < 4; ++m) { const int p = __float_as_int(rptab[u.ord * 256 + rl0 + ai * 128 + m * 16].y); const f32x4* tb = (const f32x4*)(tabR + p * 128 + wc * 32 + 8 * fq);
#pragma unroll
                for (int i = 0; i < 4; ++i) cs4[m][i] = tb[i]; }
#pragma unroll
            for (int m = 0; m < 4; ++m) {
                const int row = row0 + ai * 128 + m * 16; const float rs = sc;
                float x1[8], x2[8];
#pragma unroll
                for (int e = 0; e < 4; ++e) { x1[e] = acc[ai][0][m][0][e] * rs; x1[4 + e] = acc[ai][0][m][1][e] * rs; x2[e] = acc[ai][1][m][0][e] * rs; x2[4 + e] = acc[ai][1][m][1][e] * rs; }
#pragma unroll
                for (int e = 0; e < 8; ++e) { const float cx = cs4[m][e >> 1][2 * (e & 1)], cy = cs4[m][e >> 1][2 * (e & 1) + 1]; const float a = x1[e], b = x2[e]; x1[e] = a * cx - b * cy; x2[e] = b * cx + a * cy; }
                bf16_t* dst = dstb + (size_t)row * 1024 + hd * 256 + wc * 32 + 8 * fq;
                u32x4 w1, w2; w1.x = pk2(x1[0], x1[1]); w1.y = pk2(x1[2], x1[3]); w1.z = pk2(x1[4], x1[5]); w1.w = pk2(x1[6], x1[7]); w2.x = pk2(x2[0], x2[1]); w2.y = pk2(x2[2], x2[3]); w2.z = pk2(x2[4], x2[5]); w2.w = pk2(x2[6], x2[7]);
                *(u32x4*)dst = w1; *(u32x4*)(dst + 128) = w2;
            }
        }
    }
};
struct EpiBv {
    static constexpr bool PERM = false, TIMED = false;
    const float* ssq; bf16_t* vT; bool dry;
    __device__ __forceinline__ void operator()(const f32x4 (&acc)[2][2][4][2], const Unit& u, int wr, int wc, int fr, int fq) const {
        const int b = u.pm >> 4;
#pragma unroll
        for (int ai = 0; ai < 2; ++ai)
#pragma unroll
            for (int mp = 0; mp < 2; ++mp) {
                const int t32 = (u.pm * 256 + wr * 64 + ai * 128 + mp * 32) & (SEQ - 1);
#pragma unroll
                for (int bj = 0; bj < 2; ++bj)
#pragma unroll
                    for (int n = 0; n < 2; ++n) { const int c = u.pn * 256 + bj * 128 + wc * 32 + n * 16 + fr;
                        if (!dry) store_strip16_nt(vT + ((size_t)(b * 4 + (c >> 9)) * 512 + (c & 511)) * SEQ + t32, acc[ai][bj][2 * mp][n], acc[ai][bj][2 * mp + 1][n], fq); }
            }
    }
};
struct EpiGate {
    static constexpr bool PERM = true, TIMED = false;
    const LAS f32x4* tab; bf16_t* y; bool dry;
    __device__ __forceinline__ void operator()(const f32x4 (&acc)[2][2][4][2], const Unit& u, int wr, int wc, int fr, int fq) const {
        const int rl0 = wr * 64 + fr, row0 = u.pm * 256 + rl0, col0 = u.pn * 256 + wc * 32 + 8 * fq;
#pragma unroll
        for (int ai = 0; ai < 2; ++ai) {
            u32x4 yv[1][4][2];
#pragma unroll
            for (int m = 0; m < 4; ++m)
#pragma unroll
                for (int bj = 0; bj < 2; ++bj) yv[0][m][bj] = *(const u32x4*)(y + (size_t)(row0 + ai * 128 + m * 16) * 2048 + col0 + bj * 128);
#pragma unroll
            for (int m = 0; m < 4; ++m) {
                const f32x4 tv = tab[u.ord * 256 + rl0 + ai * 128 + m * 16]; const float rs = tv.x, rh = tv.z, nmr = tv.w;
                bf16_t* rowp = y + (size_t)(row0 + ai * 128 + m * 16) * 2048 + col0;
#pragma unroll
                for (int bj = 0; bj < 2; ++bj) { const u32x4 yq = yv[0][m][bj]; float yf[8], g[8], o[8];
                    yf[0] = __uint_as_float(yq.x << 16); yf[1] = __uint_as_float(yq.x & 0xffff0000u); yf[2] = __uint_as_float(yq.y << 16); yf[3] = __uint_as_float(yq.y & 0xffff0000u);
                    yf[4] = __uint_as_float(yq.z << 16); yf[5] = __uint_as_float(yq.z & 0xffff0000u); yf[6] = __uint_as_float(yq.w << 16); yf[7] = __uint_as_float(yq.w & 0xffff0000u);
#pragma unroll
                    for (int e = 0; e < 4; ++e) { g[e] = acc[ai][bj][m][0][e] * rs; g[4 + e] = acc[ai][bj][m][1][e] * rs; }
#pragma unroll
                    for (int e = 0; e < 8; ++e) { const float sg = g[e] * __builtin_amdgcn_rcpf(1.0f + __builtin_amdgcn_exp2f(-1.4426950408889634f * g[e])); o[e] = sg * fmaf(yf[e], rh, nmr); }
                    u32x4 w; w.x = pk2(o[0], o[1]); w.y = pk2(o[2], o[3]); w.z = pk2(o[4], o[5]); w.w = pk2(o[6], o[7]);
                    *(u32x4*)(rowp + bj * 128) = w; }
            }
        }
    }
};

#ifndef PROBE_MASK
#define PROBE_MASK 0u
#endif
constexpr int NWAVES = 8, NTHREADS = NWAVES * 64;
constexpr int RING_BYTES = 131072, LDS_BYTES = 163840, LDSCTL_OFF = LDS_BYTES - 1024, MISC_OFF = LDSCTL_OFF + 320;

struct Args {
    const float* x; const int* pos; const float* norm_mix_g; const float* norm_mlp_g; const float* w_in_a; const float* w_out_a; const float* w_in_b; const float* ret_norm_g;
    const float* w_out_b; const float* w_mlp_up; const float* w_mlp_down; const float* final_norm_g;
    float* out; unsigned char* ws; int ph_lo, ph_hi, li, pad;
};

#define XB_TMO      128
#define XB_XCNT(j)  (256  + 64 * (j))
#define XB_XSUB(j)  (1280 + 64 * (j))
#define XB_XGEN(j)  (2304 + 64 * (j))
#define XB_TOP      3328
#define XB_TOPGEN   3392
#define XCD_BAR_WORDS 3456
#define XB_SPIN_CAP (1u << 22)
constexpr int CW_BAR = 4096;
__device__ __forceinline__ unsigned xb_ld(unsigned* p)              { return __hip_atomic_load(p, __ATOMIC_RELAXED, __HIP_MEMORY_SCOPE_AGENT); }
__device__ __forceinline__ unsigned xb_add(unsigned* p, unsigned v) { return __hip_atomic_fetch_add(p, v, __ATOMIC_RELAXED, __HIP_MEMORY_SCOPE_AGENT); }
__device__ __forceinline__ unsigned xb_xcc_id() { return (unsigned)__builtin_amdgcn_s_getreg((3 << 11) | 20) & 0xFu; }
#define XB_SPIN(cond, bar) do { unsigned _sp = 0; while (cond) { __builtin_amdgcn_s_sleep(1); \
    if ((++_sp & 255u) == 0u) { if (xb_ld(&(bar)[XB_TMO])) break; if (_sp > XB_SPIN_CAP) { atomicAdd(&(bar)[XB_TMO], 1u); break; } } } } while (0)
struct XcdBarrier { unsigned* bar; unsigned x; volatile LAS unsigned* st; };
__device__ __forceinline__ XcdBarrier xcd_barrier_post(unsigned* bar, volatile LAS unsigned* st) {
    XcdBarrier b; b.bar = bar; b.x = xb_xcc_id(); b.st = st;
    if (threadIdx.x == 0) (void)xb_add(&bar[XB_XCNT(b.x)], 1u);
    return b;
}
__device__ __forceinline__ void xcd_barrier_complete(unsigned* bar, unsigned x, unsigned& nloc, unsigned& nx) {
    const unsigned G = gridDim.x * gridDim.y * gridDim.z;
    unsigned sum, cnt, mine, sp = 0u;
    for (;;) {
        sum = 0u; cnt = 0u; mine = 0u;
#pragma unroll
        for (unsigned j = 0; j < 16; ++j) { const unsigned c = xb_ld(&bar[XB_XCNT(j)]); sum += c; cnt += (c > 0u) ? 1u : 0u; mine = (j == x) ? c : mine; }
        if (sum == G) break;
        __builtin_amdgcn_s_sleep(1);
        if ((++sp & 255u) == 0u) { if (xb_ld(&bar[XB_TMO])) break; if (sp > XB_SPIN_CAP) { atomicAdd(&bar[XB_TMO], 1u); break; } }
    }
    nloc = mine > 0u ? mine : 1u; nx = cnt > 0u ? cnt : 1u;
}
__device__ __forceinline__ void xcd_barrier(const XcdBarrier& b) {
    asm volatile("s_waitcnt vmcnt(0)" ::: "memory");
    __syncthreads();
    if (threadIdx.x == 0) {
        unsigned* bar = b.bar;
        __builtin_amdgcn_s_waitcnt(0);
        unsigned nloc = b.st[0], nx = b.st[1];
        if (nloc == 0u) { xcd_barrier_complete(bar, b.x, nloc, nx); b.st[0] = nloc; b.st[1] = nx; }
        const unsigned old = xb_add(&bar[XB_XSUB(b.x)], 1u);
        const unsigned gen = old / nloc;
        if (old + 1u == (gen + 1u) * nloc) {
            __builtin_amdgcn_fence(__ATOMIC_RELEASE, "agent");
            asm volatile("s_waitcnt vmcnt(0)" ::: "memory");
            const unsigned og = xb_add(&bar[XB_TOP], 1u);
            const unsigned tg = og / nx;
            if (og + 1u == (tg + 1u) * nx) xb_add(&bar[XB_TOPGEN], 1u);
            else XB_SPIN(xb_ld(&bar[XB_TOPGEN]) == tg, bar);
            __builtin_amdgcn_fence(__ATOMIC_ACQUIRE, "agent");
            xb_add(&bar[XB_XGEN(b.x)], 1u);
            asm volatile("s_waitcnt vmcnt(0)" ::: "memory");
        } else {
            XB_SPIN(xb_ld(&bar[XB_XGEN(b.x)]) == gen, bar);
            __builtin_amdgcn_fence(__ATOMIC_ACQUIRE, "agent");
            asm volatile("s_waitcnt vmcnt(0)" ::: "memory");
        }
    }
    __syncthreads();
}

typedef float f32x16 __attribute__((ext_vector_type(16)));
#define MFMA32(a, b, c) __builtin_amdgcn_mfma_f32_32x32x16_bf16((a), (b), (c), 0, 0, 0)
constexpr int ST_STRIDE = 528, ST_BUF = 64 * ST_STRIDE;
constexpr int RET_X = 0, RET_YV = 65536, RET_YI = 65536 + 16384, RET_ST = 114688;

enum Phase { PH_PROLOGUE = 0, PH_GEMM_A, PH_DSA, PH_OUT_A, PH_UP0, PH_DOWN0, PH_GEMM_B, PH_R1, PH_RET, PH_GATE, PH_OUT_B, PH_UP1, PH_DOWN1, PH_FINAL, PH_COUNT };

__device__ __forceinline__ void transpose_item(const float* W, const float* gain, int K, int N, int Npad, bf16_t* WT, LAS float* scr, int item, int lane) {
    const int nblk = Npad / 32, kb = item / nblk, nb = item % nblk, k0 = 64 * kb, n0 = 32 * nb;
    const int nn = n0 + (lane & 31);
    float tv[32];
#pragma unroll
    for (int i = 0; i < 32; ++i) { const int kk = 2 * i + (lane >> 5); tv[i] = (nn < N) ? __builtin_nontemporal_load(W + (size_t)(k0 + kk) * N + nn) : 0.f; }
#pragma unroll
    for (int i = 0; i < 32; ++i) { const int kk = 2 * i + (lane >> 5); float v = tv[i]; if (gain) v *= gain[k0 + kk]; scr[kk * 33 + (lane & 31)] = v; }
    asm volatile("s_waitcnt lgkmcnt(0)" ::: "memory");
    const int c = lane & 7;
#pragma unroll
    for (int j = 0; j < 4; ++j) { const int n = (lane >> 3) + 8 * j; const LAS float* s = scr + (8 * c) * 33 + n;
        u32x4 o; o.x = pk2(s[0 * 33], s[1 * 33]); o.y = pk2(s[2 * 33], s[3 * 33]); o.z = pk2(s[4 * 33], s[5 * 33]); o.w = pk2(s[6 * 33], s[7 * 33]);
        *(u32x4*)(WT + (size_t)(n0 + n) * K + k0 + 8 * c) = o; }
    asm volatile("s_waitcnt lgkmcnt(0)" ::: "memory");
}


typedef short v4i16_t __attribute__((ext_vector_type(4)));
constexpr int DSA_SEL_OFF = RING_BYTES + 1024, DSA_RED_OFF = DSA_SEL_OFF + 4096, DSA_TOT_OFF = DSA_RED_OFF + 512, DSA_RES_OFF = DSA_TOT_OFF + 256;
static_assert(DSA_RES_OFF + 128 <= LDS_BYTES, "DSA LDS map");
__device__ __forceinline__ unsigned okey(float f) { const unsigned u = __float_as_uint(f); return u ^ ((unsigned)((int)u >> 31) | 0x80000000u); }
#define MFMA16(a, b, c) __builtin_amdgcn_mfma_f32_16x16x32_bf16((a), (b), (c), 0, 0, 0)

__device__ __forceinline__ unsigned wave_incl_scan(unsigned v) {
    v += (unsigned)__builtin_amdgcn_update_dpp(0, (int)v, 0x111, 0xf, 0xf, false);
    v += (unsigned)__builtin_amdgcn_update_dpp(0, (int)v, 0x112, 0xf, 0xf, false);
    v += (unsigned)__builtin_amdgcn_update_dpp(0, (int)v, 0x114, 0xf, 0xf, false);
    v += (unsigned)__builtin_amdgcn_update_dpp(0, (int)v, 0x118, 0xf, 0xf, false);
    v += (unsigned)__builtin_amdgcn_update_dpp(0, (int)v, 0x142, 0xa, 0xf, false);
    v += (unsigned)__builtin_amdgcn_update_dpp(0, (int)v, 0x143, 0xc, 0xf, false);
    return v;
}
__device__ __forceinline__ unsigned wave_min_u32(unsigned v) {
    v = min(v, (unsigned)__builtin_amdgcn_update_dpp(-1, (int)v, 0x111, 0xf, 0xf, false));
    v = min(v, (unsigned)__builtin_amdgcn_update_dpp(-1, (int)v, 0x112, 0xf, 0xf, false));
    v = min(v, (unsigned)__builtin_amdgcn_update_dpp(-1, (int)v, 0x114, 0xf, 0xf, false));
    v = min(v, (unsigned)__builtin_amdgcn_update_dpp(-1, (int)v, 0x118, 0xf, 0xf, false));
    v = min(v, (unsigned)__builtin_amdgcn_update_dpp(-1, (int)v, 0x142, 0xa, 0xf, false));
    v = min(v, (unsigned)__builtin_amdgcn_update_dpp(-1, (int)v, 0x143, 0xc, 0xf, false));
    return (unsigned)__builtin_amdgcn_readlane((int)v, 63);
}
template <class Tv> __device__ __forceinline__ Tv ldu(const void* ubase, unsigned voff) { return *(const Tv*)((const char*)ubase + voff); }

__device__ __forceinline__ void dsa_phase(LAS unsigned char* lds, const bf16_t* __restrict__ q, const bf16_t* __restrict__ k, const bf16_t* __restrict__ v, const bf16_t* __restrict__ qi, const bf16_t* __restrict__ ki,
                                          const float* __restrict__ wi, bf16_t* __restrict__ o, int vcu, int G, int tid_, int lane_, int wave, unsigned char* wsb) {
    TS_DECL;
    LAS unsigned short* selbuf = (LAS unsigned short*)(lds + DSA_SEL_OFF);
    LAS unsigned* keysL = (LAS unsigned*)lds;
    const int npu = 2048;
    const bool even = (npu % G) == 0; const int per = even ? npu / G : 0;
    if (wave >= 4) __builtin_amdgcn_s_setprio(1);
    for (int it = 0;; ++it) {
        int pu; if (even) { if (it >= per) break; pu = vcu * per + it; } else { pu = it * G + vcu; if (pu >= npu) break; }
        const int b = pu >> 8, pr = pu & 255;
#pragma unroll 1
        for (int which = 0; which < 2; ++which) {
            int lane = lane_; asm volatile("" : "+v"(lane));
            const int hf = lane >> 5, l31 = lane & 31, fr = lane & 15, fq = lane >> 4;
            LAS unsigned char* wbuf = lds + wave * 16384;
            LAS unsigned short* sel = selbuf + wave * 320;
            const int g = which ? 511 - pr : pr; const int t0 = 8 * g; const size_t tok0 = (size_t)b * SEQ + t0;
            const int t = t0 + wave;
            TS(7);
            if (t0 + 7 < TOPK) {
                __syncthreads();
                TS(8);
#pragma unroll
                for (int i = 0; i < 4; ++i) { const int p = lane + 64 * i; sel[p] = (unsigned short)((p <= t) ? p : 0xFFFF); }
            } else {
                const int nkt = ((t0 + 7) >> 5) + 1;
                const unsigned kvoff = (unsigned)(l31 * 128 + 16 * hf);
                const bf16_t* qib = qi + tok0 * 512; const float* wib = wi + tok0 * 8;
                bf16x8 af[2][4]; f32x4 wlo[2][2], whi[2][2];
#pragma unroll
                for (int rt = 0; rt < 2; ++rt) {
                    const int qla = 4 * rt + 2 * ((l31 >> 2) & 1) + (l31 >> 4), hd = (l31 & 3) + 4 * ((l31 >> 3) & 1);
                    const unsigned aoff = (unsigned)((qla * 512 + hd * 64 + 8 * hf) * 2);
#pragma unroll
                    for (int sk = 0; sk < 4; ++sk) af[rt][sk] = ldu<bf16x8>(qib, aoff + 32 * sk);
#pragma unroll
                    for (int j = 0; j < 2; ++j) { const unsigned woff = (unsigned)((4 * rt + 2 * hf + j) * 32); wlo[rt][j] = ldu<f32x4>(wib, woff); whi[rt][j] = ldu<f32x4>(wib, woff + 16); }
                }
                LAS unsigned* kq0 = keysL + (2 * hf) * 4096 + l31; LAS unsigned* kq2 = keysL + (4 + 2 * hf) * 4096 + l31;
                bf16x8 bfr[3][4];
#define B_LOAD(i_) do { int kt_ = wave + 8 * (i_); kt_ = kt_ < nkt ? kt_ : nkt - 1;     \
        const bf16_t* bpu = ki + ((size_t)b * SEQ + 32 * kt_) * 64; \
        _Pragma("unroll") for (int sk = 0; sk < 4; ++sk) bfr[(i_) % 3][sk] = ldu<bf16x8>(bpu, kvoff + 32 * sk); } while (0)
                B_LOAD(0); B_LOAD(1);
                asm volatile("s_waitcnt lgkmcnt(0)" ::: "memory"); __builtin_amdgcn_s_barrier(); asm volatile("" ::: "memory");
                TS(8);
#pragma unroll
                for (int rt = 0; rt < 2; ++rt)
#pragma unroll
                    for (int j = 0; j < 2; ++j) { wlo[rt][j] = wlo[rt][j] * 0.5f; whi[rt][j] = whi[rt][j] * 0.5f; }
#pragma unroll
                for (int i = 0; i < 16; ++i) {
                    const int kt = wave + 8 * i;
                    if (kt < nkt) {
                        if (i + 2 < 16) B_LOAD(i + 2);
                        const int kidx = 32 * kt + l31;
#pragma unroll
                        for (int rt = 0; rt < 2; ++rt) {
                            f32x16 acc;
#pragma unroll
                            for (int r = 0; r < 16; ++r) acc[r] = 0.f;
#pragma unroll
                            for (int sk = 0; sk < 4; ++sk) acc = MFMA32(af[rt][sk], bfr[i % 3][sk], acc);
#pragma unroll
                            for (int j = 0; j < 2; ++j) {
                                float sa = 0.f, sb = 0.f;
#pragma unroll
                                for (int h = 0; h < 4; ++h) { sa = fmaf(acc[8 * j + h], wlo[rt][j][h], sa); sb = fmaf(__builtin_fabsf(acc[8 * j + h]), wlo[rt][j][h], sb); }
#pragma unroll
                                for (int h = 0; h < 4; ++h) { sa = fmaf(acc[8 * j + 4 + h], whi[rt][j][h], sa); sb = fmaf(__builtin_fabsf(acc[8 * j + 4 + h]), whi[rt][j][h], sb); }
                                const float sc = (sa + sb) + 0.0f;
                                const int tq = t0 + 4 * rt + 2 * hf + j;
                                const unsigned kv = (kidx <= tq) ? okey(sc) : 0u;
                                (rt ? kq2 : kq0)[j * 4096 + 32 * kt] = kv;
                            }
                        }
                    }
                }
#undef B_LOAD
                TS(0);
                __syncthreads();
                TS(9);
                const int nj = (nkt + 1) >> 1;
                unsigned key[64];
#pragma unroll
                for (int j = 0; j < 64; ++j) key[j] = 0u;
#pragma unroll
                for (int c = 0; c < 16; ++c) if (4 * c < nj) {
#pragma unroll
                    for (int j = 4 * c; j < 4 * c + 4; ++j) { const int kidx = lane + 64 * j; const unsigned kv_ = keysL[wave * 4096 + kidx]; key[j] = (kidx < 32 * nkt) ? kv_ : 0u; } }
                TS(1);
                LAS unsigned* hist = (LAS unsigned*)wbuf;
                unsigned thr = 0u, need = (unsigned)TOPK, bincnt = 0u;
#define RADIX_PASS(SHIFT, BITS, FIRST) do { \
        _Pragma("unroll") for (int i_ = 0; i_ < 8; ++i_) ((LAS u32x4*)hist)[lane + 64 * i_] = (u32x4){0u, 0u, 0u, 0u}; \
        _Pragma("unroll") for (int c_ = 0; c_ < 16; ++c_) if (4 * c_ < nj) _Pragma("unroll") for (int j = 4 * c_; j < 4 * c_ + 4; ++j) { const unsigned k_ = key[j]; \
            const unsigned m_ = (FIRST) ? ((k_ != 0u) ? 1u : 0u) : ((((k_ >> ((SHIFT) + (BITS) - 1)) >> 1) == thr) ? 1u : 0u); \
            if (m_) __hip_atomic_fetch_add(hist + ((k_ >> (SHIFT)) & ((1u << (BITS)) - 1u)), 1u, __ATOMIC_RELAXED, __HIP_MEMORY_SCOPE_WORKGROUP); } \
        {   \
          const int lb_ = 2016 - 32 * lane; unsigned s_ = 0u; \
          _Pragma("unroll") for (int j_ = 0; j_ < 8; ++j_) { const u32x4 h4 = *(const LAS u32x4*)(hist + lb_ + 4 * j_); s_ += (h4.x + h4.y) + (h4.z + h4.w); } \
          const unsigned x_ = wave_incl_scan(s_); const unsigned T_ = x_ - s_; \
          const unsigned long long bm_ = __ballot(T_ < need && x_ >= need); \
          const int Ls_ = (int)__builtin_ctzll(bm_ | 0x8000000000000000ull); \
          const unsigned Ts_ = (unsigned)__builtin_amdgcn_readlane((int)T_, Ls_); \
          const int bb_ = 2016 - 32 * Ls_;                           \
          const unsigned hv_ = (lane < 32) ? hist[bb_ + 31 - lane] : 0u; \
          const unsigned x2_ = wave_incl_scan(hv_); const unsigned T2_ = Ts_ + x2_ - hv_; \
          const unsigned long long bm2_ = __ballot(lane < 32 && T2_ < need && T2_ + hv_ >= need); \
          const int js_ = (int)__builtin_ctzll(bm2_ | 0x8000000000000000ull); \
          thr = (thr << (BITS)) | (unsigned)(bb_ + 31 - js_); need = need - (unsigned)__builtin_amdgcn_readlane((int)T2_, js_); bincnt = (unsigned)__builtin_amdgcn_readlane((int)hv_, js_); } \
    } while (0)
                RADIX_PASS(21, 11, true);
                RADIX_PASS(10, 11, false);
                if (bincnt == need) {
                    const unsigned lo_ = thr << 10; unsigned mn_ = 0xFFFFFFFFu;
#pragma unroll
                    for (int c = 0; c < 16; ++c) if (4 * c < nj) {
#pragma unroll
                        for (int j = 4 * c; j < 4 * c + 4; ++j) mn_ = min(mn_, key[j] - lo_); }
                    thr = lo_ + wave_min_u32(mn_);
                } else {
                    RADIX_PASS(0, 10, false);
                }
#undef RADIX_PASS
                TS(2);
                if (bincnt == need) {
                    unsigned mlo = 0u, mhi = 0u;
#define GE_BIT(m_, k_) asm("v_cmp_le_u32 vcc, %2, %1\n\tv_addc_co_u32 %0, vcc, %0, %0, vcc" : "+v"(m_) : "v"(k_), "s"(thr) : "vcc")
#pragma unroll
                    for (int c = 0; c < 8; ++c) if (4 * c < nj) { GE_BIT(mlo, key[4 * c]); GE_BIT(mlo, key[4 * c + 1]); GE_BIT(mlo, key[4 * c + 2]); GE_BIT(mlo, key[4 * c + 3]); }
#pragma unroll
                    for (int c = 8; c < 16; ++c) if (4 * c < nj) { GE_BIT(mhi, key[4 * c]); GE_BIT(mhi, key[4 * c + 1]); GE_BIT(mhi, key[4 * c + 2]); GE_BIT(mhi, key[4 * c + 3]); }
#undef GE_BIT
                    const unsigned cge = (unsigned)(__builtin_popcount(mlo) + __builtin_popcount(mhi));
                    const int nj4 = (nj + 3) & ~3, nlo = nj4 < 32 ? nj4 : 32, nhi = nj4 - nlo;
                    LAS unsigned short* sp = sel + ((wave_incl_scan(cge) - cge) & 255u);
                    unsigned ib = (unsigned)(lane + 64 * (nlo - 1));
                    while (mlo) { const unsigned b_ = (unsigned)__builtin_ctz(mlo); mlo &= mlo - 1u; *sp++ = (unsigned short)(ib - 64u * b_); }
                    ib = (unsigned)(lane + 64 * (31 + nhi));
                    while (mhi) { const unsigned b_ = (unsigned)__builtin_ctz(mhi); mhi &= mhi - 1u; *sp++ = (unsigned short)(ib - 64u * b_); }
                } else {
                    unsigned base = 0u, eqbase = 0u;
#pragma unroll
                    for (int j = 0; j < 64; ++j) if (j < nj) {
                        const unsigned k_ = key[j]; const bool gt = k_ > thr, eq = k_ == thr;
                        const unsigned long long beq = __ballot(eq);
                        const unsigned eqr = eqbase + __builtin_amdgcn_mbcnt_hi((unsigned)(beq >> 32), __builtin_amdgcn_mbcnt_lo((unsigned)beq, 0u));
                        const bool take = gt || (eq && eqr < need);
                        const unsigned long long bt = __ballot(take);
                        const unsigned pos = base + __builtin_amdgcn_mbcnt_hi((unsigned)(bt >> 32), __builtin_amdgcn_mbcnt_lo((unsigned)bt, 0u));
                        if (take) sel[pos & 255u] = (unsigned short)(lane + 64 * j);
                        base += (unsigned)__builtin_popcountll(bt); eqbase += (unsigned)__builtin_popcountll(beq);
                    }
                }
            }
            TS(3);
            {
                const size_t tok = tok0 + wave;
                const bf16_t* qb = q + tok * 1024; const bf16_t* kb = k + (size_t)b * SEQ * 128; const bf16_t* vb = v + (size_t)b * SEQ * 128;
                bf16x8 qf[4];
                { const unsigned qoff = (unsigned)(((fr & 7) * 128 + 8 * fq) * 2);
#pragma unroll
                  for (int sk = 0; sk < 4; ++sk) qf[sk] = ldu<bf16x8>(qb, qoff + 64 * sk); }
#define K_DMA(kt_) do { unsigned ixs_[4]; _Pragma("unroll") for (int i = 0; i < 4; ++i) ixs_[i] = sel[16 * (kt_) + fq + 4 * i]; __builtin_amdgcn_sched_barrier(0);     \
        _Pragma("unroll") for (int i = 0; i < 4; ++i) { const int rr = fq + 4 * i; unsigned ix = ixs_[i]; ix = (ix == 0xFFFFu) ? 0u : ix; \
        __builtin_amdgcn_global_load_lds((const unsigned*)((const char*)kb + (ix * 256u + 16u * (unsigned)(fr ^ rr))), (LAS unsigned*)(wbuf + ((kt_) & 3) * 4096 + i * 1024), 16, 0, 0); } } while (0)
                f32x4 lg[16];
                asm volatile("s_waitcnt vmcnt(0)" :: "v"(qf[0]), "v"(qf[1]), "v"(qf[2]), "v"(qf[3]) : "memory");
                K_DMA(0); K_DMA(1); K_DMA(2);
#pragma unroll
                for (int kt = 0; kt < 16; ++kt) {
                    asm volatile("s_waitcnt lgkmcnt(0)" ::: "memory"); __builtin_amdgcn_sched_barrier(0);
                    if (kt + 3 < 16) K_DMA(kt + 3);
                    if (kt + 3 < 16) asm volatile("s_waitcnt vmcnt(12)" ::: "memory"); else if (kt + 2 < 16) asm volatile("s_waitcnt vmcnt(8)" ::: "memory");
                    else if (kt + 1 < 16) asm volatile("s_waitcnt vmcnt(4)" ::: "memory"); else asm volatile("s_waitcnt vmcnt(0)" ::: "memory");
                    __builtin_amdgcn_sched_barrier(0);
                    const LAS unsigned char* kbase = wbuf + (kt & 3) * 4096 + fr * 256;
                    f32x4 acc = (f32x4){0.f, 0.f, 0.f, 0.f};
#pragma unroll
                    for (int sk = 0; sk < 4; ++sk) { const bf16x8 ka = *(const LAS bf16x8*)(kbase + 16 * ((4 * sk + fq) ^ fr)); acc = MFMA16(ka, qf[sk], acc); }
#pragma unroll
                    for (int r = 0; r < 4; ++r) lg[kt][r] = acc[r];
                }
                if (t < TOPK - 1) {
#pragma unroll
                    for (int kt = 0; kt < 16; ++kt)
#pragma unroll
                        for (int r = 0; r < 4; ++r) { const int p = 16 * kt + 4 * fq + r; if (p > t) lg[kt][r] = -INFINITY; }
                }
#undef K_DMA
                TS(4);
#define V_DMA(u) do { unsigned ixs_[8]; _Pragma("unroll") for (int i = 0; i < 8; ++i) ixs_[i] = sel[32 * (u) + fq + 4 * i]; __builtin_amdgcn_sched_barrier(0); \
        _Pragma("unroll") for (int i = 0; i < 8; ++i) { const int rr = fq + 4 * i; unsigned ix = ixs_[i]; ix = (ix == 0xFFFFu) ? 0u : ix; \
        __builtin_amdgcn_global_load_lds((const unsigned*)((const char*)vb + (ix * 256u + 16u * (unsigned)(fr ^ ((rr & 7) << 1)))), (LAS unsigned*)(wbuf + ((u) & 1) * 8192 + i * 1024), 16, 0, 0); } } while (0)
                asm volatile("s_waitcnt lgkmcnt(0)" ::: "memory");
                V_DMA(0); V_DMA(1);
                float mx = -INFINITY;
#pragma unroll
                for (int kt = 0; kt < 16; ++kt) mx = fmaxf(fmaxf(mx, fmaxf(lg[kt][0], lg[kt][1])), fmaxf(lg[kt][2], lg[kt][3]));
                mx = fmaxf(mx, lane_xor16(mx)); mx = fmaxf(mx, lane_xor32(mx));
                float sm = 0.f;
#pragma unroll
                for (int kt = 0; kt < 16; ++kt)
#pragma unroll
                    for (int r = 0; r < 4; ++r) { const float e = __builtin_amdgcn_exp2f(lg[kt][r] - mx); lg[kt][r] = e; sm += e; }
                sm += lane_xor16(sm); sm += lane_xor32(sm);
                bf16x8 pb[8];
#pragma unroll
                for (int u = 0; u < 8; ++u) { u32x4 w; w.x = pk2(lg[2 * u][0], lg[2 * u][1]); w.y = pk2(lg[2 * u][2], lg[2 * u][3]); w.z = pk2(lg[2 * u + 1][0], lg[2 * u + 1][1]); w.w = pk2(lg[2 * u + 1][2], lg[2 * u + 1][3]);
                    pb[u] = __builtin_bit_cast(bf16x8, w); }
                f32x4 oacc[8];
#pragma unroll
                for (int dt = 0; dt < 8; ++dt) oacc[dt] = (f32x4){0.f, 0.f, 0.f, 0.f};
                TS(5);
                const int qq = fr >> 2, pp = fr & 3;
#pragma unroll
                for (int u = 0; u < 8; ++u) {
                    if (u + 1 < 8) asm volatile("s_waitcnt vmcnt(8)" ::: "memory"); else asm volatile("s_waitcnt vmcnt(0)" ::: "memory");
                    __builtin_amdgcn_sched_barrier(0);
                    const LAS unsigned char* vbase = wbuf + (u & 1) * 8192;
                    const int rA = 4 * fq + qq, rB = 16 + 4 * fq + qq;
                    bf16x8 va[8];
#pragma unroll
                    for (int dt = 0; dt < 8; ++dt) {
                        const int ch = 2 * dt + (pp >> 1);
                        const v4i16_t alo = __builtin_amdgcn_ds_read_tr16_b64_v4i16((LAS v4i16_t*)(vbase + rA * 256 + 16 * (ch ^ ((rA & 7) << 1)) + 8 * (pp & 1)));
                        const v4i16_t ahi = __builtin_amdgcn_ds_read_tr16_b64_v4i16((LAS v4i16_t*)(vbase + rB * 256 + 16 * (ch ^ ((rB & 7) << 1)) + 8 * (pp & 1)));
                        va[dt][0] = alo[0]; va[dt][1] = alo[1]; va[dt][2] = alo[2]; va[dt][3] = alo[3]; va[dt][4] = ahi[0]; va[dt][5] = ahi[1]; va[dt][6] = ahi[2]; va[dt][7] = ahi[3];
                    }
                    if (u + 2 < 8) { asm volatile("s_waitcnt lgkmcnt(0)" ::: "memory"); __builtin_amdgcn_sched_barrier(0); V_DMA(u + 2); }
#pragma unroll
                    for (int dt = 0; dt < 8; ++dt) oacc[dt] = MFMA16(va[dt], pb[u], oacc[dt]);
                }
#undef V_DMA
                TS(6);
                const float inv = 1.0f / sm;
                { bf16_t* op = o + tok * 1024 + (fr & 7) * 128 + 16 * (fq & 1) + 8 * (fq >> 1);
#pragma unroll
                    for (int k2 = 0; k2 < 4; ++k2) { u32x2 p0 = pk4(oacc[2 * k2] * inv), p1 = pk4(oacc[2 * k2 + 1] * inv);
                        const auto rx = __builtin_amdgcn_permlane16_swap(p0.x, p1.x, false, false); const auto ry = __builtin_amdgcn_permlane16_swap(p0.y, p1.y, false, false);
                        u32x4 w; w.x = rx[0]; w.y = ry[0]; w.z = rx[1]; w.w = ry[1];
                        if (fr < 8) *(u32x4*)(op + 32 * k2) = w; } }
            }
        }
    }
    __builtin_amdgcn_s_setprio(0);
    TS_EXPORT(wsb, blockIdx.x == 0 && wave == 0 && lane_ == 0);
}

__global__ void __launch_bounds__(NTHREADS, 2) mk_fwd(Args a) {
    extern __shared__ __attribute__((aligned(16))) unsigned char lds_raw[];
    LAS unsigned char* lds = (LAS unsigned char*)lds_raw;
    const int tid = threadIdx.x, lane = tid & 63, wave = __builtin_amdgcn_readfirstlane(tid >> 6);
    const int G = gridDim.x, bx = blockIdx.x;
    const int vcu = (G % 8 == 0) ? (bx % 8) * (G / 8) + bx / 8 : bx;
    unsigned char* ws = a.ws;
    float* ssq = (float*)(ws + WS_SSQ); float* ssq1 = (float*)(ws + WS_STATS);
    const int lo = a.ph_lo, hi = a.ph_hi;
#define IN(k) (lo <= (k) && (k) < hi)
#define SEAM(k) do { if (IN(k) && IN((k) + 1)) xcd_barrier(bar); } while (0)
    for (int u = tid; u < (LDS_BYTES - LDSCTL_OFF) / 4; u += NTHREADS) ((LAS unsigned*)(lds + LDSCTL_OFF))[u] = 0u;
    __syncthreads();
    TS_DECL;
    XcdBarrier bar; bar.bar = (unsigned*)(ws + WS_CTL) + CW_BAR + a.li * XCD_BAR_WORDS; bar.x = 0; bar.st = nullptr;
    if (hi - lo > 1) bar = xcd_barrier_post(bar.bar, (volatile LAS unsigned*)(lds + MISC_OFF) + 8);

    if (IN(PH_PROLOGUE)) for (int rep_ = 0; rep_ < 1 + (int)((PROBE_MASK >> 3) & 1u); ++rep_) {
        LAS float* scr = (LAS float*)(lds + wave * 16384);
        const int gw = vcu * NWAVES + wave, NGW = G * NWAVES;
        int base = 0;
#define CONV(Wp, gp, K_, N_, Np_, dst) do { const int n_ = ((K_) / 64) * ((Np_) / 32); int first = gw - (base % NGW); if (first < 0) first += NGW; \
            for (int it = first; it < n_; it += NGW) transpose_item(Wp, gp, K_, N_, Np_, (bf16_t*)(ws + (dst)), scr, it, lane); base += n_; } while (0)
        CONV(a.w_in_a, a.norm_mix_g, D, A_IN, A_PAD, WS_WA);
        CONV(a.w_out_a, (const float*)nullptr, D, D, D, WS_WOA);
        CONV(a.w_mlp_up, a.norm_mlp_g, D, FF, FF, WS_WUP0);
        CONV(a.w_mlp_down, (const float*)nullptr, FF, D, D, WS_WDN0);
        CONV(a.w_in_b, a.norm_mix_g + D, D, B_IN, B_IN, WS_WB);
        CONV(a.w_out_b, a.ret_norm_g, 2048, D, D, WS_WOB);
        CONV(a.w_mlp_up + (size_t)D * FF, a.norm_mlp_g + D, D, FF, FF, WS_WUP1);
        CONV(a.w_mlp_down + (size_t)FF * D, (const float*)nullptr, FF, D, D, WS_WDN1);
#undef CONV
        bf16_t* xb = (bf16_t*)(ws + WS_XB);
        for (int row = gw; row < T; row += NGW) {
            const f32x4* xr = (const f32x4*)(a.x + (size_t)row * D) + lane; u32x2* xo = (u32x2*)(xb + (size_t)row * D) + lane;
            float s = 0.f;
#pragma unroll
            for (int j = 0; j < 4; ++j) { const f32x4 v = __builtin_nontemporal_load(xr + 64 * j); xo[64 * j] = pk4(v); s += (v.x * v.x + v.y * v.y) + (v.z * v.z + v.w * v.w); }
            s = wave_sum(s);
            if (lane < 16) ssq[(size_t)row * 16 + lane] = (lane == 0) ? s : 0.f;
        }
        __syncthreads();
        LAS double* invf = (LAS double*)(lds + 8 * 16384);
        if (tid < 152) { double inv; if (tid < 16) inv = pow(500000.0, -(double)tid / 16.0); else if (tid < 24) inv = pow(500000.0, -(double)(tid - 16) / 8.0); else inv = pow(10000.0, -(double)(tid - 24) / 128.0); invf[tid] = inv; }
        __syncthreads();
        const int gt = vcu * NTHREADS + tid, NGT = G * NTHREADS;
        f32x2* tabA = (f32x2*)(ws + WS_TABA); f32x2* tabI = (f32x2*)(ws + WS_TABI); f32x2* tabR = (f32x2*)(ws + WS_TABR);
        for (int i = gt; i < SEQ * 152; i += NGT) {
            const int p = i / 152, r = i % 152; f32x2* dst;
            if (r < 16) dst = tabA + p * 16 + r; else if (r < 24) dst = tabI + p * 8 + (r - 16); else dst = tabR + p * 128 + (r - 24);
            const double ang = (double)p * invf[r]; f32x2 cs; cs.x = (float)cos(ang); cs.y = (float)sin(ang); *dst = cs;
        }
    }
    SEAM(PH_PROLOGUE);
#ifdef GEMM_NAIVE
#define RUN_GEMM_REP(BIT, EPI, SWAPV, g, E) RUN_GEMM(EPI, SWAPV, g, E)
#define RUN_GEMM(EPI, SWAPV, g, E) do { pg8::StaticOrder S_; S_.init((g).M, (g).N, G, bx); pg8::gemm_naive<EPI, pg8::StaticOrder, SWAPV>(g, S_, E); } while (0)
#else
#define RUN_GEMM(EPI, SWAPV, g, E) do { pg8::StaticOrder S_; S_.init((g).M, (g).N, G, bx); pg8::gemm_phase<EPI, pg8::StaticOrder, true, true, SWAPV>(lds, g, S_, E); } while (0)
#define RUN_GEMM_REP(BIT, EPI, SWAPV, g, E) do { for (int rep_ = 0; rep_ < 1 + (int)((PROBE_MASK >> (BIT)) & 1u); ++rep_) RUN_GEMM(EPI, SWAPV, g, E); } while (0)
#endif

    TS(12);
    if (IN(PH_GEMM_A)) {
        pg8::Gemm g{(const bf16_t*)(ws + WS_XB), (const bf16_t*)(ws + WS_WA), T, A_PAD, D};
        LAS f32x2* rptab = (LAS f32x2*)(lds + RING_BYTES);
        { pg8::StaticOrder S0; S0.init(g.M, g.N, G, bx); Unit u0;
          for (int i = 0; i < 14 && S0.next(i, u0); ++i) if (tid < 256) { const int row = u0.pm * 256 + tid; int p = a.pos[row]; p = p < 0 ? 0 : (p > SEQ - 1 ? SEQ - 1 : p);
              f32x2 rv_; rv_.x = row_rstd(ssq, row); rv_.y = __int_as_float(p); rptab[i * 256 + tid] = rv_; }
          __syncthreads(); }
        EpiA E{(const LAS f32x2*)rptab, (const f32x2*)(ws + WS_TABA), (const f32x2*)(ws + WS_TABI), (bf16_t*)(ws + WS_Q), (bf16_t*)(ws + WS_K), (bf16_t*)(ws + WS_V), (bf16_t*)(ws + WS_QI), (bf16_t*)(ws + WS_KI), (float*)(ws + WS_WI), false};
        RUN_GEMM_REP(5, EpiA, false, g, E);
    }
    TS(4);
    SEAM(PH_GEMM_A);
    if (IN(PH_DSA)) for (int rep_ = 0; rep_ < 1 + (int)((PROBE_MASK >> 1) & 1u); ++rep_) dsa_phase(lds, (const bf16_t*)(ws + WS_Q), (const bf16_t*)(ws + WS_K), (const bf16_t*)(ws + WS_V), (const bf16_t*)(ws + WS_QI), (const bf16_t*)(ws + WS_KI), (const float*)(ws + WS_WI), (bf16_t*)(ws + WS_O), vcu, G, tid, lane, wave, ws);
    SEAM(PH_DSA);
    TS(12);
    if (IN(PH_OUT_A)) {
        pg8::Gemm g{(const bf16_t*)(ws + WS_O), (const bf16_t*)(ws + WS_WOA), T, D, D};
        EpiResid E{(bf16_t*)(ws + WS_XB), ssq1, false, (const LAS float*)nullptr};
        RUN_GEMM(EpiResid, false, g, E);
    }
    TS(5);
    SEAM(PH_OUT_A);
    if (IN(PH_UP0)) {
        pg8::Gemm g{(const bf16_t*)(ws + WS_XB), (const bf16_t*)(ws + WS_WUP0), T, FF, D};
        EpiUp E{ssq, (bf16_t*)(ws + WS_HID0), false, ws};
        RUN_GEMM_REP(0, EpiUp, false, g, E);
    }
    SEAM(PH_UP0);
    if (IN(PH_DOWN0)) {
        pg8::Gemm g{(const bf16_t*)(ws + WS_HID0), (const bf16_t*)(ws + WS_WDN0), T, D, FF};
        LAS float* rtab = (LAS float*)(lds + RING_BYTES);
        { pg8::StaticOrder S0; S0.init(g.M, g.N, G, bx); Unit u0;
          for (int i = 0; i < 28 && S0.next(i, u0); ++i) if (tid < 256) { const float r_ = row_rstd(ssq1, u0.pm * 256 + tid); rtab[i * 256 + tid] = r_ * r_; }
          __syncthreads(); }
        EpiResid E{(bf16_t*)(ws + WS_XB), ssq, false, (const LAS float*)rtab};
        RUN_GEMM(EpiResid, false, g, E);
    }
    SEAM(PH_DOWN0);
    TS(12);
    if (IN(PH_GEMM_B)) {
        { pg8::Gemm g{(const bf16_t*)(ws + WS_XB), (const bf16_t*)(ws + WS_WB), T, 2048, D};
          LAS f32x2* rptab = (LAS f32x2*)(lds + RING_BYTES);
          { pg8::StaticOrder S0; S0.init(g.M, g.N, G, bx); Unit u0;
            for (int i = 0; i < 14 && S0.next(i, u0); ++i) if (tid < 256) { const int row = u0.pm * 256 + tid; int p = a.pos[row]; p = p < 0 ? 0 : (p > SEQ - 1 ? SEQ - 1 : p);
                f32x2 rv_; rv_.x = row_rstd(ssq, row); rv_.y = __int_as_float(p); rptab[i * 256 + tid] = rv_; }
            __syncthreads(); }
          EpiBqk E{(const LAS f32x2*)rptab, (const f32x2*)(ws + WS_TABR), (bf16_t*)(ws + WS_Q1), (bf16_t*)(ws + WS_K1), false};
          RUN_GEMM_REP(6, EpiBqk, false, g, E); }
        { pg8::Gemm g{(const bf16_t*)(ws + WS_XB), (const bf16_t*)(ws + WS_WB) + (size_t)2048 * D, T, 2048, D};
          EpiBv E{ssq, (bf16_t*)(ws + WS_VT), false};
          RUN_GEMM_REP(6, EpiBv, true, g, E); }
    }
    TS(6);
    SEAM(PH_GEMM_B);
    TS(12);
    if (IN(PH_R1)) {
        const bf16_t* q1 = (const bf16_t*)(ws + WS_Q1); bf16_t* k1 = (bf16_t*)(ws + WS_K1); bf16_t* inner = (bf16_t*)(ws + WS_INNER);
        const int hf = lane >> 5, l31 = lane & 31;
        constexpr int R1S = 528, R1K = 128 * R1S, R1RS = 2 * R1K;
        LAS float* rs2 = (LAS float*)(lds + R1RS);
        const int t5 = tid >> 5, s5 = tid & 31;
        const unsigned gq = (unsigned)((t5 * 1024 + s5 * 8) * 2);
        const unsigned lq = (unsigned)(t5 * R1S + s5 * 16);
        u32x4 rq[8], rk[8]; float rnx = 0.f;
#define R1_LOAD(u_) do { const int c_ = (u_) & 31, bh_ = (u_) >> 5, h_ = bh_ & 3, b_ = bh_ >> 2; const size_t r0_ = (size_t)b_ * SEQ + (size_t)c_ * 128; \
        const bf16_t* qb = q1 + r0_ * 1024 + h_ * 256; const bf16_t* kb = k1 + r0_ * 1024 + h_ * 256; \
        _Pragma("unroll") for (int i = 0; i < 8; ++i) { rq[i] = ldu<u32x4>(qb + (size_t)(16 * i) * 1024, gq); rk[i] = ldu<u32x4>(kb + (size_t)(16 * i) * 1024, gq); } \
        if (tid < 128) rnx = row_rstd(ssq, (int)r0_ + tid); } while (0)
        if (vcu < 1024) R1_LOAD(vcu);
        for (int u = vcu; u < 1024; u += G) {
            const int c = u & 31, bh = u >> 5, h = bh & 3, b = bh >> 2;
            const size_t row0 = (size_t)b * SEQ + (size_t)c * 128;
            const float l2g = log2f(1.0f - exp2f(-5.0f - (float)h));
            __syncthreads();
            { if (tid < 128) { const float r_ = rnx; rs2[tid] = r_ * r_; if (h == 0) ((float*)(ws + WS_RSN))[row0 + tid] = r_; }
#pragma unroll
              for (int i = 0; i < 8; ++i) { *(LAS u32x4*)(lds + i * 16 * R1S + lq) = rq[i]; *(LAS u32x4*)(lds + R1K + i * 16 * R1S + lq) = rk[i]; } }
            __syncthreads();
            if (u + G < 1024) R1_LOAD(u + G);
            for (int ti = wave; ti < 10; ti += 8) {
                int mt, nt; if (ti < 4) { mt = 0; nt = ti; } else if (ti < 7) { mt = 1; nt = ti - 3; } else if (ti < 9) { mt = 2; nt = ti - 5; } else { mt = 3; nt = 3; }
                f32x16 acc;
#pragma unroll
                for (int r = 0; r < 16; ++r) acc[r] = 0.f;
                const int n = 32 * nt + l31;
                const LAS unsigned char* ap = lds + R1K + (32 * mt + l31) * R1S + 16 * hf; const LAS unsigned char* bp = lds + n * R1S + 16 * hf;
#pragma unroll
                for (int sk = 0; sk < 16; ++sk) { const bf16x8 av = *(const LAS bf16x8*)(ap + 32 * sk); const bf16x8 bv = *(const LAS bf16x8*)(bp + 32 * sk); acc = MFMA32(av, bv, acc); }
                bf16_t* orow = inner + ((size_t)u * 128 + n) * 128;
#pragma unroll
                for (int k2 = 0; k2 < 2; ++k2) { f32x4 vp[2];
#pragma unroll
                    for (int g2 = 0; g2 < 2; ++g2) { const int rg = 2 * k2 + g2, m0 = 32 * mt + 8 * rg + 4 * hf;
#pragma unroll
                        for (int j = 0; j < 4; ++j) { const int m = m0 + j; vp[g2][j] = (m <= n) ? acc[4 * rg + j] * __builtin_amdgcn_exp2f(-(float)(m + 1) * l2g) * rs2[m] : 0.f; } }
                    store_pair32(orow + 32 * mt + 16 * k2, vp[0], vp[1], hf); }
            }
            { const int d = tid & 255, mh = tid >> 8; const LAS unsigned char* kcol = lds + R1K + (64 * mh) * R1S + d * 2; const LAS float* rsp = rs2 + 64 * mh;
              bf16_t* dst = k1 + (row0 + (d >> 1)) * 1024 + h * 256 + (d & 1) * 128 + 64 * mh;
#pragma unroll 2
              for (int i = 0; i < 8; ++i) { float f[8];
#pragma unroll
                  for (int j = 0; j < 8; ++j) { const int ml = 8 * i + j; f[j] = bf2f(*(const LAS bf16_t*)(kcol + ml * R1S)) * __builtin_amdgcn_exp2f((float)(127 - (64 * mh + ml)) * l2g) * rsp[ml]; }
                  u32x4 pk; pk.x = pk2(f[0], f[1]); pk.y = pk2(f[2], f[3]); pk.z = pk2(f[4], f[5]); pk.w = pk2(f[6], f[7]);
                  *(u32x4*)(dst + 8 * i) = pk; } }
        }
    }
#undef R1_LOAD
    TS(13);
    SEAM(PH_R1);
    TS(12);
    if (IN(PH_RET)) {
        const bf16_t* q1 = (const bf16_t*)(ws + WS_Q1); const bf16_t* kz = (const bf16_t*)(ws + WS_K1); const bf16_t* inner = (const bf16_t*)(ws + WS_INNER); const bf16_t* vT = (const bf16_t*)(ws + WS_VT);
        bf16_t* y = (bf16_t*)a.out; float* stats = (float*)(ws + WS_STATS);
        const int hf = lane >> 5, l31 = lane & 31, wn = wave >> 1, we = wave & 1;
        for (int rep_ = 0; rep_ < 1 + (int)((PROBE_MASK >> 2) & 1u); ++rep_)
        for (int u = vcu; u < 256; u += G) {
            const int bh = u >> 3, sl = u & 7, b = bh >> 2, h = bh & 3;
            const float l2g = log2f(1.0f - exp2f(-5.0f - (float)h)); const float gC = exp2f(128.0f * l2g);
            const float xi = exp2f((float)(32 * wn + l31 + 1) * l2g);
            f32x16 S0, S1;
#pragma unroll
            for (int r = 0; r < 16; ++r) { S0[r] = 0.f; S1[r] = 0.f; }
            __syncthreads();
            for (int i = tid; i < ST_BUF / 4; i += NTHREADS) ((LAS unsigned*)(lds + RET_ST))[i] = 0u;
            const int t5 = tid >> 5, s5 = tid & 31, t4 = tid >> 4, s4 = tid & 15;
            const unsigned gq = (unsigned)((t5 * 1024 + s5 * 8) * 2);
            const unsigned lq = (unsigned)(t5 * 512 + (((s5 & 16) | ((s5 & 15) ^ t5))) * 16);
            const unsigned lk = (unsigned)(t5 * 512 + (((s5 & 16) | ((s5 & 15) ^ ((2 * t5 + (s5 >> 4)) & 15)))) * 16);
            const unsigned gi = (unsigned)((t4 * 128 + s4 * 8) * 2);
            const unsigned li = (unsigned)(t4 * 256 + ((s4 ^ (t4 & 15))) * 16);
            const unsigned gv = (unsigned)((t4 * SEQ + s4 * 8) * 2);
            const bf16_t* qbase = q1 + (size_t)b * SEQ * 1024 + h * 256; const bf16_t* kbase = kz + (size_t)b * SEQ * 1024 + h * 256;
            const bf16_t* ibase = inner + (size_t)bh * 32 * 128 * 128; const bf16_t* vbase = vT + ((size_t)bh * 512 + 64 * sl) * SEQ;
            u32x4 rq[8], rk[8], ri[4], rv[2];
#define RET_LOAD_Y(c_) do { _Pragma("unroll") for (int i = 0; i < 4; ++i) ri[i] = ldu<u32x4>(ibase + ((size_t)(c_) * 128 + 32 * i) * 128, gi); \
                            _Pragma("unroll") for (int i = 0; i < 2; ++i) rv[i] = ldu<u32x4>(vbase + (size_t)(32 * i) * SEQ + (c_) * 128, gv); } while (0)
#define RET_LOAD_Q(c_) do { _Pragma("unroll") for (int i = 0; i < 8; ++i) rq[i] = ldu<u32x4>(qbase + ((size_t)(c_) * 128 + 16 * i) * 1024, gq); } while (0)
#define RET_LOAD_K(c_) do { _Pragma("unroll") for (int i = 0; i < 8; ++i) rk[i] = ldu<u32x4>(kbase + ((size_t)(c_) * 128 + 16 * i) * 1024, gq); } while (0)
            RET_LOAD_Y(0); RET_LOAD_Q(0); RET_LOAD_K(0);
            const int n = 32 * wn + l31, e = 32 * we + l31, dA = 64 * wn + l31;
            const float* rsnp = (const float*)(ws + WS_RSN) + (size_t)b * SEQ + n;
            float rsv = rsnp[0];
            for (int c = 0; c < 32; ++c) {
                const size_t row0 = (size_t)b * SEQ + (size_t)c * 128;
#pragma unroll
                for (int i = 0; i < 4; ++i) *(LAS u32x4*)(lds + RET_YI + i * 8192 + li) = ri[i];
#pragma unroll
                for (int i = 0; i < 2; ++i) *(LAS u32x4*)(lds + RET_YV + i * 8192 + li) = rv[i];
#pragma unroll
                for (int i = 0; i < 8; ++i) *(LAS u32x4*)(lds + RET_X + i * 8192 + lq) = rq[i];
                __syncthreads();
                const int cn = c + 1 < 32 ? c + 1 : 31;
                RET_LOAD_Q(cn);
                bf16x8 vf[8];
#pragma unroll
                for (int ks = 0; ks < 8; ++ks) vf[ks] = *(const LAS bf16x8*)(lds + RET_YV + e * 256 + (((2 * ks + hf) ^ (e & 15))) * 16);
                f32x16 o;
#pragma unroll
                for (int r = 0; r < 16; ++r) o[r] = 0.f;
#pragma unroll
                for (int mt = 0; mt < 4; ++mt) if (mt <= wn) {
#pragma unroll
                    for (int s2 = 0; s2 < 2; ++s2) { const int ks = 2 * mt + s2; const bf16x8 bv = *(const LAS bf16x8*)(lds + RET_YI + n * 256 + (((2 * ks + hf) ^ (n & 15))) * 16); o = MFMA32(vf[ks], bv, o); } }
                const LAS unsigned char* stp = lds + RET_ST + e * ST_STRIDE + 16 * hf;
#pragma unroll
                for (int sk = 0; sk < 16; ++sk) { const int slot = 2 * sk + hf; const bf16x8 av = *(const LAS bf16x8*)(stp + 32 * sk);
                    const bf16x8 bv = *(const LAS bf16x8*)(lds + RET_X + n * 512 + (((slot & 16) | ((slot & 15) ^ (n & 15)))) * 16); o = MFMA32(av, bv, o); }
                const float xs = xi * rsv;
                float s1 = 0.f, s2q = 0.f;
#pragma unroll
                for (int r = 0; r < 16; ++r) { o[r] *= xs; s1 += o[r]; s2q += o[r] * o[r]; }
                s1 += lane_xor32(s1); s2q += lane_xor32(s2q);
                if (hf == 0) { f32x2 sv; sv.x = s1; sv.y = s2q; *(f32x2*)(stats + (((row0 + n) * 4 + h) * 16 + 2 * sl + we) * 2) = sv; }
                bf16_t* yp = y + (row0 + n) * 2048 + h * 512 + 64 * sl + 32 * we;
#pragma unroll
                for (int k2 = 0; k2 < 2; ++k2) { f32x4 va, vb; va.x = o[8 * k2]; va.y = o[8 * k2 + 1]; va.z = o[8 * k2 + 2]; va.w = o[8 * k2 + 3]; vb.x = o[8 * k2 + 4]; vb.y = o[8 * k2 + 5]; vb.z = o[8 * k2 + 6]; vb.w = o[8 * k2 + 7];
                    store_pair32(yp + 16 * k2, va, vb, hf); }
                __syncthreads();
#pragma unroll
                for (int i = 0; i < 8; ++i) *(LAS u32x4*)(lds + RET_X + i * 8192 + lk) = rk[i];
                RET_LOAD_K(cn);
                rsv = rsnp[cn * 128];
                RET_LOAD_Y(cn);
                __syncthreads();
#pragma unroll
                for (int ks = 0; ks < 8; ++ks) vf[ks] = *(const LAS bf16x8*)(lds + RET_YV + e * 256 + (((2 * ks + hf) ^ (e & 15))) * 16);
#pragma unroll
                for (int r = 0; r < 16; ++r) { S0[r] *= gC; S1[r] *= gC; }
#pragma unroll
                for (int sk = 0; sk < 8; ++sk) {
                    const int d0 = dA, d1 = dA + 32; const int sl0 = 16 * (d0 & 1) + 2 * sk + hf;
                    const bf16x8 a0 = *(const LAS bf16x8*)(lds + RET_X + (d0 >> 1) * 512 + (((sl0 & 16) | ((sl0 & 15) ^ (d0 & 15)))) * 16);
                    const bf16x8 a1 = *(const LAS bf16x8*)(lds + RET_X + (d1 >> 1) * 512 + (((sl0 & 16) | ((sl0 & 15) ^ (d1 & 15)))) * 16);
                    S0 = MFMA32(a0, vf[sk], S0); S1 = MFMA32(a1, vf[sk], S1); }
                LAS unsigned char* stw = lds + RET_ST + e * ST_STRIDE + (64 * wn + 4 * hf) * 2;
#pragma unroll
                for (int rg = 0; rg < 4; ++rg) { f32x4 v0, v1; v0.x = S0[4 * rg]; v0.y = S0[4 * rg + 1]; v0.z = S0[4 * rg + 2]; v0.w = S0[4 * rg + 3]; v1.x = S1[4 * rg]; v1.y = S1[4 * rg + 1]; v1.z = S1[4 * rg + 2]; v1.w = S1[4 * rg + 3];
                    *(LAS u32x2*)(stw + 16 * rg) = pk4(v0); *(LAS u32x2*)(stw + 64 + 16 * rg) = pk4(v1); }
                __syncthreads();
            }
#undef RET_LOAD_Y
#undef RET_LOAD_Q
#undef RET_LOAD_K
        }
    }
    TS(14);
    SEAM(PH_RET);
    TS(12);
    if (IN(PH_GATE)) {
        pg8::Gemm g{(const bf16_t*)(ws + WS_XB), (const bf16_t*)(ws + WS_WB) + (size_t)4096 * D, T, 2048, D};
        LAS f32x4* gtab = (LAS f32x4*)(lds + RING_BYTES);
        { pg8::StaticOrder S0; S0.init(g.M, g.N, G, bx); Unit u0; const float* stats = (const float*)(ws + WS_STATS);
          for (int i = 0; i < 7 && S0.next(i, u0); ++i) {
              if (tid < 256) { const int row = u0.pm * 256 + tid, hd = u0.pn >> 1;
                  const f32x4* sp = (const f32x4*)(stats + ((size_t)row * 4 + hd) * 32); float sum = 0.f, sq = 0.f;
#pragma unroll
                  for (int j = 0; j < 8; ++j) { const f32x4 sv = sp[j]; sum += sv.x + sv.z; sq += sv.y + sv.w; }
                  const float mu = sum * (1.0f / 512.0f); const float var = fmaxf(sq * (1.0f / 512.0f) - mu * mu, 0.f);
                  f32x4 tv; tv.x = row_rstd(ssq, row); tv.y = mu; tv.z = rsqrtf(var + EPS); tv.w = -mu * tv.z; gtab[i * 256 + tid] = tv; } }
          __syncthreads(); }
        EpiGate E{(const LAS f32x4*)gtab, (bf16_t*)a.out, false};
        RUN_GEMM(EpiGate, false, g, E);
    }
    TS(1);
    SEAM(PH_GATE);
    TS(12);
    if (IN(PH_OUT_B)) {
        pg8::Gemm g{(const bf16_t*)a.out, (const bf16_t*)(ws + WS_WOB), T, D, 2048};
        EpiResid E{(bf16_t*)(ws + WS_XB), ssq1, false, (const LAS float*)nullptr};
        RUN_GEMM(EpiResid, false, g, E);
    }
    TS(7);
    SEAM(PH_OUT_B);
    if (IN(PH_UP1)) {
        pg8::Gemm g{(const bf16_t*)(ws + WS_XB), (const bf16_t*)(ws + WS_WUP1), T, FF, D};
        EpiUp E{ssq, (bf16_t*)(ws + WS_HID1), false, ws};
        RUN_GEMM_REP(0, EpiUp, false, g, E);
    }
    SEAM(PH_UP1);
    TS(12);
    if (IN(PH_DOWN1)) {
        pg8::Gemm g{(const bf16_t*)(ws + WS_HID1), (const bf16_t*)(ws + WS_WDN1), T, D, FF};
        LAS float* rtab = (LAS float*)(lds + RING_BYTES);
        { pg8::StaticOrder S0; S0.init(g.M, g.N, G, bx); Unit u0;
          for (int i = 0; i < 28 && S0.next(i, u0); ++i) if (tid < 256) { const float r_ = row_rstd(ssq1, u0.pm * 256 + tid); rtab[i * 256 + tid] = r_ * r_; }
          __syncthreads(); }
        EpiResid E{(bf16_t*)(ws + WS_XB), ssq, false, (const LAS float*)rtab};
        RUN_GEMM(EpiResid, false, g, E);
    }
    TS(8);
    SEAM(PH_DOWN1);
    TS_EXPORT(ws, blockIdx.x == 0 && tid == 0);
    if (IN(PH_FINAL)) {
        int lane_f = lane; asm volatile("" : "+v"(lane_f));
        const int gw = vcu * NWAVES + wave, NGW = G * NWAVES; const bf16_t* xb = (const bf16_t*)(ws + WS_XB);
        for (int row = gw; row < T; row += NGW) {
            const float rs = row_rstd(ssq, row);
            const u32x2* xr = (const u32x2*)(xb + (size_t)row * D) + lane_f; f32x4* orow = (f32x4*)(a.out + (size_t)row * D) + lane_f; const f32x4* gr = (const f32x4*)a.final_norm_g + lane_f;
#pragma unroll
            for (int j = 0; j < 4; ++j) { const u32x2 xv = __builtin_nontemporal_load(xr + 64 * j); f32x4 hv; hv.x = __uint_as_float(xv.x << 16); hv.y = __uint_as_float(xv.x & 0xffff0000u); hv.z = __uint_as_float(xv.y << 16); hv.w = __uint_as_float(xv.y & 0xffff0000u);
                __builtin_nontemporal_store(hv * rs * gr[64 * j], orow + 64 * j); }
        }
#ifdef TPROBE
        if (bx == 0 && tid == 0) { const unsigned long long tv_ = ((const unsigned long long*)(ws + WS_TPROBE))[TPROBE]; a.out[0] += (float)tv_ * (0.01f / 5.0f); }
#endif
    }
#undef IN
#undef SEAM
}

extern "C" void kernel_launch(void* const* d_in, const int* in_sizes, int n_in, void* d_out, int out_size, void* d_ws, size_t ws_size, hipStream_t stream) {
    static int grid = 0;
    if (grid == 0) {
        if (n_in != 12 || out_size != T * D || ws_size < WS_END) { fprintf(stderr, "kernel_launch: unexpected shapes (n_in %d out %d ws %zu)\n", n_in, out_size, ws_size); grid = -1; return; }
        int dev = 0, cus = 0;
        if (hipGetDevice(&dev) != hipSuccess || hipDeviceGetAttribute(&cus, hipDeviceAttributeMultiprocessorCount, dev) != hipSuccess) { grid = -1; return; }
        if (hipFuncSetAttribute((const void*)mk_fwd, hipFuncAttributeMaxDynamicSharedMemorySize, LDS_BYTES) != hipSuccess) { fprintf(stderr, "kernel_launch: hipFuncSetAttribute failed\n"); grid = -1; return; }
        int per_cu = 0;
        if (hipOccupancyMaxActiveBlocksPerMultiprocessor(&per_cu, (const void*)mk_fwd, NTHREADS, LDS_BYTES) != hipSuccess || per_cu < 1) { fprintf(stderr, "kernel_launch: occupancy query says %d workgroups per CU; nothing launched\n", per_cu); grid = -1; return; }
        (void)hipGetLastError();
        grid = cus;
    }
    if (grid < 0) return;
    unsigned char* ws = (unsigned char*)d_ws;
    Args a{};
    a.x = (const float*)d_in[0]; a.pos = (const int*)d_in[1]; a.norm_mix_g = (const float*)d_in[2]; a.norm_mlp_g = (const float*)d_in[3]; a.w_in_a = (const float*)d_in[4]; a.w_out_a = (const float*)d_in[5];
    a.w_in_b = (const float*)d_in[6]; a.ret_norm_g = (const float*)d_in[7]; a.w_out_b = (const float*)d_in[8]; a.w_mlp_up = (const float*)d_in[9]; a.w_mlp_down = (const float*)d_in[10]; a.final_norm_g = (const float*)d_in[11];
    a.out = (float*)d_out; a.ws = ws;
    if (hipMemsetAsync(ws + WS_CTL, 0, CTL_ZERO_BYTES, stream) != hipSuccess) { fprintf(stderr, "kernel_launch: memset failed\n"); return; }
    int li = 0;
    auto seg = [&](int lo, int hi) {
        a.ph_lo = lo; a.ph_hi = hi; a.li = li++;
        if (hi - lo > 1) { void* args[] = {&a}; hipError_t e = hipLaunchCooperativeKernel((const void*)mk_fwd, dim3(grid), dim3(NTHREADS), args, LDS_BYTES, stream);
            if (e != hipSuccess) fprintf(stderr, "cooperative launch failed: %s\n", hipGetErrorString(e)); }
        else hipLaunchKernelGGL(mk_fwd, dim3(grid), dim3(NTHREADS), LDS_BYTES, stream, a);
    };
#ifdef PROBE_PRE_PHASE
    seg(PROBE_PRE_PHASE, PROBE_PRE_PHASE + 1);
#endif
    seg(PH_PROLOGUE, PH_COUNT);
#ifdef PROBE_EXTRA_PHASE
    seg(PROBE_EXTRA_PHASE, PROBE_EXTRA_PHASE + 1);
#endif
}
```
